# Optimizing an MI355X kernel written in HIP

```python
import math
import jax, jax.numpy as jnp
from jax import lax
import numpy as np

D_MODEL = 1024
BATCH = 4
SEQ = 4096
DEPTH = 2

CHUNK = 64
Q_BLOCK = 128
D_MIX = D_MODEL
SSD_WIDTH = D_MIX // 2
SSD_HEAD_DIM = 64
SSD_HEADS = SSD_WIDTH // SSD_HEAD_DIM
SSD_GROUPS = 2
SSD_HPG = SSD_HEADS // SSD_GROUPS
SSD_STATE = 128
SSD_CONV = 4
SSD_CONV_DIM = SSD_WIDTH + 2 * SSD_GROUPS * SSD_STATE
SSD_IN = SSD_WIDTH + SSD_CONV_DIM + SSD_HEADS
FOX_WIDTH = D_MIX // 4
FOX_HEAD_DIM = 64
FOX_HEADS = FOX_WIDTH // FOX_HEAD_DIM
FOX_IN = 3 * FOX_WIDTH + FOX_HEADS
SCONV_WIDTH = D_MIX - SSD_WIDTH - FOX_WIDTH
SCONV_K = 3
SCONV_IN = 3 * SCONV_WIDTH
D_IN_PROJ = SSD_IN + FOX_IN + SCONV_IN
D_FF = 2816
ALPHA = (2 * DEPTH) ** 0.25
BETA = (8 * DEPTH) ** -0.25
LN_EPS = 1e-5
RMS_EPS = 1e-5
N_SUB = 3

kernel_name = "hybrid_ssd_fox_shortconv_macaron_deepnorm_adaln"


def layer_norm(x, g, b):
    xf = x.astype(jnp.float32)
    mu = jnp.mean(xf, axis=-1, keepdims=True)
    var = jnp.mean(jnp.square(xf - mu), axis=-1, keepdims=True)
    return ((xf - mu) * lax.rsqrt(var + LN_EPS) * g + b).astype(x.dtype)


def causal_depthwise_conv(x, w, b=None):
    k_w, ch = w.shape
    y = lax.conv_general_dilated(
        x, w[:, None, :], window_strides=(1,), padding=[(k_w - 1, 0)],
        dimension_numbers=("NWC", "WIO", "NWC"), feature_group_count=ch)
    return y if b is None else y + b


def swiglu_ffn(h, w_in, w_out):
    gate, up = jnp.split(h @ w_in, 2, axis=-1)
    return (jax.nn.silu(gate) * up) @ w_out


def segsum(a):
    t = a.shape[-1]
    cs = jnp.cumsum(a, axis=-1)
    diff = cs[..., :, None] - cs[..., None, :]
    mask = jnp.tril(jnp.ones((t, t), dtype=bool))
    return jnp.where(mask, diff, -jnp.inf)


def ssd_chunked_scan(xdt, a, bm, cm):
    b, seq, g, e, p = xdt.shape
    n = bm.shape[-1]
    nc = seq // CHUNK
    xdt = xdt.reshape(b, nc, CHUNK, g, e, p)
    bm = bm.reshape(b, nc, CHUNK, g, n)
    cm = cm.reshape(b, nc, CHUNK, g, n)
    a = jnp.transpose(a.reshape(b, nc, CHUNK, g, e), (0, 3, 4, 1, 2))
    a_cs = jnp.cumsum(a, axis=-1)
    l_mat = jnp.exp(segsum(a))
    cb = jnp.einsum("bclgn,bcsgn->bgcls", cm, bm)
    y_diag = jnp.einsum("bgcls,bgecls,bcsgep->bclgep", cb, l_mat, xdt)
    decay_states = jnp.exp(a_cs[..., -1:] - a_cs)
    states = jnp.einsum("bclgn,bgecl,bclgep->bcgepn", bm, decay_states, xdt)
    chunk_a = jnp.pad(a_cs[..., -1], ((0, 0), (0, 0), (0, 0), (1, 0)))
    decay_chunk = jnp.exp(segsum(chunk_a))
    states = jnp.concatenate([jnp.zeros_like(states[:, :1]), states], axis=1)
    states_in = jnp.einsum("bgezc,bcgepn->bzgepn", decay_chunk, states)[:, :-1]
    y_off = jnp.einsum("bclgn,bcgepn,bgecl->bclgep", cm, states_in, jnp.exp(a_cs))
    return (y_diag + y_off).reshape(b, seq, g, e, p)


def mamba2_group(proj, conv_w, conv_b, dt_bias, a_log, d_skip, norm_g):
    b, seq, _ = proj.shape
    z, xbc, dt_raw = jnp.split(proj, [SSD_WIDTH, SSD_WIDTH + SSD_CONV_DIM], axis=-1)
    xbc = jax.nn.silu(causal_depthwise_conv(xbc, conv_w, conv_b))
    xs, bm, cm = jnp.split(xbc, [SSD_WIDTH, SSD_WIDTH + SSD_GROUPS * SSD_STATE], axis=-1)
    xs = xs.astype(jnp.float32).reshape(b, seq, SSD_GROUPS, SSD_HPG, SSD_HEAD_DIM)
    bm = bm.astype(jnp.float32).reshape(b, seq, SSD_GROUPS, SSD_STATE)
    cm = cm.astype(jnp.float32).reshape(b, seq, SSD_GROUPS, SSD_STATE)
    dt = jax.nn.softplus(dt_raw.astype(jnp.float32) + dt_bias.astype(jnp.float32))
    dt = dt.reshape(b, seq, SSD_GROUPS, SSD_HPG)
    a_head = -jnp.exp(a_log.astype(jnp.float32)).reshape(SSD_GROUPS, SSD_HPG)
    y = ssd_chunked_scan(xs * dt[..., None], dt * a_head, bm, cm)
    y = y + d_skip.astype(jnp.float32).reshape(SSD_GROUPS, SSD_HPG)[:, :, None] * xs
    y = y.reshape(b, seq, SSD_WIDTH) * jax.nn.silu(z.astype(jnp.float32))
    yg = y.reshape(b, seq, SSD_GROUPS, SSD_WIDTH // SSD_GROUPS)
    yg = yg * lax.rsqrt(jnp.mean(jnp.square(yg), axis=-1, keepdims=True) + RMS_EPS)
    return (yg.reshape(b, seq, SSD_WIDTH) * norm_g).astype(proj.dtype)


def fox_group(proj, f_bias):
    b, seq, _ = proj.shape
    q, k, v, f = jnp.split(proj, [FOX_WIDTH, 2 * FOX_WIDTH, 3 * FOX_WIDTH], axis=-1)
    q = q.reshape(b, seq, FOX_HEADS, FOX_HEAD_DIM)
    k = k.reshape(b, seq, FOX_HEADS, FOX_HEAD_DIM)
    v = v.reshape(b, seq, FOX_HEADS, FOX_HEAD_DIM)
    log_f = jax.nn.log_sigmoid(f.astype(jnp.float32) + f_bias.astype(jnp.float32))
    cum_f = jnp.transpose(jnp.cumsum(log_f, axis=1), (0, 2, 1))
    scale = FOX_HEAD_DIM ** -0.5
    outs = []
    for i in range(seq // Q_BLOCK):
        q0, end = i * Q_BLOCK, (i + 1) * Q_BLOCK
        s = jnp.einsum("bqhd,bkhd->bhqk", q[:, q0:end], k[:, :end]).astype(jnp.float32) * scale
        s = s + cum_f[:, :, q0:end, None] - cum_f[:, :, None, :end]
        mask = jnp.arange(q0, end)[:, None] >= jnp.arange(end)[None, :]
        prob = jax.nn.softmax(jnp.where(mask, s, -jnp.inf), axis=-1)
        outs.append(jnp.einsum("bhqk,bkhd->bqhd", prob.astype(v.dtype), v[:, :end]))
    return jnp.concatenate(outs, axis=1).reshape(b, seq, FOX_WIDTH)


def shortconv_group(proj, conv_w):
    bg, cg, xin = jnp.split(proj, 3, axis=-1)
    return bg * causal_depthwise_conv(cg * xin, conv_w)


def modulate(x, shift, scale):
    return x * (1.0 + scale) + shift


def setup_inputs(seed: int = 0) -> dict:
    key = jax.random.key(seed)
    ks = jax.random.split(key, 24)

    def nrm(k, shape, s):
        return jax.random.normal(k, shape, jnp.float32) * s

    dt0 = jnp.exp(jax.random.uniform(ks[12], (DEPTH, SSD_HEADS), jnp.float32,
                                     minval=math.log(1e-3), maxval=math.log(1e-1)))
    return {
        "x": nrm(ks[0], (BATCH, SEQ, D_MODEL), 1.0),
        "c": nrm(ks[1], (BATCH, D_MODEL), 1.0),
        "ln_in_g": 1.0 + nrm(ks[2], (D_MODEL,), 0.01),
        "ln_in_b": nrm(ks[3], (D_MODEL,), 0.01),
        "ada_w": nrm(ks[4], (DEPTH, D_MODEL, N_SUB * 3 * D_MODEL), 0.5 * D_MODEL ** -0.5),
        "ada_b": nrm(ks[5], (DEPTH, N_SUB * 3 * D_MODEL), 0.01),
        "ffn1_w_in": nrm(ks[6], (DEPTH, D_MODEL, 2 * D_FF), D_MODEL ** -0.5),
        "ffn1_w_out": nrm(ks[7], (DEPTH, D_FF, D_MODEL), BETA * D_FF ** -0.5),
        "mix_w_in": nrm(ks[8], (DEPTH, D_MODEL, D_IN_PROJ), D_MODEL ** -0.5),
        "mix_w_out": nrm(ks[9], (DEPTH, D_MIX, D_MODEL), BETA * D_MIX ** -0.5),
        "ssd_conv_w": nrm(ks[10], (DEPTH, SSD_CONV, SSD_CONV_DIM), SSD_CONV ** -0.5),
        "ssd_conv_b": nrm(ks[11], (DEPTH, SSD_CONV_DIM), 0.01),
        "ssd_dt_bias": dt0 + jnp.log(-jnp.expm1(-dt0)),
        "ssd_a_log": jnp.log(jax.random.uniform(ks[13], (DEPTH, SSD_HEADS), jnp.float32,
                                                 minval=1.0, maxval=16.0)),
        "ssd_d": 1.0 + nrm(ks[14], (DEPTH, SSD_HEADS), 0.01),
        "ssd_norm_g": 1.0 + nrm(ks[15], (DEPTH, SSD_WIDTH), 0.01),
        "fox_f_bias": jax.random.uniform(ks[16], (DEPTH, FOX_HEADS), jnp.float32,
                                         minval=1.0, maxval=5.0),
        "sconv_w": nrm(ks[17], (DEPTH, SCONV_K, SCONV_WIDTH), SCONV_K ** -0.5),
        "ffn2_w_in": nrm(ks[18], (DEPTH, D_MODEL, 2 * D_FF), D_MODEL ** -0.5),
        "ffn2_w_out": nrm(ks[19], (DEPTH, D_FF, D_MODEL), BETA * D_FF ** -0.5),
        "ln_g": 1.0 + nrm(ks[20], (DEPTH, N_SUB, D_MODEL), 0.01),
        "ln_b": nrm(ks[21], (DEPTH, N_SUB, D_MODEL), 0.01),
    }


def reference(x, c, ln_in_g, ln_in_b, ada_w, ada_b, ffn1_w_in, ffn1_w_out,
              mix_w_in, mix_w_out, ssd_conv_w, ssd_conv_b, ssd_dt_bias, ssd_a_log,
              ssd_d, ssd_norm_g, fox_f_bias, sconv_w, ffn2_w_in, ffn2_w_out,
              ln_g, ln_b):
    b = x.shape[0]
    x = layer_norm(x, ln_in_g, ln_in_b)
    c_act = jax.nn.silu(c)
    for l in range(DEPTH):
        mod = (c_act @ ada_w[l] + ada_b[l]).reshape(b, N_SUB, 3, 1, D_MODEL)

        h = modulate(x, mod[:, 0, 0], mod[:, 0, 1])
        y = swiglu_ffn(h, ffn1_w_in[l], ffn1_w_out[l])
        x = layer_norm(ALPHA * x + 0.5 * mod[:, 0, 2] * y, ln_g[l, 0], ln_b[l, 0])

        h = modulate(x, mod[:, 1, 0], mod[:, 1, 1])
        proj = h @ mix_w_in[l]
        p_ssd, p_fox, p_sc = jnp.split(proj, [SSD_IN, SSD_IN + FOX_IN], axis=-1)
        y_ssd = mamba2_group(p_ssd, ssd_conv_w[l], ssd_conv_b[l], ssd_dt_bias[l],
                             ssd_a_log[l], ssd_d[l], ssd_norm_g[l])
        y_fox = fox_group(p_fox, fox_f_bias[l])
        y_sc = shortconv_group(p_sc, sconv_w[l])
        y = jnp.concatenate([y_ssd, y_fox, y_sc], axis=-1) @ mix_w_out[l]
        x = layer_norm(ALPHA * x + mod[:, 1, 2] * y, ln_g[l, 1], ln_b[l, 1])

        h = modulate(x, mod[:, 2, 0], mod[:, 2, 1])
        y = swiglu_ffn(h, ffn2_w_in[l], ffn2_w_out[l])
        x = layer_norm(ALPHA * x + 0.5 * mod[:, 2, 2] * y, ln_g[l, 2], ln_b[l, 2])
    return x
```

```cpp
#include <hip/hip_runtime.h>
#include <hip/hip_cooperative_groups.h>
#include <cstdio>
#include <cstdint>
namespace cg = cooperative_groups;
#ifndef PG8_A_AUX
#define PG8_A_AUX 16
#endif
namespace pg8 {
#define PG8_LAS __attribute__((address_space(3)))
typedef unsigned short bf16_t;
typedef short bf16x8 __attribute__((ext_vector_type(8)));
typedef float f32x4 __attribute__((ext_vector_type(4)));
typedef unsigned u32x4 __attribute__((ext_vector_type(4)));
constexpr int BM = 256, BK = 64, HALF = 128, HTB = HALF * BK * 2  , STAGE_BYTES = 8 * HTB, NXCD = 8, WGM = 8;

__host__ __device__ __forceinline__ int lds_byte(int r, int c) { const int st = (r >> 4) * 2 + (c >> 5), rr = r & 15, cc = c & 31, ob = rr * 64 + cc * 2; return st * 1024 + (ob ^ (((ob >> 9) & 1) << 5)); }
__host__ __device__ __forceinline__ void stage_rc(int b, int& R, int& C) { const int st = b / 1024, sb = b % 1024, swz = sb ^ (((sb >> 9) & 1) << 5); R = (st >> 1) * 16 + swz / 64; C = (st & 1) * 32 + (swz % 64) / 2; }
__host__ __device__ __forceinline__ int perm32(int rho) { const int n = rho >> 4, i = rho & 15; return 8 * (i >> 2) + 4 * n + (i & 3); }

struct Unit { int pm, pn; };
struct Gemm { const bf16_t* A; const bf16_t* Bt; int M, N, K; };

struct StaticOrder {
    int nM, nN, nwg, G, c;
    __host__ __device__ void init(int M, int N, int G_, int c_) { nM = M / BM; nN = N / BM; nwg = nM * nN; G = G_; c = c_; }
    __host__ __device__ bool next(int i, Unit& u) const {
        const long L = (long)i * G + c; if (L >= nwg) return false;
        int wgid = (int)L; { const int q = nwg / NXCD, r = nwg % NXCD, xcd = wgid % NXCD, off = wgid / NXCD; wgid = (xcd < r ? xcd * (q + 1) : r * (q + 1) + (xcd - r) * q) + off; }
        const int nig = WGM * nN, gid = wgid / nig, fm = gid * WGM, gsz = (nM - fm) < WGM ? (nM - fm) : WGM;
        u.pm = fm + ((wgid % nig) % gsz); u.pn = (wgid % nig) / gsz; return true;
    }
    __device__ __forceinline__ void a_ready(const Unit&) const {}
    __device__ __forceinline__ void done(const Unit&) const {}
};

__device__ __forceinline__ unsigned cvt_pk_bf16(float lo, float hi) { unsigned r; asm volatile("v_cvt_pk_bf16_f32 %0, %1, %2" : "=v"(r) : "v"(lo), "v"(hi)); return r; }
typedef float f32x2 __attribute__((ext_vector_type(2)));
__device__ __forceinline__ f32x2 gelu_pk(f32x2 v) {
    const f32x2 av = __builtin_elementwise_abs(v), d = av * 0.2316418882f + 1.0f;
    f32x2 t; t.x = __builtin_amdgcn_rcpf(d.x); t.y = __builtin_amdgcn_rcpf(d.y);
    f32x2 q = t * 0.5307027145f + (-0.7265760135f); q = q * t + 0.7107068705f; q = q * t + (-0.142248368f); q = q * t + 0.127414796f; q = q * t;
    const f32x2 s = (v * v) * (-0.72134752044f);
    f32x2 e; e.x = __builtin_amdgcn_exp2f(s.x); e.y = __builtin_amdgcn_exp2f(s.y);
    const f32x2 m = v * (q * e), r = v - m;
    f32x2 o; o.x = v.x < 0.f ? m.x : r.x; o.y = v.y < 0.f ? m.y : r.y; return o;
}

template <int ACT  > struct EpiBf16 {
    static constexpr bool PERM = true, AFTER_DRAIN = false; static_assert(ACT == 0 || ACT == 1, "EpiBf16: ACT is 0 (none) or 1 (gelu_pk)");
    bf16_t* O; int ldc; const float* bias; int split_cols; size_t split_stride; float scale0;
    __device__ __forceinline__ void operator()(const f32x4 (&acc)[2][2][4][2], const Unit& u, int wr, int wc, int fr, int fq) const {
        const int row0 = u.pm * BM + wr * 64 + fr; int colt = u.pn * BM; bf16_t* base = O;
        float sc = 1.f; if (split_cols) { const int t = colt / split_cols; base += (size_t)t * split_stride; colt -= t * split_cols; if (t == 0) sc = scale0; }
        const int col0 = colt + wc * 32 + 8 * fq, bcol0 = u.pn * BM + wc * 32 + 8 * fq;
        f32x4 bv[2][2];
#pragma unroll
        for (int bj = 0; bj < 2; ++bj)
#pragma unroll
            for (int n = 0; n < 2; ++n) bv[bj][n] = bias ? *(const f32x4*)(bias + bcol0 + bj * HALF + 4 * n) : (f32x4){0.f, 0.f, 0.f, 0.f};
#pragma unroll
        for (int ai = 0; ai < 2; ++ai)
#pragma unroll
            for (int m = 0; m < 4; ++m) { bf16_t* rowp = base + (size_t)(row0 + ai * HALF + m * 16) * ldc + col0;
#pragma unroll
                for (int bj = 0; bj < 2; ++bj) { f32x4 v0 = acc[ai][bj][m][0] + bv[bj][0], v1 = acc[ai][bj][m][1] + bv[bj][1];
                    if (ACT == 1) { f32x2 a = gelu_pk((f32x2){v0[0], v0[1]}), b = gelu_pk((f32x2){v0[2], v0[3]}), c = gelu_pk((f32x2){v1[0], v1[1]}), d = gelu_pk((f32x2){v1[2], v1[3]});
                        v0 = (f32x4){a.x, a.y, b.x, b.y}; v1 = (f32x4){c.x, c.y, d.x, d.y}; }
                    v0 = v0 * sc; v1 = v1 * sc; u32x4 w; w.x = cvt_pk_bf16(v0[0], v0[1]); w.y = cvt_pk_bf16(v0[2], v0[3]); w.z = cvt_pk_bf16(v1[0], v1[1]); w.w = cvt_pk_bf16(v1[2], v1[3]);
                    *(u32x4*)(rowp + bj * HALF) = w; } }
    }
};

struct PanelStats {
    unsigned* xbuf;
    unsigned* cnt;
    unsigned* tmo;
    int ntn; float eps;
    unsigned code;
    __device__ __forceinline__ bool run(const f32x4 (&v)[2][2][4][2], const Unit& u, int wr, int wc, int fr, int fq, PG8_LAS unsigned char* lds, int wid, int lane) const {
        typedef float f32x2v __attribute__((ext_vector_type(2)));
        PG8_LAS f32x2v* P = (PG8_LAS f32x2v*)lds;
        PG8_LAS f32x2v* S = (PG8_LAS f32x2v*)(lds + 8192);
        PG8_LAS unsigned* flag = (PG8_LAS unsigned*)(lds + 8192 + 2048);
#pragma unroll
        for (int ai = 0; ai < 2; ++ai)
#pragma unroll
            for (int m = 0; m < 4; ++m) {
                float s = 0.f;
#pragma unroll
                for (int bj = 0; bj < 2; ++bj)
#pragma unroll
                    for (int n = 0; n < 2; ++n) { const f32x4 x = v[ai][bj][m][n]; s += (x[0] + x[1]) + (x[2] + x[3]); }
                s += __shfl_xor(s, 16); s += __shfl_xor(s, 32);
                const float mw = s * (1.0f / 64.0f); float q = 0.f;
#pragma unroll
                for (int bj = 0; bj < 2; ++bj)
#pragma unroll
                    for (int n = 0; n < 2; ++n) { const f32x4 d = v[ai][bj][m][n] - mw; q += (d[0] * d[0] + d[1] * d[1]) + (d[2] * d[2] + d[3] * d[3]); }
                q += __shfl_xor(q, 16); q += __shfl_xor(q, 32);
                if (fq == 0) P[(ai * HALF + wr * 64 + m * 16 + fr) * 4 + wc] = (f32x2v){mw, q};
            }
        asm volatile("s_waitcnt lgkmcnt(0)" ::: "memory"); __builtin_amdgcn_s_barrier(); asm volatile("" ::: "memory");
#if defined(BROKEN_EXCHANGE_NO_WAIT)
#warning BROKEN CONTROL BUILD: the row-statistics exchange does not wait; results are wrong by design
        if (blockIdx.x >= 64) { const long long t0_ = clock64(); while (clock64() - t0_ < 60000) __builtin_amdgcn_s_sleep(8); }
#endif
        const int row = wid * 32 + (lane & 31);
        if (lane < 32) {
            const f32x2v a = P[row * 4 + 0], b = P[row * 4 + 1], c = P[row * 4 + 2], d = P[row * 4 + 3];
            const float mt = (a.x + b.x + c.x + d.x) * 0.25f;
            const float da = a.x - mt, db = b.x - mt, dc = c.x - mt, dd = d.x - mt;
            const float m2 = (a.y + b.y) + (c.y + d.y) + 64.0f * ((da * da + db * db) + (dc * dc + dd * dd));
            unsigned long long* slot = (unsigned long long*)xbuf + ((size_t)(u.pm * BM + row) * 4 + u.pn);
            __hip_atomic_store(slot, ((unsigned long long)__float_as_uint(m2) << 32) | __float_as_uint(mt), __ATOMIC_RELAXED, __HIP_MEMORY_SCOPE_AGENT);
        }
        asm volatile("s_waitcnt vmcnt(0)" ::: "memory");
        if (lane == 0) __hip_atomic_fetch_add(cnt + 64 * u.pm, 1u, __ATOMIC_RELAXED, __HIP_MEMORY_SCOPE_AGENT);
        if (wid == 0) {
            bool dead = false; const unsigned long long t0 = __builtin_amdgcn_s_memrealtime(); const unsigned want = 8u * (unsigned)ntn;
            for (;;) {
#if defined(BROKEN_EXCHANGE_NO_WAIT)
                break;
#endif
                if ((unsigned)__builtin_amdgcn_readfirstlane(__hip_atomic_load(cnt + 64 * u.pm, __ATOMIC_RELAXED, __HIP_MEMORY_SCOPE_AGENT)) >= want) break;
                if (__builtin_amdgcn_s_memrealtime() - t0 > 2000000ull) {
                    if (lane == 0) { unsigned expect = 0u; __hip_atomic_compare_exchange_strong(tmo + 1, &expect, code | (unsigned)(u.pm & 0xff), __ATOMIC_RELAXED, __ATOMIC_RELAXED, __HIP_MEMORY_SCOPE_AGENT);
                                     __hip_atomic_store(tmo, 1u, __ATOMIC_RELAXED, __HIP_MEMORY_SCOPE_AGENT); }
                    dead = true; break; }
                __builtin_amdgcn_s_sleep(2);
            }
            __builtin_amdgcn_fence(__ATOMIC_ACQUIRE, "agent");
            if (lane == 0) flag[0] = dead ? 1u : 0u;
        }
        asm volatile("s_waitcnt vmcnt(0) lgkmcnt(0)" ::: "memory"); __builtin_amdgcn_s_barrier(); asm volatile("" ::: "memory");
        const bool bad = flag[0] != 0u;
        if (lane < 32) {
            const unsigned long long* slot = (const unsigned long long*)xbuf + (size_t)(u.pm * BM + row) * 4; float mt[4], m2[4]; float ms = 0.f;
#pragma unroll
            for (int t = 0; t < 4; ++t) { if (t < ntn) { const unsigned long long w = __hip_atomic_load(slot + t, __ATOMIC_RELAXED, __HIP_MEMORY_SCOPE_AGENT); mt[t] = __uint_as_float((unsigned)w); m2[t] = __uint_as_float((unsigned)(w >> 32)); } else { mt[t] = 0.f; m2[t] = 0.f; } ms += mt[t]; }
            const float mean = ms / (float)ntn; float q = 0.f;
#pragma unroll
            for (int t = 0; t < 4; ++t) if (t < ntn) { const float dm = mt[t] - mean; q += m2[t] + 256.0f * dm * dm; }
            S[row] = (f32x2v){mean, 1.0f / sqrtf(q / (256.0f * (float)ntn) + eps)};
        }
        asm volatile("s_waitcnt lgkmcnt(0)" ::: "memory"); __builtin_amdgcn_s_barrier(); asm volatile("" ::: "memory");
        return bad;
    }
};
struct EpiLnRes {
    static constexpr bool PERM = false, AFTER_DRAIN = true;
    const float* base; float* out; int ldc; const float* bias; PanelStats st; unsigned poison;
    __device__ __forceinline__ void fused(f32x4 (&acc)[2][2][4][2], const Unit& u, int wr, int wc, int fr, int fq, PG8_LAS unsigned char* lds, int wid, int lane) const {
        typedef float f32x2v __attribute__((ext_vector_type(2)));
        const PG8_LAS f32x2v* S = (const PG8_LAS f32x2v*)(lds + 8192);
        const int col0 = u.pn * BM + wc * 32 + 4 * fq;
#pragma unroll
        for (int bj = 0; bj < 2; ++bj)
#pragma unroll
            for (int n = 0; n < 2; ++n) { const f32x4 bv = bias ? *(const f32x4*)(bias + col0 + bj * HALF + n * 16) : (f32x4){0.f, 0.f, 0.f, 0.f};
#pragma unroll
                for (int ai = 0; ai < 2; ++ai)
#pragma unroll
                    for (int m = 0; m < 4; ++m) acc[ai][bj][m][n] += bv; }
        f32x4 pre[4][2][2];
#pragma unroll
        for (int m = 0; m < 4; ++m) { const size_t off = (size_t)(u.pm * BM + wr * 64 + m * 16 + fr) * ldc + col0;
#pragma unroll
            for (int bj = 0; bj < 2; ++bj)
#pragma unroll
                for (int n = 0; n < 2; ++n) pre[m][bj][n] = *(const f32x4*)(base + off + bj * HALF + n * 16); }
        const bool bad = st.run(acc, u, wr, wc, fr, fq, lds, wid, lane) || poison != 0u;
        const float qnan = __builtin_nanf("");
#pragma unroll
        for (int ai = 0; ai < 2; ++ai)
#pragma unroll
            for (int m = 0; m < 4; ++m) { const int r = ai * HALF + wr * 64 + m * 16 + fr; const f32x2v sr = S[r]; const size_t off = (size_t)(u.pm * BM + r) * ldc + col0;
#pragma unroll
                for (int bj = 0; bj < 2; ++bj)
#pragma unroll
                    for (int n = 0; n < 2; ++n) { const f32x4 bs = ai == 0 ? pre[m][bj][n] : *(const f32x4*)(base + off + bj * HALF + n * 16); f32x4 o = bs + (acc[ai][bj][m][n] - sr.x) * sr.y;
                        if (bad) o = (f32x4){qnan, qnan, qnan, qnan}; *(f32x4*)(out + off + bj * HALF + n * 16) = o; }
                if (m & 1) asm volatile("" ::: "memory"); }
    }
};
struct EpiLnResLn {
    static constexpr bool PERM = false, AFTER_DRAIN = true;
    const float* base; float* out; bf16_t* xn; int ldc; const float* bias; PanelStats st1, st2; unsigned poison;
    __device__ __forceinline__ void fused(f32x4 (&acc)[2][2][4][2], const Unit& u, int wr, int wc, int fr, int fq, PG8_LAS unsigned char* lds, int wid, int lane) const {
        typedef float f32x2v __attribute__((ext_vector_type(2))); typedef unsigned u32x2v __attribute__((ext_vector_type(2)));
        const PG8_LAS f32x2v* S = (const PG8_LAS f32x2v*)(lds + 8192);
        const int col0 = u.pn * BM + wc * 32 + 4 * fq;
#pragma unroll
        for (int bj = 0; bj < 2; ++bj)
#pragma unroll
            for (int n = 0; n < 2; ++n) { const f32x4 bv = bias ? *(const f32x4*)(bias + col0 + bj * HALF + n * 16) : (f32x4){0.f, 0.f, 0.f, 0.f};
#pragma unroll
                for (int ai = 0; ai < 2; ++ai)
#pragma unroll
                    for (int m = 0; m < 4; ++m) acc[ai][bj][m][n] += bv; }
        bool bad = st1.run(acc, u, wr, wc, fr, fq, lds, wid, lane) || poison != 0u;
        const float qnan = __builtin_nanf("");
#pragma unroll
        for (int ai = 0; ai < 2; ++ai)
#pragma unroll
            for (int m = 0; m < 4; ++m) { const int r = ai * HALF + wr * 64 + m * 16 + fr; const f32x2v sr = S[r]; const size_t off = (size_t)(u.pm * BM + r) * ldc + col0;
#pragma unroll
                for (int bj = 0; bj < 2; ++bj)
#pragma unroll
                    for (int n = 0; n < 2; ++n) { const f32x4 bs = *(const f32x4*)(base + off + bj * HALF + n * 16); acc[ai][bj][m][n] = bs + (acc[ai][bj][m][n] - sr.x) * sr.y; }
                asm volatile("" : "+v"(acc[ai][0][m][0]), "+v"(acc[ai][0][m][1]), "+v"(acc[ai][1][m][0]), "+v"(acc[ai][1][m][1]));
                if (m & 1) asm volatile("" ::: "memory"); }
        const bool bad1 = bad;
        bad = st2.run(acc, u, wr, wc, fr, fq, lds, wid, lane) || bad;
#pragma unroll
        for (int ai = 0; ai < 2; ++ai)
#pragma unroll
            for (int m = 0; m < 4; ++m) { const int r = ai * HALF + wr * 64 + m * 16 + fr; const f32x2v sr = S[r]; const size_t off = (size_t)(u.pm * BM + r) * ldc + col0;
#pragma unroll
                for (int bj = 0; bj < 2; ++bj)
#pragma unroll
                    for (int n = 0; n < 2; ++n) { const f32x4 x1 = acc[ai][bj][m][n]; *(f32x4*)(out + off + bj * HALF + n * 16) = bad1 ? (f32x4){qnan, qnan, qnan, qnan} : x1;
                        const f32x4 o = (x1 - sr.x) * sr.y; u32x2v w; w.x = cvt_pk_bf16(o[0], o[1]); w.y = cvt_pk_bf16(o[2], o[3]);
                        if (bad) { w.x = 0x7fc07fc0u; w.y = 0x7fc07fc0u; } *(u32x2v*)(xn + off + bj * HALF + n * 16) = w; }
                asm volatile("" ::: "memory"); }
    }
};

template <class Epi, class Sched, bool ALIGN_EPI = false, bool SP2 = false>
__device__ __forceinline__ void gemm_phase(PG8_LAS unsigned char* lds, const Gemm g, const Sched& S, const Epi& E) {
    int tid_ = threadIdx.x; asm volatile("" : "+v"(tid_)); const int tid = tid_, wid = __builtin_amdgcn_readfirstlane(tid >> 6), lane = tid & 63, wr = wid >> 2, wc = wid & 3, fr = lane & 15, fq = lane >> 4;
    const int K = g.K, nt = K / BK;
    unsigned voffA[2], voffB[2];
#pragma unroll
    for (int i = 0; i < 2; ++i) { int R, C; stage_rc(tid * 16 + i * 8192, R, C); const int Rb = Epi::PERM ? ((R & ~31) + perm32(R & 31)) : R;
        voffA[i] = (unsigned)(R * K + C) * 2u; voffB[i] = (unsigned)(Rb * K + C) * 2u; }
    const size_t kstep = (size_t)(BK * 2);
    const size_t hstep = (size_t)HALF * K * 2;
    const size_t tstep = 2 * hstep;
    const unsigned ldsw = (unsigned)wid * 1024u;
    const int aoff = lds_byte(wr * 64 + fr, fq * 8), boff = lds_byte(wc * 32 + fr, fq * 8);
#define PG8_SA(b, h) (((b) * 2 + (h)) * HTB)
#define PG8_SB(b, h) ((4 + (b) * 2 + (h)) * HTB)
#define PG8_STAGE_X(bufoff, gbase, voff, aux) do { _Pragma("unroll") for (int _i = 0; _i < 2; ++_i) \
        __builtin_amdgcn_global_load_lds((const unsigned*)((const char*)(gbase) + (voff)[_i]), (PG8_LAS unsigned*)(lds + (bufoff) + ldsw + _i * 8192), 16, 0, aux); } while (0)
#define PG8_STAGE(bufoff, gbase, voff) PG8_STAGE_X(bufoff, gbase, voff, 0)
#define PG8_STAGE_A(bufoff, gbase, voff) PG8_STAGE_X(bufoff, gbase, voff, PG8_A_AUX)
#define PG8_LDA(dst, b, h) do { _Pragma("unroll") for (int m = 0; m < 4; ++m) _Pragma("unroll") for (int k = 0; k < 2; ++k) dst[m][k] = *(const PG8_LAS bf16x8*)(lds + PG8_SA(b, h) + aoff + m * 2048 + k * 1024); } while (0)
#define PG8_LDB(dst, b, h) do { _Pragma("unroll") for (int n = 0; n < 2; ++n) _Pragma("unroll") for (int k = 0; k < 2; ++k) dst[n][k] = *(const PG8_LAS bf16x8*)(lds + PG8_SB(b, h) + boff + n * 2048 + k * 1024); } while (0)
#define PG8_MMA(ai, bj, At, Bt) do { __builtin_amdgcn_s_setprio(1); _Pragma("unroll") for (int m = 0; m < 4; ++m) _Pragma("unroll") for (int n = 0; n < 2; ++n) _Pragma("unroll") for (int k = 0; k < 2; ++k) \
        acc[ai][bj][m][n] = __builtin_amdgcn_mfma_f32_16x16x32_bf16(Bt[n][k], At[m][k], acc[ai][bj][m][n], 0, 0, 0); __builtin_amdgcn_s_setprio(0); } while (0)
#define PG8_WAIT_V(n) asm volatile("s_waitcnt vmcnt(" #n ")" ::: "memory")
#define PG8_WAIT_L(n) asm volatile("s_waitcnt lgkmcnt(" #n ")" ::: "memory")
#define PG8_BAR __builtin_amdgcn_s_barrier()
#define PG8_SCHED __builtin_amdgcn_sched_barrier(0)
    Unit cur, nxt; int ui = 0;
    if (!S.next(0, cur)) return;
    f32x4 acc[2][2][4][2];
#pragma unroll
    for (int a = 0; a < 2; ++a)
#pragma unroll
        for (int b = 0; b < 2; ++b)
#pragma unroll
            for (int m = 0; m < 4; ++m)
#pragma unroll
                for (int n = 0; n < 2; ++n) acc[a][b][m][n] = (f32x4){0.f, 0.f, 0.f, 0.f};
    bf16x8 At[4][2], B0[2][2], B1[2][2];
    const char* cA = (const char*)g.A + (size_t)cur.pm * tstep; const char* cB = (const char*)g.Bt + (size_t)cur.pn * tstep;
    S.a_ready(cur);
    if constexpr (SP2) {
        PG8_STAGE(PG8_SB(0, 0), cB, voffB); PG8_STAGE(PG8_SB(0, 1), cB + hstep, voffB); PG8_STAGE_A(PG8_SA(0, 0), cA, voffA); PG8_STAGE_A(PG8_SA(0, 1), cA + hstep, voffA);
        if (wr == 1) PG8_BAR;
        PG8_WAIT_V(2); PG8_BAR;
        PG8_STAGE(PG8_SB(1, 0), cB + kstep, voffB); PG8_STAGE_A(PG8_SA(1, 0), cA + kstep, voffA); PG8_STAGE(PG8_SB(1, 1), cB + hstep + kstep, voffB);
        PG8_WAIT_V(6); PG8_BAR;
    } else {
        PG8_STAGE(PG8_SB(0, 0), cB, voffB); PG8_STAGE_A(PG8_SA(0, 0), cA, voffA); PG8_STAGE(PG8_SB(0, 1), cB + hstep, voffB); PG8_STAGE_A(PG8_SA(0, 1), cA + hstep, voffA);
        if (wr == 1) PG8_BAR;
        PG8_WAIT_V(4); PG8_BAR;
        PG8_STAGE(PG8_SB(1, 0), cB + kstep, voffB); PG8_STAGE_A(PG8_SA(1, 0), cA + kstep, voffA); PG8_STAGE(PG8_SB(1, 1), cB + hstep + kstep, voffB);
        PG8_WAIT_V(6); PG8_BAR;
    }
    for (;;) {
        const bool has_next = S.next(ui + 1, nxt);
        const char* nA = has_next ? (const char*)g.A + (size_t)nxt.pm * tstep : cA; const char* nB = has_next ? (const char*)g.Bt + (size_t)nxt.pn * tstep : cB;
        for (int t = 0; t < nt; t += 2) {
            const bool last = (t == nt - 2);
            const char* a1 = cA + (size_t)(t + 1) * kstep;
            const char* a2 = last ? nA : cA + (size_t)(t + 2) * kstep; const char* b2 = last ? nB : cB + (size_t)(t + 2) * kstep;
            const char* a3 = a2 + kstep; const char* b3 = b2 + kstep;
            if (last && has_next) S.a_ready(nxt);
            if constexpr (SP2) {
            PG8_LDB(B0, 0, 0); PG8_LDB(B1, 0, 1); PG8_SCHED; PG8_LDA(At, 0, 0); PG8_STAGE_A(PG8_SA(1, 1), a1 + hstep, voffA);
            PG8_WAIT_V(8); PG8_WAIT_L(0); PG8_BAR; PG8_MMA(0, 0, At, B0); PG8_MMA(0, 1, At, B1); PG8_BAR; PG8_SCHED;
            PG8_LDA(At, 0, 1); PG8_STAGE(PG8_SB(0, 0), b2, voffB); PG8_STAGE(PG8_SB(0, 1), b2 + hstep, voffB); PG8_STAGE_A(PG8_SA(0, 0), a2, voffA);
            PG8_WAIT_V(8); PG8_WAIT_L(0); PG8_BAR; PG8_MMA(1, 0, At, B0); PG8_MMA(1, 1, At, B1); PG8_BAR; PG8_SCHED;
            PG8_LDB(B0, 1, 0); PG8_LDB(B1, 1, 1); PG8_SCHED; PG8_LDA(At, 1, 0); PG8_STAGE_A(PG8_SA(0, 1), a2 + hstep, voffA);
            PG8_WAIT_V(8); PG8_WAIT_L(0); PG8_BAR; PG8_MMA(0, 0, At, B0); PG8_MMA(0, 1, At, B1); PG8_BAR; PG8_SCHED;
            PG8_LDA(At, 1, 1); PG8_STAGE(PG8_SB(1, 0), b3, voffB); PG8_STAGE(PG8_SB(1, 1), b3 + hstep, voffB); PG8_STAGE_A(PG8_SA(1, 0), a3, voffA);
            PG8_WAIT_V(8); PG8_WAIT_L(0); PG8_BAR; PG8_MMA(1, 0, At, B0); PG8_MMA(1, 1, At, B1); PG8_BAR; PG8_SCHED;
            } else {
            PG8_LDB(B0, 0, 0); PG8_SCHED; PG8_LDA(At, 0, 0); PG8_STAGE_A(PG8_SA(1, 1), a1 + hstep, voffA);
            PG8_WAIT_L(8); PG8_BAR; PG8_WAIT_L(0); PG8_MMA(0, 0, At, B0); PG8_BAR; PG8_SCHED;
            PG8_LDB(B1, 0, 1); PG8_STAGE(PG8_SB(0, 0), b2, voffB);
            PG8_BAR; PG8_WAIT_L(0); PG8_MMA(0, 1, At, B1); PG8_BAR;
            PG8_LDA(At, 0, 1); PG8_STAGE_A(PG8_SA(0, 0), a2, voffA);
            PG8_BAR; PG8_WAIT_L(0); PG8_MMA(1, 0, At, B0); PG8_BAR; PG8_SCHED;
            PG8_STAGE(PG8_SB(0, 1), b2 + hstep, voffB);
            PG8_WAIT_V(6); PG8_BAR; PG8_MMA(1, 1, At, B1); PG8_BAR;
            PG8_LDB(B0, 1, 0); PG8_SCHED; PG8_LDA(At, 1, 0); PG8_STAGE_A(PG8_SA(0, 1), a2 + hstep, voffA);
            PG8_WAIT_L(8); PG8_BAR; PG8_WAIT_L(0); PG8_MMA(0, 0, At, B0); PG8_BAR; PG8_SCHED;
            PG8_LDB(B1, 1, 1); PG8_STAGE(PG8_SB(1, 0), b3, voffB);
            PG8_BAR; PG8_WAIT_L(0); PG8_MMA(0, 1, At, B1); PG8_BAR;
            PG8_LDA(At, 1, 1); PG8_STAGE_A(PG8_SA(1, 0), a3, voffA);
            PG8_BAR; PG8_WAIT_L(0); PG8_MMA(1, 0, At, B0); PG8_BAR; PG8_SCHED;
            PG8_STAGE(PG8_SB(1, 1), b3 + hstep, voffB);
            PG8_WAIT_V(6); PG8_BAR; PG8_MMA(1, 1, At, B1); PG8_BAR;
            }
        }
        if constexpr (ALIGN_EPI) { if (wr == 0) PG8_BAR; }
        if constexpr (!Epi::AFTER_DRAIN) { E(acc, cur, wr, wc, fr, fq); S.done(cur); }
        if (!has_next) break;
#pragma unroll
        for (int a = 0; a < 2; ++a)
#pragma unroll
            for (int b = 0; b < 2; ++b)
#pragma unroll
                for (int m = 0; m < 4; ++m)
#pragma unroll
                    for (int n = 0; n < 2; ++n) acc[a][b][m][n] = (f32x4){0.f, 0.f, 0.f, 0.f};
        cur = nxt; cA = nA; cB = nB; ++ui;
        if constexpr (ALIGN_EPI) { if (wr == 1) PG8_BAR; }
    }
    PG8_WAIT_V(0);
    if constexpr (!ALIGN_EPI) { if (wr == 0) PG8_BAR; }
    PG8_BAR;
    if constexpr (Epi::AFTER_DRAIN) { E.fused(acc, cur, wr, wc, fr, fq, lds, wid, lane); S.done(cur); }
#undef PG8_SA
#undef PG8_SB
#undef PG8_STAGE
#undef PG8_STAGE_A
#undef PG8_STAGE_X
#undef PG8_LDA
#undef PG8_LDB
#undef PG8_MMA
#undef PG8_WAIT_V
#undef PG8_WAIT_L
#undef PG8_BAR
#undef PG8_SCHED
}
}

#ifndef SCALE_MIX
#define SCALE_MIX 1.0f
#endif
#ifndef SCALE_FFN
#define SCALE_FFN 1.0f
#endif
namespace mk {
#ifdef ZERO_SSD
constexpr float ZS = 0.f;
#elif defined(SC_SSD)
constexpr float ZS = SC_SSD;
#else
constexpr float ZS = 1.f;
#endif
#ifdef ZERO_FOX
constexpr float ZF = 0.f;
#elif defined(SC_FOX)
constexpr float ZF = SC_FOX;
#else
constexpr float ZF = 1.f;
#endif
#ifdef ZERO_SC
constexpr float ZC = 0.f;
#elif defined(SC_SC)
constexpr float ZC = SC_SC;
#else
constexpr float ZC = 1.f;
#endif
using pg8::bf16_t; using pg8::bf16x8; using pg8::f32x4; using pg8::u32x4;
typedef unsigned u32x2 __attribute__((ext_vector_type(2)));
constexpr int DM = 1024, BATCH = 4, SEQ = 4096, MROWS = BATCH * SEQ, DFF = 2816, NFF = 2 * DFF, NPROJ = 3072, NMOD = 9216;
constexpr int NT = 512, NW = 8;
constexpr float ALPHA = 1.4142135623730951f, LN_EPS = 1e-5f, RMS_EPS = 1e-5f, LOG2E = 1.4426950408889634f;
constexpr int PC_Z = 0, PC_XBC = 512, PC_Q = 1536, PC_K = 1792, PC_V = 2048, PC_SB = 2304, PC_SC = 2560, PC_SX = 2816;
constexpr size_t MiB = 1u << 20;
constexpr size_t WS_MOD = 0, WS_WMISC = 1 * MiB, WS_DTF = 2 * MiB, WS_CDEC = 3 * MiB, WS_BAR = 3 * MiB + 512 * 1024, WS_W = 4 * MiB;
constexpr size_t W_L = 41 * MiB;
constexpr size_t WO_1IN = 0, WO_1OUT = 11 * MiB, WO_MI = 11 * MiB + 5632 * 1024, WO_MO = WO_MI + 6 * MiB, WO_2IN = WO_MO + 2 * MiB, WO_2OUT = WO_2IN + 11 * MiB;
static_assert(WO_2OUT + 5632 * 1024 == W_L, "weight map");
constexpr size_t WS_HB = WS_W + 2 * W_L;
constexpr size_t WS_BIG = WS_HB + 32 * MiB;
constexpr size_t WS_YCAT = WS_BIG + 96 * MiB;
constexpr size_t WS_ST = WS_YCAT + 32 * MiB;
constexpr size_t WS_END = WS_ST + 32 * MiB;
constexpr int LDS_BYTES = 147456;

struct Args { const float* in[22]; float* out; unsigned char* ws; };
typedef const __attribute__((address_space(4))) Args* CArgsP;
__device__ __forceinline__ CArgsP get_args() { CArgsP p = (CArgsP)__builtin_amdgcn_kernarg_segment_ptr(); asm volatile("" : "+s"(p)); return p; }

typedef float f32x2_t __attribute__((ext_vector_type(2))); typedef __bf16 bf16x2_t __attribute__((ext_vector_type(2)));
__device__ __forceinline__ float bf_lo(unsigned w) { return __uint_as_float(w << 16); }
__device__ __forceinline__ float bf_hi(unsigned w) { return __uint_as_float(w & 0xffff0000u); }
__device__ __forceinline__ float bf2f(bf16_t v) { return __uint_as_float((unsigned)v << 16); }
#ifdef DEGRADE_BF16
__device__ __forceinline__ unsigned pk2(float lo, float hi) { return DEGRADE_OP(pg8::cvt_pk_bf16(lo, hi)); }
#elif defined(MANUAL_RNE)
__device__ __forceinline__ unsigned f2bf_rne_(float f) { unsigned u = __builtin_bit_cast(unsigned, f); return (u + 0x7fffu + ((u >> 16) & 1u)) >> 16; }
__device__ __forceinline__ unsigned pk2(float lo, float hi) { return f2bf_rne_(lo) | (f2bf_rne_(hi) << 16); }
#else
__device__ __forceinline__ unsigned pk2(float lo, float hi) { return pg8::cvt_pk_bf16(lo, hi); }
#endif
#ifdef DEGRADE_W
__device__ __forceinline__ unsigned pk2w(float lo, float hi) { return pg8::cvt_pk_bf16(lo, hi) & 0xFFFEFFFEu; }
#else
__device__ __forceinline__ unsigned pk2w(float lo, float hi) { return pg8::cvt_pk_bf16(lo, hi); }
#endif
__device__ __forceinline__ bf16_t f2bf(float f) { return (bf16_t)(pk2(f, 0.f) & 0xffffu); }
#ifndef DEG_SITES
#define DEG_SITES 0
#endif
template <int S> __device__ __forceinline__ unsigned pk2t(float lo, float hi) { unsigned r; if constexpr (S >= 2) { f32x2_t v_ = {lo, hi}; r = __builtin_bit_cast(unsigned, __builtin_convertvector(v_, bf16x2_t)); } else r = pg8::cvt_pk_bf16(lo, hi); if ((DEG_SITES >> S) & 1) r &= 0xFFFEFFFEu; return r; }
template <int S> __device__ __forceinline__ bf16_t f2bft(float f) { return (bf16_t)(pk2t<S>(f, 0.f) & 0xffffu); }
__device__ __forceinline__ float siluf(float v) { return v * __builtin_amdgcn_rcpf(1.f + __builtin_amdgcn_exp2f(-v * LOG2E)); }
__device__ __forceinline__ float wave_sum(float v) {
#pragma unroll
    for (int o = 1; o < 64; o <<= 1) v += __shfl_xor(v, o);
    return v;
}
__device__ __forceinline__ float wave_incl_scan(float v, int lane) {
#pragma unroll
    for (int o = 1; o < 64; o <<= 1) { const float t = __shfl_up(v, o); if (lane >= o) v += t; }
    return v;
}
__device__ __forceinline__ void unpack8(const u32x4 r, float (&f)[8]) {
    f[0] = bf_lo(r.x); f[1] = bf_hi(r.x); f[2] = bf_lo(r.y); f[3] = bf_hi(r.y); f[4] = bf_lo(r.z); f[5] = bf_hi(r.z); f[6] = bf_lo(r.w); f[7] = bf_hi(r.w);
}
template <class T> __device__ __forceinline__ T ldx(const T* p) {
    if constexpr (sizeof(T) == 16) { const unsigned long long* q = (const unsigned long long*)p; struct { unsigned long long a, b; } r;
        r.a = __hip_atomic_load(q, __ATOMIC_RELAXED, __HIP_MEMORY_SCOPE_AGENT); r.b = __hip_atomic_load(q + 1, __ATOMIC_RELAXED, __HIP_MEMORY_SCOPE_AGENT); return __builtin_bit_cast(T, r); }
    else if constexpr (sizeof(T) == 4) { const unsigned v = __hip_atomic_load((const unsigned*)p, __ATOMIC_RELAXED, __HIP_MEMORY_SCOPE_AGENT); return __builtin_bit_cast(T, v); }
    else { static_assert(sizeof(T) == 2, "ldx"); const unsigned short v = __hip_atomic_load((const unsigned short*)p, __ATOMIC_RELAXED, __HIP_MEMORY_SCOPE_AGENT); return __builtin_bit_cast(T, v); }
}
#define LDS_WAIT() asm volatile("s_waitcnt lgkmcnt(0)" ::: "memory")

__device__ __forceinline__ int srcmap(int mode, int r0) {
    if (mode == 1) { const int pn = r0 >> 8, j = r0 & 255; return j < 128 ? pn * 128 + j : DFF + pn * 128 + (j - 128); }
    if (mode == 2) { return r0 < 1536 ? r0 : (r0 < 2304 ? r0 + 8 : r0 + 12); }
    return r0;
}
__device__ __forceinline__ void p0_item(const float* __restrict__ W, int K, int Nsrc, int Ndst, bf16_t* __restrict__ WT, int mode, float* scr, int item, int lane) {
    const int nblk = Ndst / 32, kb = item / nblk, nb = item % nblk, k0 = 64 * kb, r0 = 32 * nb, s0 = srcmap(mode, r0);
#pragma unroll 8
    for (int i = 0; i < 32; ++i) { const int kk = 2 * i + (lane >> 5); scr[kk * 33 + (lane & 31)] = W[(size_t)(k0 + kk) * Nsrc + s0 + (lane & 31)]; }
    LDS_WAIT();
    const int c = lane & 7;
#pragma unroll
    for (int j = 0; j < 4; ++j) { const int n = (lane >> 3) + 8 * j; const float* s = scr + (8 * c) * 33 + n;
        u32x4 o; o.x = pk2w(s[0 * 33], s[1 * 33]); o.y = pk2w(s[2 * 33], s[3 * 33]); o.z = pk2w(s[4 * 33], s[5 * 33]); o.w = pk2w(s[6 * 33], s[7 * 33]);
        *(u32x4*)(WT + (size_t)(r0 + n) * K + k0 + 8 * c) = o; }
    LDS_WAIT();
}
__device__ __forceinline__ void phase_p0(CArgsP a, unsigned char* lds, int tid, int wave, int lane) {
    float* mod = (float*)(a->ws + WS_MOD);
    float* sc = (float*)(lds + 69632);
    float* red = (float*)(lds + 69632 + 16384);
    for (int i = tid; i < 4096; i += NT) { const float v = a->in[1][i]; sc[i] = v / (1.f + expf(-v)); }
    __syncthreads();
    for (int it = blockIdx.x; it < 288; it += gridDim.x) {
        const int l = it / 144, cgp = it % 144, col = cgp * 64 + lane, k0 = wave * 128;
        const float* Wp = a->in[4] + (size_t)l * DM * NMOD + (size_t)k0 * NMOD + col;
        float a0 = 0.f, a1 = 0.f, a2 = 0.f, a3 = 0.f;
#pragma unroll 16
        for (int k = 0; k < 128; ++k) { const float w = Wp[(size_t)k * NMOD];
            a0 += sc[k0 + k] * w; a1 += sc[1024 + k0 + k] * w; a2 += sc[2048 + k0 + k] * w; a3 += sc[3072 + k0 + k] * w; }
        red[(wave * 4 + 0) * 64 + lane] = a0; red[(wave * 4 + 1) * 64 + lane] = a1; red[(wave * 4 + 2) * 64 + lane] = a2; red[(wave * 4 + 3) * 64 + lane] = a3;
        __syncthreads();
        if (tid < 256) { const int b = tid >> 6, ln = tid & 63; float s = 0.f;
#pragma unroll
            for (int w = 0; w < 8; ++w) s += red[(w * 4 + b) * 64 + ln];
            mod[(size_t)(l * 4 + b) * NMOD + cgp * 64 + ln] = s + a->in[5][l * NMOD + cgp * 64 + ln]; }
        __syncthreads();
    }
    { float* wm = (float*)(a->ws + WS_WMISC);
      for (int i = blockIdx.x * NT + tid; i < 2 * 12 * 1024; i += gridDim.x * NT) { const int l = i / 12288, r = i % 12288, j = r / 1024, k = r % 1024;
          const int colj = j < 8 ? 1536 + j : 2312 + (j - 8); wm[i] = a->in[8][(size_t)l * DM * 3084 + (size_t)k * 3084 + colj]; } }
    float* scr = (float*)(lds + wave * 8448);
    const int gw = blockIdx.x * NW + wave, NGW = gridDim.x * NW;
    constexpr int I_IN = 16 * (NFF / 32), I_OUT = (DFF / 64) * 32, I_MI = 16 * (NPROJ / 32), I_MO = 16 * 32, I_L = 2 * I_IN + 2 * I_OUT + I_MI + I_MO;
    for (int it = gw; it < 2 * I_L; it += NGW) {
        const int l = it / I_L; int r = it % I_L; unsigned char* wl = a->ws + WS_W + l * W_L;
        if (r < I_IN) { p0_item(a->in[6] + (size_t)l * DM * NFF, DM, NFF, NFF, (bf16_t*)(wl + WO_1IN), 1, scr, r, lane); continue; } r -= I_IN;
        if (r < I_IN) { p0_item(a->in[18] + (size_t)l * DM * NFF, DM, NFF, NFF, (bf16_t*)(wl + WO_2IN), 1, scr, r, lane); continue; } r -= I_IN;
        if (r < I_OUT) { p0_item(a->in[7] + (size_t)l * DFF * DM, DFF, DM, DM, (bf16_t*)(wl + WO_1OUT), 0, scr, r, lane); continue; } r -= I_OUT;
        if (r < I_OUT) { p0_item(a->in[19] + (size_t)l * DFF * DM, DFF, DM, DM, (bf16_t*)(wl + WO_2OUT), 0, scr, r, lane); continue; } r -= I_OUT;
        if (r < I_MI) { p0_item(a->in[8] + (size_t)l * DM * 3084, DM, 3084, NPROJ, (bf16_t*)(wl + WO_MI), 2, scr, r, lane); continue; } r -= I_MI;
        p0_item(a->in[9] + (size_t)l * DM * DM, DM, DM, DM, (bf16_t*)(wl + WO_MO), 0, scr, r, lane);
    }
}

template <bool MISC>
__device__ __forceinline__ void phase_ln(const float* src, float* X, bf16_t* Hb, const float* gamma, const float* beta, const float* modl, int sub, bool write_h,
                                         const float* wm, float* DTF, unsigned char* lds, int tid, int wave, int lane) {
    float* wml = (float*)lds;
    if (MISC) { for (int i = tid; i < 12288; i += NT) wml[i] = wm[i]; __syncthreads(); }
    const int gw = blockIdx.x * NW + wave, NGW = gridDim.x * NW;
    f32x4 g4[4], b4[4];
#pragma unroll
    for (int j = 0; j < 4; ++j) { g4[j] = *(const f32x4*)(gamma + 4 * lane + 256 * j); b4[j] = *(const f32x4*)(beta + 4 * lane + 256 * j); }
    for (int blk = gw; blk < MROWS / 8; blk += NGW) {
        const int m0 = blk * 8, b = m0 / SEQ;
        const float* shp = modl + (size_t)b * NMOD + (sub * 3 + 0) * DM; const float* scp = modl + (size_t)b * NMOD + (sub * 3 + 1) * DM;
        f32x4 sh4[4], sc4[4];
#pragma unroll
        for (int j = 0; j < 4; ++j) { if (write_h) { sh4[j] = *(const f32x4*)(shp + 4 * lane + 256 * j); sc4[j] = *(const f32x4*)(scp + 4 * lane + 256 * j) + 1.0f; } else { sh4[j] = (f32x4){0.f, 0.f, 0.f, 0.f}; sc4[j] = sh4[j]; } }
        for (int i = 0; i < 8; ++i) {
            const size_t m = (size_t)(m0 + i);
            f32x4 v[4]; float s = 0.f;
#pragma unroll
            for (int j = 0; j < 4; ++j) { v[j] = ldx((const f32x4*)(src + m * DM + 4 * lane + 256 * j)); s += (v[j].x + v[j].y) + (v[j].z + v[j].w); }
            const float mean = wave_sum(s) * (1.f / DM); float s2 = 0.f;
#pragma unroll
            for (int j = 0; j < 4; ++j) { v[j] = v[j] - mean; s2 += (v[j].x * v[j].x + v[j].y * v[j].y) + (v[j].z * v[j].z + v[j].w * v[j].w); }
            const float rstd = 1.f / sqrtf(wave_sum(s2) * (1.f / DM) + LN_EPS);
#pragma unroll
            for (int j = 0; j < 4; ++j) { v[j] = v[j] * rstd * g4[j] + b4[j]; *(f32x4*)(X + m * DM + 4 * lane + 256 * j) = v[j]; }
            if (write_h) {
#pragma unroll
                for (int j = 0; j < 4; ++j) { v[j] = v[j] * sc4[j] + sh4[j]; u32x2 w; w.x = pk2t<0>(v[j].x, v[j].y); w.y = pk2t<0>(v[j].z, v[j].w); *(u32x2*)(Hb + m * DM + 4 * lane + 256 * j) = w; }
                if (MISC) {
                    float keep = 0.f;
#pragma unroll
                    for (int jj = 0; jj < 12; ++jj) { float d = 0.f;
#pragma unroll
                        for (int j = 0; j < 4; ++j) { const f32x4 w4 = *(const f32x4*)(wml + jj * 1024 + 4 * lane + 256 * j); d += (v[j].x * w4.x + v[j].y * w4.y) + (v[j].z * w4.z + v[j].w * w4.w); }
                        d = wave_sum(d); if (lane == jj) keep = d; }
                    if (lane < 12) DTF[m * 12 + lane] = keep;
                }
            }
        }
    }
}

struct EpiMulti {
    static constexpr bool PERM = true, AFTER_DRAIN = false;
    int code;
    __device__ __forceinline__ void operator()(const f32x4 (&acc)[2][2][4][2], const pg8::Unit& u, int wr, int wc, int fr, int fq) const {
        CArgsP a = get_args(); int cd = code; asm volatile("" : "+s"(cd)); const int s = cd & 255, l = cd >> 8;
        unsigned char* ws = a->ws;
        if (s == 0 || s == 9) {
            bf16_t* O = (bf16_t*)(ws + WS_BIG);
            const int row0 = u.pm * 256 + wr * 64 + fr, col0 = u.pn * 128 + wc * 32 + 8 * fq;
#pragma unroll
            for (int ai = 0; ai < 2; ++ai)
#pragma unroll
                for (int m = 0; m < 4; ++m) {
                    const f32x4 g0 = acc[ai][0][m][0], g1 = acc[ai][0][m][1], u0 = acc[ai][1][m][0], u1 = acc[ai][1][m][1];
                    u32x4 w;
                    w.x = pk2t<1>(siluf(g0[0]) * u0[0], siluf(g0[1]) * u0[1]); w.y = pk2t<1>(siluf(g0[2]) * u0[2], siluf(g0[3]) * u0[3]);
                    w.z = pk2t<1>(siluf(g1[0]) * u1[0], siluf(g1[1]) * u1[1]); w.w = pk2t<1>(siluf(g1[2]) * u1[2], siluf(g1[3]) * u1[3]);
                    *(u32x4*)(O + (size_t)(row0 + ai * 128 + m * 16) * DFF + col0) = w;
                }
        } else if (s == 3) {
            bf16_t* O = (bf16_t*)(ws + WS_BIG);
            const int row0 = u.pm * 256 + wr * 64 + fr, col0 = u.pn * 256 + wc * 32 + 8 * fq;
#pragma unroll
            for (int ai = 0; ai < 2; ++ai)
#pragma unroll
                for (int m = 0; m < 4; ++m)
#pragma unroll
                    for (int bj = 0; bj < 2; ++bj) { const f32x4 v0 = acc[ai][bj][m][0], v1 = acc[ai][bj][m][1];
                        u32x4 w; w.x = pk2t<1>(v0[0], v0[1]); w.y = pk2t<1>(v0[2], v0[3]); w.z = pk2t<1>(v1[0], v1[1]); w.w = pk2t<1>(v1[2], v1[3]);
                        *(u32x4*)(O + (size_t)(row0 + ai * 128 + m * 16) * NPROJ + col0 + bj * 128) = w; }
        } else {
            const int sub = s == 1 ? 0 : (s == 7 ? 1 : 2);
#ifdef ZERO_FFN
            const float coef = s == 7 ? 1.0f : 0.0f;
#elif defined(ZERO_MIX)
            const float coef = s == 7 ? 0.0f : 0.5f;
#else
            const float coef = s == 7 ? 1.0f * SCALE_MIX : 0.5f * SCALE_FFN;
#endif
            float* X = a->out; const float* gate = (const float*)(ws + WS_MOD) + (size_t)l * 4 * NMOD + (sub * 3 + 2) * DM;
            const int b = u.pm >> 4, col0 = u.pn * 256 + wc * 32 + 8 * fq;
#pragma unroll
            for (int bj = 0; bj < 2; ++bj)
#pragma unroll
                for (int n = 0; n < 2; ++n) {
                    const int c = col0 + bj * 128 + n * 4;
                    const f32x4 gv = *(const f32x4*)(gate + (size_t)b * NMOD + c) * coef;
#pragma unroll
                    for (int ai = 0; ai < 2; ++ai)
#pragma unroll
                        for (int m = 0; m < 4; ++m) { float* p = X + (size_t)(u.pm * 256 + ai * 128 + wr * 64 + m * 16 + fr) * DM + c;
                            const f32x4 xv = ldx((const f32x4*)p);
#ifdef SKIP_T
                            const int rr_ = (u.pm * 256 + ai * 128 + wr * 64 + m * 16 + fr) & 4095; const float km_ = (s == 7 && rr_ >= SKIP_T0 && rr_ < SKIP_T) ? 0.f : 1.f;
                            *(f32x4*)p = xv * ALPHA + gv * acc[ai][bj][m][n] * km_; }
#else
                            *(f32x4*)p = xv * ALPHA + gv * acc[ai][bj][m][n]; }
#endif
                }
        }
    }
};

__device__ __forceinline__ void ssd_dt_acs(const float* DTF, const float* dt_bias, const float* a_log, int R0, int g, int wave, int lane, float* sDt, float* sAcs) {
    if (wave < 4) { const int h = g * 4 + wave; const float x = ldx(DTF + (size_t)(R0 + lane) * 12 + h) + dt_bias[h];
        const float dt = x > 20.f ? x : log1pf(expf(x)); const float av = -expf(a_log[h]) * dt; const float cs = wave_incl_scan(av, lane);
        sDt[wave * 64 + lane] = dt; sAcs[wave * 64 + lane] = cs; }
}
__device__ __forceinline__ void conv8(const bf16_t* PROJ, int b, int t, int cc, const float* cw, const float* cb, float (&o)[8]) {
    { const f32x4 b0 = *(const f32x4*)(cb + cc), b1 = *(const f32x4*)(cb + cc + 4); o[0] = b0.x; o[1] = b0.y; o[2] = b0.z; o[3] = b0.w; o[4] = b1.x; o[5] = b1.y; o[6] = b1.z; o[7] = b1.w; }
#pragma unroll
    for (int k = 0; k < 4; ++k) { const int tt = t - 3 + k;
        if (tt >= 0) { const u32x4 raw = ldx((const u32x4*)(PROJ + (size_t)(b * SEQ + tt) * NPROJ + PC_XBC + cc)); float x[8]; unpack8(raw, x);
            const f32x4 w0 = *(const f32x4*)(cw + k * 1024 + cc), w1 = *(const f32x4*)(cw + k * 1024 + cc + 4);
            o[0] += w0.x * x[0]; o[1] += w0.y * x[1]; o[2] += w0.z * x[2]; o[3] += w0.w * x[3]; o[4] += w1.x * x[4]; o[5] += w1.y * x[5]; o[6] += w1.z * x[6]; o[7] += w1.w * x[7]; } }
#pragma unroll
    for (int j = 0; j < 8; ++j) o[j] = siluf(o[j]);
}

__device__ __forceinline__ void phase_ma(CArgsP a, int l, unsigned char* lds, int tid, int wave, int lane) {
    const bf16_t* PROJ = (const bf16_t*)(a->ws + WS_BIG); bf16_t* YCAT = (bf16_t*)(a->ws + WS_YCAT); bf16_t* ST = (bf16_t*)(a->ws + WS_ST);
    const float* DTF = (const float*)(a->ws + WS_DTF); float* CDEC = (float*)(a->ws + WS_CDEC);
    const float* cw = a->in[10] + (size_t)l * 4 * 1024; const float* cb = a->in[11] + l * 1024; const float* dtb = a->in[12] + l * 8; const float* alog = a->in[13] + l * 8;
    const int fr = lane & 15, fq = lane >> 4;
    bf16_t* sBT = (bf16_t*)lds;
    bf16_t* sXT = (bf16_t*)(lds + 18432);
    float* sDt = (float*)(lds + 18432 + 36864);
    float* sAcs = sDt + 256;
    for (int it = blockIdx.x; it < 512; it += gridDim.x) {
        const int b = it >> 7, c = (it >> 1) & 63, g = it & 1, t0 = c * 64, R0 = b * SEQ + t0;
        ssd_dt_acs(DTF, dtb, alog, R0, g, wave, lane, sDt, sAcs);
        __syncthreads();
        if (wave < 4 && lane == 63) CDEC[(b * 64 + c) * 8 + g * 4 + wave] = expf(sAcs[wave * 64 + 63]);
        for (int o = tid; o < 3072; o += NT) {
            float v[8];
            if (o < 1024) { const int ll = o >> 4, n = (o & 15) * 8; conv8(PROJ, b, t0 + ll, 512 + g * 128 + n, cw, cb, v);
#pragma unroll
                for (int j = 0; j < 8; ++j) sBT[(n + j) * 72 + ll] = f2bft<2>(v[j]); }
            else { const int o2 = o - 1024, ll = o2 >> 5, ch = (o2 & 31) * 8, e = ch >> 6, p = ch & 63; conv8(PROJ, b, t0 + ll, g * 256 + ch, cw, cb, v);
                const float wgt = sDt[e * 64 + ll] * expf(sAcs[e * 64 + 63] - sAcs[e * 64 + ll]);
#pragma unroll
                for (int j = 0; j < 8; ++j) sXT[(e * 64 + p + j) * 72 + ll] = f2bft<2>(v[j] * wgt); }
        }
        __syncthreads();
        { const int e = wave >> 1, nh = wave & 1;
          f32x4 acc[4][4];
#pragma unroll
          for (int i = 0; i < 4; ++i)
#pragma unroll
              for (int j = 0; j < 4; ++j) acc[i][j] = (f32x4){0.f, 0.f, 0.f, 0.f};
#pragma unroll
          for (int kk = 0; kk < 2; ++kk) {
              bf16x8 af[4], bfr[4];
#pragma unroll
              for (int i = 0; i < 4; ++i) af[i] = *(const bf16x8*)(sBT + (nh * 64 + 16 * i + fr) * 72 + 32 * kk + 8 * fq);
#pragma unroll
              for (int j = 0; j < 4; ++j) bfr[j] = *(const bf16x8*)(sXT + (e * 64 + 16 * j + fr) * 72 + 32 * kk + 8 * fq);
#pragma unroll
              for (int i = 0; i < 4; ++i)
#pragma unroll
                  for (int j = 0; j < 4; ++j) acc[i][j] = __builtin_amdgcn_mfma_f32_16x16x32_bf16(af[i], bfr[j], acc[i][j], 0, 0, 0);
          }
          bf16_t* sp = ST + (size_t)((b * 64 + c) * 8 + g * 4 + e) * 8192;
#pragma unroll
          for (int i = 0; i < 4; ++i)
#pragma unroll
              for (int j = 0; j < 4; ++j) { u32x2 w; w.x = pk2t<2>(acc[i][j][0], acc[i][j][1]); w.y = pk2t<2>(acc[i][j][2], acc[i][j][3]);
                  *(u32x2*)(sp + (16 * j + fr) * 128 + nh * 64 + 16 * i + 4 * fq) = w; }
        }
        __syncthreads();
    }
    { const float* sw = a->in[17] + (size_t)l * 3 * 256;
      for (int op = blockIdx.x * NT + tid; op < MROWS * 32; op += gridDim.x * NT) {
          const int m = op >> 5, ch = (op & 31) * 8, t = m & (SEQ - 1);
          float acc[8];
#pragma unroll
          for (int j = 0; j < 8; ++j) acc[j] = 0.f;
#pragma unroll
          for (int k = 0; k < 3; ++k) { const int tt = t - 2 + k;
              if (tt >= 0) { const bf16_t* rp = PROJ + (size_t)(m - 2 + k) * NPROJ; float cg[8], xi[8]; unpack8(ldx((const u32x4*)(rp + PC_SC + ch)), cg); unpack8(ldx((const u32x4*)(rp + PC_SX + ch)), xi);
                  const f32x4 w0 = *(const f32x4*)(sw + k * 256 + ch), w1 = *(const f32x4*)(sw + k * 256 + ch + 4);
                  acc[0] += w0.x * (cg[0] * xi[0]); acc[1] += w0.y * (cg[1] * xi[1]); acc[2] += w0.z * (cg[2] * xi[2]); acc[3] += w0.w * (cg[3] * xi[3]);
                  acc[4] += w1.x * (cg[4] * xi[4]); acc[5] += w1.y * (cg[5] * xi[5]); acc[6] += w1.z * (cg[6] * xi[6]); acc[7] += w1.w * (cg[7] * xi[7]); } }
          float bg[8]; unpack8(ldx((const u32x4*)(PROJ + (size_t)m * NPROJ + PC_SB + ch)), bg);
#pragma unroll
          for (int j = 0; j < 8; ++j) bg[j] *= ZC;
          u32x4 w; w.x = pk2t<6>(bg[0] * acc[0], bg[1] * acc[1]); w.y = pk2t<6>(bg[2] * acc[2], bg[3] * acc[3]); w.z = pk2t<6>(bg[4] * acc[4], bg[5] * acc[5]); w.w = pk2t<6>(bg[6] * acc[6], bg[7] * acc[7]);
          *(u32x4*)(YCAT + (size_t)m * DM + 768 + ch) = w;
      } }
}

__device__ __forceinline__ void phase_mb(CArgsP a, int l, unsigned char* lds, int tid, int wave, int lane) {
    const bf16_t* PROJ = (const bf16_t*)(a->ws + WS_BIG); bf16_t* YCAT = (bf16_t*)(a->ws + WS_YCAT);
    const float* DTF = (const float*)(a->ws + WS_DTF); const float* CDEC = (const float*)(a->ws + WS_CDEC);
    { unsigned* ST = (unsigned*)(a->ws + WS_ST);
      for (int gid = blockIdx.x * NT + tid; gid < 32 * 4096; gid += gridDim.x * NT) {
          const int bh = gid >> 12, rem = gid & 4095, b = bh >> 3, h = bh & 7;
          float r0 = 0.f, r1 = 0.f;
          for (int c0 = 0; c0 < 64; c0 += 8) {
              unsigned w[8]; float d[8];
#pragma unroll
              for (int i = 0; i < 8; ++i) { w[i] = ldx(ST + (size_t)((b * 64 + c0 + i) * 8 + h) * 4096 + rem); d[i] = ldx(CDEC + (b * 64 + c0 + i) * 8 + h); }
#pragma unroll
              for (int i = 0; i < 8; ++i) { ST[(size_t)((b * 64 + c0 + i) * 8 + h) * 4096 + rem] = pk2t<3>(r0, r1); r0 = r0 * d[i] + bf_lo(w[i]); r1 = r1 * d[i] + bf_hi(w[i]); }
          }
      } }
#ifdef NAIVE_ATTN
    { const float* fbias_ = a->in[16] + l * 4;
      for (int row = blockIdx.x * NT + tid; row < 16 * SEQ; row += gridDim.x * NT) {
          const int bh = row >> 12, q = row & 4095, b = bh >> 2, h = bh & 3; const float fb = fbias_[h];
          float qv[64], o[64];
#pragma unroll
          for (int d = 0; d < 64; ++d) { qv[d] = bf2f(ldx(PROJ + (size_t)(b * SEQ + q) * NPROJ + PC_Q + h * 64 + d)); o[d] = 0.f; }
          float m = -INFINITY, lsum = 0.f, bias = 0.f;
          for (int k = q; k >= 0; --k) {
              const bf16_t* kp = PROJ + (size_t)(b * SEQ + k) * NPROJ + PC_K + h * 64;
              float s = 0.f;
#pragma unroll
              for (int d8 = 0; d8 < 8; ++d8) { float kv[8]; unpack8(ldx((const u32x4*)(kp + d8 * 8)), kv);
#pragma unroll
                  for (int j = 0; j < 8; ++j) s += qv[d8 * 8 + j] * kv[j]; }
              s = s * 0.125f + bias;
              const float mn = fmaxf(m, s), al = expf(m - mn), p = expf(s - mn);
              lsum = lsum * al + p; m = mn;
#pragma unroll
              for (int d8 = 0; d8 < 8; ++d8) { float vv[8]; unpack8(ldx((const u32x4*)(kp + (PC_V - PC_K) + d8 * 8)), vv);
#pragma unroll
                  for (int j = 0; j < 8; ++j) o[d8 * 8 + j] = o[d8 * 8 + j] * al + p * vv[j]; }
              const float x = ldx(DTF + (size_t)(b * SEQ + k) * 12 + 8 + h) + fb; bias += fminf(x, 0.f) - log1pf(expf(-fabsf(x)));
          }
          const float inv = 1.f / lsum;
#pragma unroll
          for (int d = 0; d < 64; ++d) YCAT[(size_t)(b * SEQ + q) * DM + 512 + h * 64 + d] = f2bft<4>(o[d] * inv);
      } }
#endif
    const int fr = lane & 15, fq = lane >> 4;
    float* cf2 = (float*)lds;
    bf16_t* sK = (bf16_t*)(lds + 16384);
    bf16_t* sV = (bf16_t*)(lds + 16384 + 18432);
    float* wtot = (float*)(lds + 16384 + 36864);
    const float* fbias = a->in[16] + l * 4;
    constexpr float C2 = 0.125f * LOG2E;
#ifdef NAIVE_ATTN
    for (int v = 256; v < 256; v += gridDim.x) {
#else
    for (int v = blockIdx.x; v < 256; v += gridDim.x) {
#endif
        const int bh = v >> 4, s = v & 15, b = bh >> 2, h = bh & 3;
        __syncthreads();
        { float vals[8]; float run = 0.f; const float fb = fbias[h];
#pragma unroll
          for (int i = 0; i < 8; ++i) { const float x = ldx(DTF + (size_t)(b * SEQ + tid * 8 + i) * 12 + 8 + h) + fb; const float ls = fminf(x, 0.f) - log1pf(expf(-fabsf(x))); run += ls * LOG2E; vals[i] = run; }
          const float inc = wave_incl_scan(run, lane); if (lane == 63) wtot[wave] = inc;
          __syncthreads();
          float off = inc - run; for (int w = 0; w < wave; ++w) off += wtot[w];
#pragma unroll
          for (int i = 0; i < 8; ++i) cf2[tid * 8 + i] = vals[i] + off;
          __syncthreads(); }
        for (int uu = 0; uu < 2; ++uu) {
            const int qb = uu ? 31 - s : s, q0 = qb * 128, nt = 2 * (qb + 1);
            const int qw0 = q0 + wave * 16, qrow = qw0 + fr;
            const bf16_t* qp = PROJ + (size_t)(b * SEQ + qrow) * NPROJ + PC_Q + h * 64 + fq * 8;
            const bf16x8 qf0 = ldx((const bf16x8*)qp), qf1 = ldx((const bf16x8*)(qp + 32));
            const float cfq = cf2[qrow];
            float mrun = -INFINITY, lrun = 0.f; f32x4 o[4];
#pragma unroll
            for (int j = 0; j < 4; ++j) o[j] = (f32x4){0.f, 0.f, 0.f, 0.f};
            const int key = tid >> 3, dch = tid & 7;
            const bf16_t* kp = PROJ + (size_t)(b * SEQ + key) * NPROJ + PC_K + h * 64 + dch * 8;
            u32x4 kreg = ldx((const u32x4*)kp), vreg = ldx((const u32x4*)(kp + (PC_V - PC_K)));
            for (int kt = 0; kt < nt; ++kt) {
                const int buf = kt & 1; bf16_t* sKb = sK + buf * 4608; bf16_t* sVb = sV + buf * 4608;
                *(u32x4*)(sKb + key * 72 + dch * 8) = kreg;
                { bf16_t* vd = sVb + (dch * 8) * 72 + key;
                  vd[0 * 72] = (bf16_t)(vreg.x & 0xffffu); vd[1 * 72] = (bf16_t)(vreg.x >> 16); vd[2 * 72] = (bf16_t)(vreg.y & 0xffffu); vd[3 * 72] = (bf16_t)(vreg.y >> 16);
                  vd[4 * 72] = (bf16_t)(vreg.z & 0xffffu); vd[5 * 72] = (bf16_t)(vreg.z >> 16); vd[6 * 72] = (bf16_t)(vreg.w & 0xffffu); vd[7 * 72] = (bf16_t)(vreg.w >> 16); }
                __syncthreads();
                if (kt + 1 < nt) { const bf16_t* kn = kp + (size_t)(kt + 1) * 64 * NPROJ; kreg = ldx((const u32x4*)kn); vreg = ldx((const u32x4*)(kn + (PC_V - PC_K))); }
                const int k0 = kt * 64;
#ifdef NOSKIP
                if (true) {
#else
                if (k0 <= qw0 + 15) {
#endif
                    f32x4 sc[4];
#pragma unroll
                    for (int j = 0; j < 4; ++j) { const bf16x8 a0 = *(const bf16x8*)(sKb + (16 * j + fr) * 72 + fq * 8), a1 = *(const bf16x8*)(sKb + (16 * j + fr) * 72 + 32 + fq * 8);
                        sc[j] = __builtin_amdgcn_mfma_f32_16x16x32_bf16(a0, qf0, (f32x4){0.f, 0.f, 0.f, 0.f}, 0, 0, 0);
                        sc[j] = __builtin_amdgcn_mfma_f32_16x16x32_bf16(a1, qf1, sc[j], 0, 0, 0); }
#pragma unroll
                    for (int j = 0; j < 4; ++j) { const f32x4 ck = *(const f32x4*)(cf2 + k0 + 16 * j + 4 * fq);
#pragma unroll
                        for (int r = 0; r < 4; ++r) sc[j][r] = sc[j][r] * C2 + (cfq - ck[r]); }
#ifdef NOSKIP
                    if (true) {
#else
                    if (k0 + 63 > qw0) {
#endif
#pragma unroll
                        for (int j = 0; j < 4; ++j)
#pragma unroll
                            for (int r = 0; r < 4; ++r) if (k0 + 16 * j + 4 * fq + r > qrow) sc[j][r] = -INFINITY;
                    }
                    float mx = fmaxf(fmaxf(sc[0][0], sc[0][1]), fmaxf(sc[0][2], sc[0][3]));
#pragma unroll
                    for (int j = 1; j < 4; ++j) mx = fmaxf(mx, fmaxf(fmaxf(sc[j][0], sc[j][1]), fmaxf(sc[j][2], sc[j][3])));
                    mx = fmaxf(mx, __shfl_xor(mx, 16)); mx = fmaxf(mx, __shfl_xor(mx, 32));
                    const float mnew = fmaxf(mrun, mx), alpha = __builtin_amdgcn_exp2f(mrun - mnew);
                    float ls = 0.f;
#pragma unroll
                    for (int j = 0; j < 4; ++j)
#pragma unroll
                        for (int r = 0; r < 4; ++r) { sc[j][r] = __builtin_amdgcn_exp2f(sc[j][r] - mnew); ls += sc[j][r]; }
                    lrun = lrun * alpha + ls; mrun = mnew;
#pragma unroll
                    for (int j = 0; j < 4; ++j) o[j] = o[j] * alpha;
#pragma unroll
                    for (int ks = 0; ks < 2; ++ks) {
                        u32x4 pw; pw.x = pk2t<4>(sc[2 * ks][0], sc[2 * ks][1]); pw.y = pk2t<4>(sc[2 * ks][2], sc[2 * ks][3]); pw.z = pk2t<4>(sc[2 * ks + 1][0], sc[2 * ks + 1][1]); pw.w = pk2t<4>(sc[2 * ks + 1][2], sc[2 * ks + 1][3]);
                        const bf16x8 pb = __builtin_bit_cast(bf16x8, pw);
#pragma unroll
                        for (int dj = 0; dj < 4; ++dj) { const bf16_t* vp = sVb + (16 * dj + fr) * 72 + 32 * ks + 4 * fq;
                            const u32x2 lo = *(const u32x2*)vp, hi = *(const u32x2*)(vp + 16); u32x4 vw; vw.x = lo.x; vw.y = lo.y; vw.z = hi.x; vw.w = hi.y;
                            o[dj] = __builtin_amdgcn_mfma_f32_16x16x32_bf16(__builtin_bit_cast(bf16x8, vw), pb, o[dj], 0, 0, 0); }
                    }
                }
            }
            float lt = lrun; lt += __shfl_xor(lt, 16); lt += __shfl_xor(lt, 32);
            const float inv = ZF / lt;
            bf16_t* op = YCAT + (size_t)(b * SEQ + qrow) * DM + 512 + h * 64 + 4 * fq;
#pragma unroll
            for (int dj = 0; dj < 4; ++dj) { u32x2 w; w.x = pk2t<4>(o[dj][0] * inv, o[dj][1] * inv); w.y = pk2t<4>(o[dj][2] * inv, o[dj][3] * inv); *(u32x2*)(op + 16 * dj) = w; }
            __syncthreads();
        }
    }
}

__device__ __forceinline__ void phase_mc(CArgsP a, int l, unsigned char* lds, int tid, int wave, int lane) {
    const bf16_t* PROJ = (const bf16_t*)(a->ws + WS_BIG); bf16_t* YCAT = (bf16_t*)(a->ws + WS_YCAT); const bf16_t* ST = (const bf16_t*)(a->ws + WS_ST);
    const float* DTF = (const float*)(a->ws + WS_DTF);
    const float* cw = a->in[10] + (size_t)l * 4 * 1024; const float* cb = a->in[11] + l * 1024; const float* dtb = a->in[12] + l * 8; const float* alog = a->in[13] + l * 8;
    const float* dsk = a->in[14] + l * 8; const float* ng = a->in[15] + l * 512;
    const int fr = lane & 15, fq = lane >> 4;
    bf16_t* sC = (bf16_t*)lds;
    bf16_t* sB = (bf16_t*)(lds + 17408);
    bf16_t* sXT = (bf16_t*)(lds + 34816);
    float* sCB = (float*)(lds + 71680);
    float* sDt = (float*)(lds + 89088);
    float* sAcs = sDt + 256;
    float* sRms = sAcs + 256;
    for (int it = blockIdx.x; it < 512; it += gridDim.x) {
        const int b = it >> 7, c = (it >> 1) & 63, g = it & 1, t0 = c * 64, R0 = b * SEQ + t0;
        ssd_dt_acs(DTF, dtb, alog, R0, g, wave, lane, sDt, sAcs);
        for (int o = tid; o < 4096; o += NT) {
            float v[8];
            if (o < 2048) { const int isC = o >> 10, o1 = o & 1023, ll = o1 >> 4, n = (o1 & 15) * 8; conv8(PROJ, b, t0 + ll, (isC ? 768 : 512) + g * 128 + n, cw, cb, v);
                u32x4 w; w.x = pk2t<5>(v[0], v[1]); w.y = pk2t<5>(v[2], v[3]); w.z = pk2t<5>(v[4], v[5]); w.w = pk2t<5>(v[6], v[7]);
                *(u32x4*)((isC ? sC : sB) + ll * 136 + n) = w; }
            else { const int o2 = o - 2048, ll = o2 >> 5, ch = (o2 & 31) * 8; conv8(PROJ, b, t0 + ll, g * 256 + ch, cw, cb, v);
#pragma unroll
                for (int j = 0; j < 8; ++j) sXT[(ch + j) * 72 + ll] = f2bft<5>(v[j]); }
        }
        __syncthreads();
        { const int li = wave >> 1;
#pragma unroll
          for (int q = 0; q < 2; ++q) { const int sj = 2 * (wave & 1) + q; f32x4 acc = (f32x4){0.f, 0.f, 0.f, 0.f};
#pragma unroll
              for (int kk = 0; kk < 4; ++kk) { const bf16x8 af = *(const bf16x8*)(sC + (16 * li + fr) * 136 + 32 * kk + 8 * fq), bfr = *(const bf16x8*)(sB + (16 * sj + fr) * 136 + 32 * kk + 8 * fq);
                  acc = __builtin_amdgcn_mfma_f32_16x16x32_bf16(af, bfr, acc, 0, 0, 0); }
#pragma unroll
              for (int r = 0; r < 4; ++r) sCB[(16 * li + 4 * fq + r) * 68 + 16 * sj + fr] = acc[r]; } }
        __syncthreads();
        { const int e = wave >> 1, lh = wave & 1, h = g * 4 + e;
          f32x4 yd[2][4], yo[2][4];
#pragma unroll
          for (int mi = 0; mi < 2; ++mi)
#pragma unroll
              for (int pj = 0; pj < 4; ++pj) { yd[mi][pj] = (f32x4){0.f, 0.f, 0.f, 0.f}; yo[mi][pj] = yd[mi][pj]; }
#ifdef NOSKIP
          for (int kk = 0; kk < 2; ++kk) {
#else
          for (int kk = 0; kk <= lh; ++kk) {
#endif
              bf16x8 bx[4];
#pragma unroll
              for (int pj = 0; pj < 4; ++pj) bx[pj] = *(const bf16x8*)(sXT + (e * 64 + 16 * pj + fr) * 72 + 32 * kk + 8 * fq);
#pragma unroll
              for (int mi = 0; mi < 2; ++mi) { const int lrow = 32 * lh + 16 * mi + fr, s0 = 32 * kk + 8 * fq; const float al = sAcs[e * 64 + lrow];
                  const f32x4 c0 = *(const f32x4*)(sCB + lrow * 68 + s0), c1 = *(const f32x4*)(sCB + lrow * 68 + s0 + 4);
                  const f32x4 as0 = *(const f32x4*)(sAcs + e * 64 + s0), as1 = *(const f32x4*)(sAcs + e * 64 + s0 + 4), d0 = *(const f32x4*)(sDt + e * 64 + s0), d1 = *(const f32x4*)(sDt + e * 64 + s0 + 4);
                  float gv[8];
#pragma unroll
                  for (int j = 0; j < 4; ++j) { gv[j] = (s0 + j <= lrow) ? c0[j] * d0[j] * __expf(al - as0[j]) : 0.f; gv[4 + j] = (s0 + 4 + j <= lrow) ? c1[j] * d1[j] * __expf(al - as1[j]) : 0.f; }
                  u32x4 gw; gw.x = pk2t<5>(gv[0], gv[1]); gw.y = pk2t<5>(gv[2], gv[3]); gw.z = pk2t<5>(gv[4], gv[5]); gw.w = pk2t<5>(gv[6], gv[7]);
                  const bf16x8 ga = __builtin_bit_cast(bf16x8, gw);
#pragma unroll
                  for (int pj = 0; pj < 4; ++pj) yd[mi][pj] = __builtin_amdgcn_mfma_f32_16x16x32_bf16(ga, bx[pj], yd[mi][pj], 0, 0, 0); }
          }
          const bf16_t* sp = ST + (size_t)((b * 64 + c) * 8 + h) * 8192;
#pragma unroll
          for (int kk = 0; kk < 4; ++kk) {
              bf16x8 bs[4], ca[2];
#pragma unroll
              for (int pj = 0; pj < 4; ++pj) bs[pj] = ldx((const bf16x8*)(sp + (16 * pj + fr) * 128 + 32 * kk + 8 * fq));
#pragma unroll
              for (int mi = 0; mi < 2; ++mi) ca[mi] = *(const bf16x8*)(sC + (32 * lh + 16 * mi + fr) * 136 + 32 * kk + 8 * fq);
#pragma unroll
              for (int mi = 0; mi < 2; ++mi)
#pragma unroll
                  for (int pj = 0; pj < 4; ++pj) yo[mi][pj] = __builtin_amdgcn_mfma_f32_16x16x32_bf16(ca[mi], bs[pj], yo[mi][pj], 0, 0, 0);
          }
          const float dh = dsk[h];
          float ss[2][4];
#pragma unroll
          for (int mi = 0; mi < 2; ++mi) { const int lb = 32 * lh + 16 * mi + 4 * fq; const f32x4 ea = *(const f32x4*)(sAcs + e * 64 + lb);
#pragma unroll
              for (int r = 0; r < 4; ++r) ss[mi][r] = 0.f;
#pragma unroll
              for (int pj = 0; pj < 4; ++pj) { const int p = 16 * pj + fr; const u32x2 xw = *(const u32x2*)(sXT + (e * 64 + p) * 72 + lb);
                  const float xs[4] = {bf_lo(xw.x), bf_hi(xw.x), bf_lo(xw.y), bf_hi(xw.y)};
#pragma unroll
                  for (int r = 0; r < 4; ++r) { const float z = bf2f(ldx(PROJ + (size_t)(R0 + lb + r) * NPROJ + PC_Z + g * 256 + e * 64 + p));
                      float y = yd[mi][pj][r] + __expf(ea[r]) * yo[mi][pj][r] + dh * xs[r]; y *= siluf(z); yd[mi][pj][r] = y; ss[mi][r] += y * y; } } }
#pragma unroll
          for (int mi = 0; mi < 2; ++mi)
#pragma unroll
              for (int r = 0; r < 4; ++r) { float s = ss[mi][r]; s += __shfl_xor(s, 1); s += __shfl_xor(s, 2); s += __shfl_xor(s, 4); s += __shfl_xor(s, 8);
                  if (fr == 0) sRms[(32 * lh + 16 * mi + 4 * fq + r) * 4 + e] = s; }
          __syncthreads();
#pragma unroll
          for (int mi = 0; mi < 2; ++mi) { const int lb = 32 * lh + 16 * mi + 4 * fq;
#pragma unroll
              for (int r = 0; r < 4; ++r) { const f32x4 q4 = *(const f32x4*)(sRms + (lb + r) * 4); const float rstd = 1.f / sqrtf(((q4.x + q4.y) + (q4.z + q4.w)) * (1.f / 256.f) + RMS_EPS);
#pragma unroll
                  for (int pj = 0; pj < 4; ++pj) { const int ch = g * 256 + e * 64 + 16 * pj + fr; YCAT[(size_t)(R0 + lb + r) * DM + ch] = f2bft<5>(ZS * yd[mi][pj][r] * rstd * ng[ch]); } } }
        }
        __syncthreads();
    }
}
}


#define LAS __attribute__((address_space(3)))
#ifndef XB_ACQ_SCOPE
#define XB_ACQ_SCOPE ""
#endif
#define XB_TMO      128
#define XB_XCNT(j)  (256  + 64 * (j))
#define XB_XSUB(j)  (1280 + 64 * (j))
#define XB_XGEN(j)  (2304 + 64 * (j))
#define XB_TOP      3328
#define XB_TOPGEN   3392
#define XCD_BAR_WORDS 3456
#define XB_SPIN_CAP (1u << 18)

__device__ __forceinline__ unsigned xb_ld(unsigned* p)              { return __hip_atomic_load(p, __ATOMIC_RELAXED, __HIP_MEMORY_SCOPE_AGENT); }
__device__ __forceinline__ unsigned xb_add(unsigned* p, unsigned v) { return __hip_atomic_fetch_add(p, v, __ATOMIC_RELAXED, __HIP_MEMORY_SCOPE_AGENT); }
__device__ __forceinline__ unsigned xb_xcc_id() { return (unsigned)__builtin_amdgcn_s_getreg((3 << 11) | 20) & 0xFu; }
#define XB_SPIN(cond, bar) do { unsigned _sp = 0; while (cond) { __builtin_amdgcn_s_sleep(1); \
    if ((++_sp & 255u) == 0u) { if (xb_ld(&(bar)[XB_TMO])) break; if (_sp > XB_SPIN_CAP) { atomicAdd(&(bar)[XB_TMO], 1u); break; } } } } while (0)

struct XcdBarrier {
    unsigned* bar; unsigned x;
    volatile LAS unsigned* st;
};

__device__ __forceinline__ XcdBarrier xcd_barrier_post(unsigned* bar, volatile LAS unsigned* st) {
    XcdBarrier b; b.bar = bar; b.x = xb_xcc_id(); b.st = st;
    if (threadIdx.x == 0) (void)xb_add(&bar[XB_XCNT(b.x)], 1u);
    return b;
}
__device__ __forceinline__ void xcd_barrier_complete(unsigned* bar, unsigned x, unsigned& nloc, unsigned& nx) {
    const unsigned G = gridDim.x * gridDim.y * gridDim.z;
    unsigned sum, cnt, mine, sp = 0u;
    for (;;) {
        sum = 0u; cnt = 0u; mine = 0u;
#pragma unroll
        for (unsigned j = 0; j < 16; ++j) { const unsigned c = xb_ld(&bar[XB_XCNT(j)]); sum += c; cnt += (c > 0u) ? 1u : 0u; mine = (j == x) ? c : mine; }
        if (sum == G) break;
        __builtin_amdgcn_s_sleep(1);
        if ((++sp & 255u) == 0u) { if (xb_ld(&bar[XB_TMO])) break; if (sp > XB_SPIN_CAP) { atomicAdd(&bar[XB_TMO], 1u); break; } }
    }
    nloc = mine > 0u ? mine : 1u; nx = cnt > 0u ? cnt : 1u;
}

__device__ __forceinline__ void xcd_barrier(const XcdBarrier& b) {
    asm volatile("s_waitcnt vmcnt(0)" ::: "memory");
    __syncthreads();
    if (threadIdx.x == 0) {
        unsigned* bar = b.bar;
        __builtin_amdgcn_s_waitcnt(0);
        unsigned nloc = b.st[0], nx = b.st[1];
        if (nloc == 0u) { xcd_barrier_complete(bar, b.x, nloc, nx); b.st[0] = nloc; b.st[1] = nx; }
        const unsigned old = xb_add(&bar[XB_XSUB(b.x)], 1u);
        const unsigned gen = old / nloc;
        if (old + 1u == (gen + 1u) * nloc) {
            __builtin_amdgcn_fence(__ATOMIC_RELEASE, "agent");
            asm volatile("s_waitcnt vmcnt(0)" ::: "memory");
            const unsigned og = xb_add(&bar[XB_TOP], 1u);
            const unsigned tg = og / nx;
            if (og + 1u == (tg + 1u) * nx) xb_add(&bar[XB_TOPGEN], 1u);
            else XB_SPIN(xb_ld(&bar[XB_TOPGEN]) == tg, bar);
            __builtin_amdgcn_fence(__ATOMIC_ACQUIRE, "");
            asm volatile("s_waitcnt vmcnt(0)" ::: "memory");
            xb_add(&bar[XB_XGEN(b.x)], 1u);
            asm volatile("s_waitcnt vmcnt(0)" ::: "memory");
        } else {
            XB_SPIN(xb_ld(&bar[XB_XGEN(b.x)]) == gen, bar);
            __builtin_amdgcn_fence(__ATOMIC_ACQUIRE, "agent");
            asm volatile("s_waitcnt vmcnt(0)" ::: "memory");
        }
    }
    __syncthreads();
}


#ifndef MK_STOP_AFTER
#define MK_STOP_AFTER 1000
#endif
__global__ void __launch_bounds__(512, 2) mega_fwd(mk::Args a_unused) {
    using namespace mk;
    extern __shared__ __attribute__((aligned(16))) unsigned char lds[];
    cg::grid_group grid = cg::this_grid();
    volatile LAS unsigned* bst = (volatile LAS unsigned*)((LAS unsigned char*)lds + 131072 + 256);
#ifdef LDS_POISON
    for (int i = threadIdx.x; i < mk::LDS_BYTES / 4; i += 512) ((volatile unsigned*)lds)[i] = 0xFFFFFFFFu;
    __syncthreads();
#endif
    if (threadIdx.x < 2) bst[threadIdx.x] = 0u;
    __syncthreads();
    { CArgsP a0 = get_args(); (void)xcd_barrier_post((unsigned*)(a0->ws + WS_BAR), bst); }
    grid.sync();
#define GSYNC() do { CArgsP a_ = get_args(); XcdBarrier b_; b_.bar = (unsigned*)(a_->ws + WS_BAR); b_.x = xb_xcc_id(); b_.st = bst; xcd_barrier(b_); } while (0)
#pragma unroll 1
    for (int ph_ = 0; ph_ < (MK_STOP_AFTER < 25 ? MK_STOP_AFTER + 1 : 26); ++ph_) {
        int ph = ph_; asm volatile("" : "+s"(ph));
        int tid = threadIdx.x; asm volatile("" : "+v"(tid)); const int lane = tid & 63, wave = __builtin_amdgcn_readfirstlane(tid >> 6);
        CArgsP a = get_args();
        unsigned char* ws = a->ws;
        const int p = ph - 2, l = p < 0 ? 0 : p / 12, s = p < 0 ? -1 : p % 12;
        if (s == 0 || s == 1 || s == 3 || s == 7 || s == 9 || s == 10) {
#ifndef NO_G
            unsigned char* wl = ws + WS_W + (size_t)l * W_L;
            const size_t aoff = (s == 0 || s == 3 || s == 9) ? WS_HB : (s == 7 ? WS_YCAT : WS_BIG);
            const size_t boff = s == 0 ? WO_1IN : s == 1 ? WO_1OUT : s == 3 ? WO_MI : s == 7 ? WO_MO : s == 9 ? WO_2IN : WO_2OUT;
            const int N = (s == 0 || s == 9) ? NFF : (s == 3 ? NPROJ : DM), K = (s == 1 || s == 10) ? DFF : DM;
            pg8::Gemm g_{(const bf16_t*)(ws + aoff), (const bf16_t*)(wl + boff), MROWS, N, K}; pg8::StaticOrder S_; S_.init(MROWS, N, (int)gridDim.x, (int)blockIdx.x);
            EpiMulti E{s | (l << 8)};
            pg8::gemm_phase<EpiMulti, pg8::StaticOrder, true, true>((PG8_LAS unsigned char*)lds, g_, S_, E);
#endif
        } else if (ph == 0) {
#ifndef NO_P0
            phase_p0(a, lds, tid, wave, lane);
#endif
        } else if (ph == 1 || s == 8 || s == 11) {
            const float* modl = (const float*)(ws + WS_MOD) + (size_t)l * 4 * NMOD;
            const int li = s == 8 ? 1 : 2, sub = s == 8 ? 2 : 0; const bool wh = !(s == 11 && l == 1);
            const float* src = ph == 1 ? a->in[0] : (const float*)a->out;
            const float* gm = ph == 1 ? a->in[2] : a->in[20] + (l * 3 + li) * DM; const float* bt = ph == 1 ? a->in[3] : a->in[21] + (l * 3 + li) * DM;
            const float* md = (s == 11 && l == 0) ? modl + 4 * NMOD : modl;
            phase_ln<false>(src, a->out, (bf16_t*)(ws + WS_HB), gm, bt, md, sub, wh, nullptr, nullptr, lds, tid, wave, lane);
        } else if (s == 2) {
            const float* modl = (const float*)(ws + WS_MOD) + (size_t)l * 4 * NMOD;
            phase_ln<true>(a->out, a->out, (bf16_t*)(ws + WS_HB), a->in[20] + l * 3 * DM, a->in[21] + l * 3 * DM, modl, 1, true, (const float*)(ws + WS_WMISC) + l * 12288, (float*)(ws + WS_DTF), lds, tid, wave, lane);
        } else if (s == 4) {
#ifndef NO_MA
            phase_ma(a, l, lds, tid, wave, lane);
#endif
        } else if (s == 5) {
#ifndef NO_MB
            phase_mb(a, l, lds, tid, wave, lane);
#endif
        } else {
#ifndef NO_MC
            phase_mc(a, l, lds, tid, wave, lane);
#endif
        }
        if (ph_ < 25) GSYNC();
    }
}

extern "C" void kernel_launch(void* const* d_in, const int* in_sizes, int n_in, void* d_out, int out_size, void* d_ws, size_t ws_size, hipStream_t stream) {
    static int grid = 0;
    if (grid == 0) {
        if (n_in != 22 || out_size != mk::MROWS * mk::DM || ws_size < mk::WS_END) { fprintf(stderr, "kernel_launch: unexpected problem (n_in %d out %d ws %zu)\n", n_in, out_size, ws_size); grid = -1; return; }
        int dev = 0, cus = 0, per_cu = 0;
        (void)hipGetDevice(&dev); (void)hipDeviceGetAttribute(&cus, hipDeviceAttributeMultiprocessorCount, dev);
        (void)hipFuncSetAttribute((const void*)mega_fwd, hipFuncAttributeMaxDynamicSharedMemorySize, mk::LDS_BYTES);
        (void)hipOccupancyMaxActiveBlocksPerMultiprocessor(&per_cu, (const void*)mega_fwd, 512, mk::LDS_BYTES);
        (void)hipGetLastError();
        if (per_cu < 1) { fprintf(stderr, "kernel_launch: occupancy query says %d\n", per_cu); grid = -1; return; }
        grid = cus;
    }
    if (grid < 0) return;
#ifdef NAN_POISON
    (void)hipMemsetAsync(d_ws, 0xFF, mk::WS_END, stream); (void)hipMemsetAsync(d_out, 0xFF, (size_t)out_size * 4, stream);
#endif
    if (hipMemsetAsync((char*)d_ws + mk::WS_BAR, 0, 16384, stream) != hipSuccess) { fprintf(stderr, "kernel_launch: memset failed\n"); return; }
    mk::Args a{};
    for (int i = 0; i < 22; ++i) a.in[i] = (const float*)d_in[i];
    a.out = (float*)d_out; a.ws = (unsigned char*)d_ws;
    void* args[] = {&a};
    hipError_t e = hipLaunchCooperativeKernel((const void*)mega_fwd, dim3(grid), dim3(512), args, mk::LDS_BYTES, stream);
    if (e != hipSuccess) fprintf(stderr, "cooperative launch failed: %s (grid %d)\n", hipGetErrorString(e), grid);
}
```

```cpp
#include <hip/hip_runtime.h>
#include <hip/hip_cooperative_groups.h>
#include <cstdio>
#include <cstdint>
namespace cg = cooperative_groups;
#ifndef PG8_A_AUX
#define PG8_A_AUX 16
#endif
namespace pg8 {
#define PG8_LAS __attribute__((address_space(3)))
typedef unsigned short bf16_t;
typedef short bf16x8 __attribute__((ext_vector_type(8)));
typedef float f32x4 __attribute__((ext_vector_type(4)));
typedef unsigned u32x4 __attribute__((ext_vector_type(4)));
constexpr int BM = 256, BK = 64, HALF = 128, HTB = HALF * BK * 2  , STAGE_BYTES = 8 * HTB, NXCD = 8, WGM = 8;

__host__ __device__ __forceinline__ int lds_byte(int r, int c) { const int st = (r >> 4) * 2 + (c >> 5), rr = r & 15, cc = c & 31, ob = rr * 64 + cc * 2; return st * 1024 + (ob ^ (((ob >> 9) & 1) << 5)); }
__host__ __device__ __forceinline__ void stage_rc(int b, int& R, int& C) { const int st = b / 1024, sb = b % 1024, swz = sb ^ (((sb >> 9) & 1) << 5); R = (st >> 1) * 16 + swz / 64; C = (st & 1) * 32 + (swz % 64) / 2; }
__host__ __device__ __forceinline__ int perm32(int rho) { const int n = rho >> 4, i = rho & 15; return 8 * (i >> 2) + 4 * n + (i & 3); }

struct Unit { int pm, pn; };
struct Gemm { const bf16_t* A; const bf16_t* Bt; int M, N, K; };

struct StaticOrder {
    int nM, nN, nwg, G, c;
    __host__ __device__ void init(int M, int N, int G_, int c_) { nM = M / BM; nN = N / BM; nwg = nM * nN; G = G_; c = c_; }
    __host__ __device__ bool next(int i, Unit& u) const {
        const long L = (long)i * G + c; if (L >= nwg) return false;
        int wgid = (int)L; { const int q = nwg / NXCD, r = nwg % NXCD, xcd = wgid % NXCD, off = wgid / NXCD; wgid = (xcd < r ? xcd * (q + 1) : r * (q + 1) + (xcd - r) * q) + off; }
        const int nig = WGM * nN, gid = wgid / nig, fm = gid * WGM, gsz = (nM - fm) < WGM ? (nM - fm) : WGM;
        u.pm = fm + ((wgid % nig) % gsz); u.pn = (wgid % nig) / gsz; return true;
    }
    __device__ __forceinline__ void a_ready(const Unit&) const {}
    __device__ __forceinline__ void done(const Unit&) const {}
};

__device__ __forceinline__ unsigned cvt_pk_bf16(float lo, float hi) { unsigned r; asm volatile("v_cvt_pk_bf16_f32 %0, %1, %2" : "=v"(r) : "v"(lo), "v"(hi)); return r; }
typedef float f32x2 __attribute__((ext_vector_type(2)));
__device__ __forceinline__ f32x2 gelu_pk(f32x2 v) {
    const f32x2 av = __builtin_elementwise_abs(v), d = av * 0.2316418882f + 1.0f;
    f32x2 t; t.x = __builtin_amdgcn_rcpf(d.x); t.y = __builtin_amdgcn_rcpf(d.y);
    f32x2 q = t * 0.5307027145f + (-0.7265760135f); q = q * t + 0.7107068705f; q = q * t + (-0.142248368f); q = q * t + 0.127414796f; q = q * t;
    const f32x2 s = (v * v) * (-0.72134752044f);
    f32x2 e; e.x = __builtin_amdgcn_exp2f(s.x); e.y = __builtin_amdgcn_exp2f(s.y);
    const f32x2 m = v * (q * e), r = v - m;
    f32x2 o; o.x = v.x < 0.f ? m.x : r.x; o.y = v.y < 0.f ? m.y : r.y; return o;
}

template <int ACT  > struct EpiBf16 {
    static constexpr bool PERM = true, AFTER_DRAIN = false; static_assert(ACT == 0 || ACT == 1, "EpiBf16: ACT is 0 (none) or 1 (gelu_pk)");
    bf16_t* O; int ldc; const float* bias; int split_cols; size_t split_stride; float scale0;
    __device__ __forceinline__ void operator()(const f32x4 (&acc)[2][2][4][2], const Unit& u, int wr, int wc, int fr, int fq) const {
        const int row0 = u.pm * BM + wr * 64 + fr; int colt = u.pn * BM; bf16_t* base = O;
        float sc = 1.f; if (split_cols) { const int t = colt / split_cols; base += (size_t)t * split_stride; colt -= t * split_cols; if (t == 0) sc = scale0; }
        const int col0 = colt + wc * 32 + 8 * fq, bcol0 = u.pn * BM + wc * 32 + 8 * fq;
        f32x4 bv[2][2];
#pragma unroll
        for (int bj = 0; bj < 2; ++bj)
#pragma unroll
            for (int n = 0; n < 2; ++n) bv[bj][n] = bias ? *(const f32x4*)(bias + bcol0 + bj * HALF + 4 * n) : (f32x4){0.f, 0.f, 0.f, 0.f};
#pragma unroll
        for (int ai = 0; ai < 2; ++ai)
#pragma unroll
            for (int m = 0; m < 4; ++m) { bf16_t* rowp = base + (size_t)(row0 + ai * HALF + m * 16) * ldc + col0;
#pragma unroll
                for (int bj = 0; bj < 2; ++bj) { f32x4 v0 = acc[ai][bj][m][0] + bv[bj][0], v1 = acc[ai][bj][m][1] + bv[bj][1];
                    if (ACT == 1) { f32x2 a = gelu_pk((f32x2){v0[0], v0[1]}), b = gelu_pk((f32x2){v0[2], v0[3]}), c = gelu_pk((f32x2){v1[0], v1[1]}), d = gelu_pk((f32x2){v1[2], v1[3]});
                        v0 = (f32x4){a.x, a.y, b.x, b.y}; v1 = (f32x4){c.x, c.y, d.x, d.y}; }
                    v0 = v0 * sc; v1 = v1 * sc; u32x4 w; w.x = cvt_pk_bf16(v0[0], v0[1]); w.y = cvt_pk_bf16(v0[2], v0[3]); w.z = cvt_pk_bf16(v1[0], v1[1]); w.w = cvt_pk_bf16(v1[2], v1[3]);
                    *(u32x4*)(rowp + bj * HALF) = w; } }
    }
};

struct PanelStats {
    unsigned* xbuf;
    unsigned* cnt;
    unsigned* tmo;
    int ntn; float eps;
    unsigned code;
    __device__ __forceinline__ bool run(const f32x4 (&v)[2][2][4][2], const Unit& u, int wr, int wc, int fr, int fq, PG8_LAS unsigned char* lds, int wid, int lane) const {
        typedef float f32x2v __attribute__((ext_vector_type(2)));
        PG8_LAS f32x2v* P = (PG8_LAS f32x2v*)lds;
        PG8_LAS f32x2v* S = (PG8_LAS f32x2v*)(lds + 8192);
        PG8_LAS unsigned* flag = (PG8_LAS unsigned*)(lds + 8192 + 2048);
#pragma unroll
        for (int ai = 0; ai < 2; ++ai)
#pragma unroll
            for (int m = 0; m < 4; ++m) {
                float s = 0.f;
#pragma unroll
                for (int bj = 0; bj < 2; ++bj)
#pragma unroll
                    for (int n = 0; n < 2; ++n) { const f32x4 x = v[ai][bj][m][n]; s += (x[0] + x[1]) + (x[2] + x[3]); }
                s += __shfl_xor(s, 16); s += __shfl_xor(s, 32);
                const float mw = s * (1.0f / 64.0f); float q = 0.f;
#pragma unroll
                for (int bj = 0; bj < 2; ++bj)
#pragma unroll
                    for (int n = 0; n < 2; ++n) { const f32x4 d = v[ai][bj][m][n] - mw; q += (d[0] * d[0] + d[1] * d[1]) + (d[2] * d[2] + d[3] * d[3]); }
                q += __shfl_xor(q, 16); q += __shfl_xor(q, 32);
                if (fq == 0) P[(ai * HALF + wr * 64 + m * 16 + fr) * 4 + wc] = (f32x2v){mw, q};
            }
        asm volatile("s_waitcnt lgkmcnt(0)" ::: "memory"); __builtin_amdgcn_s_barrier(); asm volatile("" ::: "memory");
#if defined(BROKEN_EXCHANGE_NO_WAIT)
#warning BROKEN CONTROL BUILD: the row-statistics exchange does not wait; results are wrong by design
        if (blockIdx.x >= 64) { const long long t0_ = clock64(); while (clock64() - t0_ < 60000) __builtin_amdgcn_s_sleep(8); }
#endif
        const int row = wid * 32 + (lane & 31);
        if (lane < 32) {
            const f32x2v a = P[row * 4 + 0], b = P[row * 4 + 1], c = P[row * 4 + 2], d = P[row * 4 + 3];
            const float mt = (a.x + b.x + c.x + d.x) * 0.25f;
            const float da = a.x - mt, db = b.x - mt, dc = c.x - mt, dd = d.x - mt;
            const float m2 = (a.y + b.y) + (c.y + d.y) + 64.0f * ((da * da + db * db) + (dc * dc + dd * dd));
            unsigned long long* slot = (unsigned long long*)xbuf + ((size_t)(u.pm * BM + row) * 4 + u.pn);
            __hip_atomic_store(slot, ((unsigned long long)__float_as_uint(m2) << 32) | __float_as_uint(mt), __ATOMIC_RELAXED, __HIP_MEMORY_SCOPE_AGENT);
        }
        asm volatile("s_waitcnt vmcnt(0)" ::: "memory");
        if (lane == 0) __hip_atomic_fetch_add(cnt + 64 * u.pm, 1u, __ATOMIC_RELAXED, __HIP_MEMORY_SCOPE_AGENT);
        if (wid == 0) {
            bool dead = false; const unsigned long long t0 = __builtin_amdgcn_s_memrealtime(); const unsigned want = 8u * (unsigned)ntn;
            for (;;) {
#if defined(BROKEN_EXCHANGE_NO_WAIT)
                break;
#endif
                if ((unsigned)__builtin_amdgcn_readfirstlane(__hip_atomic_load(cnt + 64 * u.pm, __ATOMIC_RELAXED, __HIP_MEMORY_SCOPE_AGENT)) >= want) break;
                if (__builtin_amdgcn_s_memrealtime() - t0 > 2000000ull) {
                    if (lane == 0) { unsigned expect = 0u; __hip_atomic_compare_exchange_strong(tmo + 1, &expect, code | (unsigned)(u.pm & 0xff), __ATOMIC_RELAXED, __ATOMIC_RELAXED, __HIP_MEMORY_SCOPE_AGENT);
                                     __hip_atomic_store(tmo, 1u, __ATOMIC_RELAXED, __HIP_MEMORY_SCOPE_AGENT); }
                    dead = true; break; }
                __builtin_amdgcn_s_sleep(2);
            }
            __builtin_amdgcn_fence(__ATOMIC_ACQUIRE, "agent");
            if (lane == 0) flag[0] = dead ? 1u : 0u;
        }
        asm volatile("s_waitcnt vmcnt(0) lgkmcnt(0)" ::: "memory"); __builtin_amdgcn_s_barrier(); asm volatile("" ::: "memory");
        const bool bad = flag[0] != 0u;
        if (lane < 32) {
            const unsigned long long* slot = (const unsigned long long*)xbuf + (size_t)(u.pm * BM + row) * 4; float mt[4], m2[4]; float ms = 0.f;
#pragma unroll
            for (int t = 0; t < 4; ++t) { if (t < ntn) { const unsigned long long w = __hip_atomic_load(slot + t, __ATOMIC_RELAXED, __HIP_MEMORY_SCOPE_AGENT); mt[t] = __uint_as_float((unsigned)w); m2[t] = __uint_as_float((unsigned)(w >> 32)); } else { mt[t] = 0.f; m2[t] = 0.f; } ms += mt[t]; }
            const float mean = ms / (float)ntn; float q = 0.f;
#pragma unroll
            for (int t = 0; t < 4; ++t) if (t < ntn) { const float dm = mt[t] - mean; q += m2[t] + 256.0f * dm * dm; }
            S[row] = (f32x2v){mean, 1.0f / sqrtf(q / (256.0f * (float)ntn) + eps)};
        }
        asm volatile("s_waitcnt lgkmcnt(0)" ::: "memory"); __builtin_amdgcn_s_barrier(); asm volatile("" ::: "memory");
        return bad;
    }
};
struct EpiLnRes {
    static constexpr bool PERM = false, AFTER_DRAIN = true;
    const float* base; float* out; int ldc; const float* bias; PanelStats st; unsigned poison;
    __device__ __forceinline__ void fused(f32x4 (&acc)[2][2][4][2], const Unit& u, int wr, int wc, int fr, int fq, PG8_LAS unsigned char* lds, int wid, int lane) const {
        typedef float f32x2v __attribute__((ext_vector_type(2)));
        const PG8_LAS f32x2v* S = (const PG8_LAS f32x2v*)(lds + 8192);
        const int col0 = u.pn * BM + wc * 32 + 4 * fq;
#pragma unroll
        for (int bj = 0; bj < 2; ++bj)
#pragma unroll
            for (int n = 0; n < 2; ++n) { const f32x4 bv = bias ? *(const f32x4*)(bias + col0 + bj * HALF + n * 16) : (f32x4){0.f, 0.f, 0.f, 0.f};
#pragma unroll
                for (int ai = 0; ai < 2; ++ai)
#pragma unroll
                    for (int m = 0; m < 4; ++m) acc[ai][bj][m][n] += bv; }
        f32x4 pre[4][2][2];
#pragma unroll
        for (int m = 0; m < 4; ++m) { const size_t off = (size_t)(u.pm * BM + wr * 64 + m * 16 + fr) * ldc + col0;
#pragma unroll
            for (int bj = 0; bj < 2; ++bj)
#pragma unroll
                for (int n = 0; n < 2; ++n) pre[m][bj][n] = *(const f32x4*)(base + off + bj * HALF + n * 16); }
        const bool bad = st.run(acc, u, wr, wc, fr, fq, lds, wid, lane) || poison != 0u;
        const float qnan = __builtin_nanf("");
#pragma unroll
        for (int ai = 0; ai < 2; ++ai)
#pragma unroll
            for (int m = 0; m < 4; ++m) { const int r = ai * HALF + wr * 64 + m * 16 + fr; const f32x2v sr = S[r]; const size_t off = (size_t)(u.pm * BM + r) * ldc + col0;
#pragma unroll
                for (int bj = 0; bj < 2; ++bj)
#pragma unroll
                    for (int n = 0; n < 2; ++n) { const f32x4 bs = ai == 0 ? pre[m][bj][n] : *(const f32x4*)(base + off + bj * HALF + n * 16); f32x4 o = bs + (acc[ai][bj][m][n] - sr.x) * sr.y;
                        if (bad) o = (f32x4){qnan, qnan, qnan, qnan}; *(f32x4*)(out + off + bj * HALF + n * 16) = o; }
                if (m & 1) asm volatile("" ::: "memory"); }
    }
};
struct EpiLnResLn {
    static constexpr bool PERM = false, AFTER_DRAIN = true;
    const float* base; float* out; bf16_t* xn; int ldc; const float* bias; PanelStats st1, st2; unsigned poison;
    __device__ __forceinline__ void fused(f32x4 (&acc)[2][2][4][2], const Unit& u, int wr, int wc, int fr, int fq, PG8_LAS unsigned char* lds, int wid, int lane) const {
        typedef float f32x2v __attribute__((ext_vector_type(2))); typedef unsigned u32x2v __attribute__((ext_vector_type(2)));
        const PG8_LAS f32x2v* S = (const PG8_LAS f32x2v*)(lds + 8192);
        const int col0 = u.pn * BM + wc * 32 + 4 * fq;
#pragma unroll
        for (int bj = 0; bj < 2; ++bj)
#pragma unroll
            for (int n = 0; n < 2; ++n) { const f32x4 bv = bias ? *(const f32x4*)(bias + col0 + bj * HALF + n * 16) : (f32x4){0.f, 0.f, 0.f, 0.f};
#pragma unroll
                for (int ai = 0; ai < 2; ++ai)
#pragma unroll
                    for (int m = 0; m < 4; ++m) acc[ai][bj][m][n] += bv; }
        bool bad = st1.run(acc, u, wr, wc, fr, fq, lds, wid, lane) || poison != 0u;
        const float qnan = __builtin_nanf("");
#pragma unroll
        for (int ai = 0; ai < 2; ++ai)
#pragma unroll
            for (int m = 0; m < 4; ++m) { const int r = ai * HALF + wr * 64 + m * 16 + fr; const f32x2v sr = S[r]; const size_t off = (size_t)(u.pm * BM + r) * ldc + col0;
#pragma unroll
                for (int bj = 0; bj < 2; ++bj)
#pragma unroll
                    for (int n = 0; n < 2; ++n) { const f32x4 bs = *(const f32x4*)(base + off + bj * HALF + n * 16); acc[ai][bj][m][n] = bs + (acc[ai][bj][m][n] - sr.x) * sr.y; }
                asm volatile("" : "+v"(acc[ai][0][m][0]), "+v"(acc[ai][0][m][1]), "+v"(acc[ai][1][m][0]), "+v"(acc[ai][1][m][1]));
                if (m & 1) asm volatile("" ::: "memory"); }
        const bool bad1 = bad;
        bad = st2.run(acc, u, wr, wc, fr, fq, lds, wid, lane) || bad;
#pragma unroll
        for (int ai = 0; ai < 2; ++ai)
#pragma unroll
            for (int m = 0; m < 4; ++m) { const int r = ai * HALF + wr * 64 + m * 16 + fr; const f32x2v sr = S[r]; const size_t off = (size_t)(u.pm * BM + r) * ldc + col0;
#pragma unroll
                for (int bj = 0; bj < 2; ++bj)
#pragma unroll
                    for (int n = 0; n < 2; ++n) { const f32x4 x1 = acc[ai][bj][m][n]; *(f32x4*)(out + off + bj * HALF + n * 16) = bad1 ? (f32x4){qnan, qnan, qnan, qnan} : x1;
                        const f32x4 o = (x1 - sr.x) * sr.y; u32x2v w; w.x = cvt_pk_bf16(o[0], o[1]); w.y = cvt_pk_bf16(o[2], o[3]);
                        if (bad) { w.x = 0x7fc07fc0u; w.y = 0x7fc07fc0u; } *(u32x2v*)(xn + off + bj * HALF + n * 16) = w; }
                asm volatile("" ::: "memory"); }
    }
};

template <class Epi, class Sched, bool ALIGN_EPI = false, bool SP2 = false>
__device__ __forceinline__ void gemm_phase(PG8_LAS unsigned char* lds, const Gemm g, const Sched& S, const Epi& E) {
    int tid_ = threadIdx.x; asm volatile("" : "+v"(tid_)); const int tid = tid_, wid = __builtin_amdgcn_readfirstlane(tid >> 6), lane = tid & 63, wr = wid >> 2, wc = wid & 3, fr = lane & 15, fq = lane >> 4;
    const int K = g.K, nt = K / BK;
    unsigned voffA[2], voffB[2];
#pragma unroll
    for (int i = 0; i < 2; ++i) { int R, C; stage_rc(tid * 16 + i * 8192, R, C); const int Rb = Epi::PERM ? ((R & ~31) + perm32(R & 31)) : R;
        voffA[i] = (unsigned)(R * K + C) * 2u; voffB[i] = (unsigned)(Rb * K + C) * 2u; }
    const size_t kstep = (size_t)(BK * 2);
    const size_t hstep = (size_t)HALF * K * 2;
    const size_t tstep = 2 * hstep;
    const unsigned ldsw = (unsigned)wid * 1024u;
    const int aoff = lds_byte(wr * 64 + fr, fq * 8), boff = lds_byte(wc * 32 + fr, fq * 8);
#define PG8_SA(b, h) (((b) * 2 + (h)) * HTB)
#define PG8_SB(b, h) ((4 + (b) * 2 + (h)) * HTB)
#define PG8_STAGE_X(bufoff, gbase, voff, aux) do { _Pragma("unroll") for (int _i = 0; _i < 2; ++_i) \
        __builtin_amdgcn_global_load_lds((const unsigned*)((const char*)(gbase) + (voff)[_i]), (PG8_LAS unsigned*)(lds + (bufoff) + ldsw + _i * 8192), 16, 0, aux); } while (0)
#define PG8_STAGE(bufoff, gbase, voff) PG8_STAGE_X(bufoff, gbase, voff, 0)
#define PG8_STAGE_A(bufoff, gbase, voff) PG8_STAGE_X(bufoff, gbase, voff, PG8_A_AUX)
#define PG8_LDA(dst, b, h) do { _Pragma("unroll") for (int m = 0; m < 4; ++m) _Pragma("unroll") for (int k = 0; k < 2; ++k) dst[m][k] = *(const PG8_LAS bf16x8*)(lds + PG8_SA(b, h) + aoff + m * 2048 + k * 1024); } while (0)
#define PG8_LDB(dst, b, h) do { _Pragma("unroll") for (int n = 0; n < 2; ++n) _Pragma("unroll") for (int k = 0; k < 2; ++k) dst[n][k] = *(const PG8_LAS bf16x8*)(lds + PG8_SB(b, h) + boff + n * 2048 + k * 1024); } while (0)
#define PG8_MMA(ai, bj, At, Bt) do { __builtin_amdgcn_s_setprio(1); _Pragma("unroll") for (int m = 0; m < 4; ++m) _Pragma("unroll") for (int n = 0; n < 2; ++n) _Pragma("unroll") for (int k = 0; k < 2; ++k) \
        acc[ai][bj][m][n] = __builtin_amdgcn_mfma_f32_16x16x32_bf16(Bt[n][k], At[m][k], acc[ai][bj][m][n], 0, 0, 0); __builtin_amdgcn_s_setprio(0); } while (0)
#define PG8_WAIT_V(n) asm volatile("s_waitcnt vmcnt(" #n ")" ::: "memory")
#define PG8_WAIT_L(n) asm volatile("s_waitcnt lgkmcnt(" #n ")" ::: "memory")
#define PG8_BAR __builtin_amdgcn_s_barrier()
#define PG8_SCHED __builtin_amdgcn_sched_barrier(0)
    Unit cur, nxt; int ui = 0;
    if (!S.next(0, cur)) return;
    f32x4 acc[2][2][4][2];
#pragma unroll
    for (int a = 0; a < 2; ++a)
#pragma unroll
        for (int b = 0; b < 2; ++b)
#pragma unroll
            for (int m = 0; m < 4; ++m)
#pragma unroll
                for (int n = 0; n < 2; ++n) acc[a][b][m][n] = (f32x4){0.f, 0.f, 0.f, 0.f};
    bf16x8 At[4][2], B0[2][2], B1[2][2];
    const char* cA = (const char*)g.A + (size_t)cur.pm * tstep; const char* cB = (const char*)g.Bt + (size_t)cur.pn * tstep;
    S.a_ready(cur);
    if constexpr (SP2) {
        PG8_STAGE(PG8_SB(0, 0), cB, voffB); PG8_STAGE(PG8_SB(0, 1), cB + hstep, voffB); PG8_STAGE_A(PG8_SA(0, 0), cA, voffA); PG8_STAGE_A(PG8_SA(0, 1), cA + hstep, voffA);
        if (wr == 1) PG8_BAR;
        PG8_WAIT_V(2); PG8_BAR;
        PG8_STAGE(PG8_SB(1, 0), cB + kstep, voffB); PG8_STAGE_A(PG8_SA(1, 0), cA + kstep, voffA); PG8_STAGE(PG8_SB(1, 1), cB + hstep + kstep, voffB);
        PG8_WAIT_V(6); PG8_BAR;
    } else {
        PG8_STAGE(PG8_SB(0, 0), cB, voffB); PG8_STAGE_A(PG8_SA(0, 0), cA, voffA); PG8_STAGE(PG8_SB(0, 1), cB + hstep, voffB); PG8_STAGE_A(PG8_SA(0, 1), cA + hstep, voffA);
        if (wr == 1) PG8_BAR;
        PG8_WAIT_V(4); PG8_BAR;
        PG8_STAGE(PG8_SB(1, 0), cB + kstep, voffB); PG8_STAGE_A(PG8_SA(1, 0), cA + kstep, voffA); PG8_STAGE(PG8_SB(1, 1), cB + hstep + kstep, voffB);
        PG8_WAIT_V(6); PG8_BAR;
    }
    for (;;) {
        const bool has_next = S.next(ui + 1, nxt);
        const char* nA = has_next ? (const char*)g.A + (size_t)nxt.pm * tstep : cA; const char* nB = has_next ? (const char*)g.Bt + (size_t)nxt.pn * tstep : cB;
        for (int t = 0; t < nt; t += 2) {
            const bool last = (t == nt - 2);
            const char* a1 = cA + (size_t)(t + 1) * kstep;
            const char* a2 = last ? nA : cA + (size_t)(t + 2) * kstep; const char* b2 = last ? nB : cB + (size_t)(t + 2) * kstep;
            const char* a3 = a2 + kstep; const char* b3 = b2 + kstep;
            if (last && has_next) S.a_ready(nxt);
            if constexpr (SP2) {
            PG8_LDB(B0, 0, 0); PG8_LDB(B1, 0, 1); PG8_SCHED; PG8_LDA(At, 0, 0); PG8_STAGE_A(PG8_SA(1, 1), a1 + hstep, voffA);
            PG8_WAIT_V(8); PG8_WAIT_L(0); PG8_BAR; PG8_MMA(0, 0, At, B0); PG8_MMA(0, 1, At, B1); PG8_BAR; PG8_SCHED;
            PG8_LDA(At, 0, 1); PG8_STAGE(PG8_SB(0, 0), b2, voffB); PG8_STAGE(PG8_SB(0, 1), b2 + hstep, voffB); PG8_STAGE_A(PG8_SA(0, 0), a2, voffA);
            PG8_WAIT_V(8); PG8_WAIT_L(0); PG8_BAR; PG8_MMA(1, 0, At, B0); PG8_MMA(1, 1, At, B1); PG8_BAR; PG8_SCHED;
            PG8_LDB(B0, 1, 0); PG8_LDB(B1, 1, 1); PG8_SCHED; PG8_LDA(At, 1, 0); PG8_STAGE_A(PG8_SA(0, 1), a2 + hstep, voffA);
            PG8_WAIT_V(8); PG8_WAIT_L(0); PG8_BAR; PG8_MMA(0, 0, At, B0); PG8_MMA(0, 1, At, B1); PG8_BAR; PG8_SCHED;
            PG8_LDA(At, 1, 1); PG8_STAGE(PG8_SB(1, 0), b3, voffB); PG8_STAGE(PG8_SB(1, 1), b3 + hstep, voffB); PG8_STAGE_A(PG8_SA(1, 0), a3, voffA);
            PG8_WAIT_V(8); PG8_WAIT_L(0); PG8_BAR; PG8_MMA(1, 0, At, B0); PG8_MMA(1, 1, At, B1); PG8_BAR; PG8_SCHED;
            } else {
            PG8_LDB(B0, 0, 0); PG8_SCHED; PG8_LDA(At, 0, 0); PG8_STAGE_A(PG8_SA(1, 1), a1 + hstep, voffA);
            PG8_WAIT_L(8); PG8_BAR; PG8_WAIT_L(0); PG8_MMA(0, 0, At, B0); PG8_BAR; PG8_SCHED;
            PG8_LDB(B1, 0, 1); PG8_STAGE(PG8_SB(0, 0), b2, voffB);
            PG8_BAR; PG8_WAIT_L(0); PG8_MMA(0, 1, At, B1); PG8_BAR;
            PG8_LDA(At, 0, 1); PG8_STAGE_A(PG8_SA(0, 0), a2, voffA);
            PG8_BAR; PG8_WAIT_L(0); PG8_MMA(1, 0, At, B0); PG8_BAR; PG8_SCHED;
            PG8_STAGE(PG8_SB(0, 1), b2 + hstep, voffB);
            PG8_WAIT_V(6); PG8_BAR; PG8_MMA(1, 1, At, B1); PG8_BAR;
            PG8_LDB(B0, 1, 0); PG8_SCHED; PG8_LDA(At, 1, 0); PG8_STAGE_A(PG8_SA(0, 1), a2 + hstep, voffA);
            PG8_WAIT_L(8); PG8_BAR; PG8_WAIT_L(0); PG8_MMA(0, 0, At, B0); PG8_BAR; PG8_SCHED;
            PG8_LDB(B1, 1, 1); PG8_STAGE(PG8_SB(1, 0), b3, voffB);
            PG8_BAR; PG8_WAIT_L(0); PG8_MMA(0, 1, At, B1); PG8_BAR;
            PG8_LDA(At, 1, 1); PG8_STAGE_A(PG8_SA(1, 0), a3, voffA);
            PG8_BAR; PG8_WAIT_L(0); PG8_MMA(1, 0, At, B0); PG8_BAR; PG8_SCHED;
            PG8_STAGE(PG8_SB(1, 1), b3 + hstep, voffB);
            PG8_WAIT_V(6); PG8_BAR; PG8_MMA(1, 1, At, B1); PG8_BAR;
            }
        }
        if constexpr (ALIGN_EPI) { if (wr == 0) PG8_BAR; }
        if constexpr (!Epi::AFTER_DRAIN) { E(acc, cur, wr, wc, fr, fq); S.done(cur); }
        if (!has_next) break;
#pragma unroll
        for (int a = 0; a < 2; ++a)
#pragma unroll
            for (int b = 0; b < 2; ++b)
#pragma unroll
                for (int m = 0; m < 4; ++m)
#pragma unroll
                    for (int n = 0; n < 2; ++n) acc[a][b][m][n] = (f32x4){0.f, 0.f, 0.f, 0.f};
        cur = nxt; cA = nA; cB = nB; ++ui;
        if constexpr (ALIGN_EPI) { if (wr == 1) PG8_BAR; }
    }
    PG8_WAIT_V(0);
    if constexpr (!ALIGN_EPI) { if (wr == 0) PG8_BAR; }
    PG8_BAR;
    if constexpr (Epi::AFTER_DRAIN) { E.fused(acc, cur, wr, wc, fr, fq, lds, wid, lane); S.done(cur); }
#undef PG8_SA
#undef PG8_SB
#undef PG8_STAGE
#undef PG8_STAGE_A
#undef PG8_STAGE_X
#undef PG8_LDA
#undef PG8_LDB
#undef PG8_MMA
#undef PG8_WAIT_V
#undef PG8_WAIT_L
#undef PG8_BAR
#undef PG8_SCHED
}
}

#ifndef SCALE_MIX
#define SCALE_MIX 1.0f
#endif
#ifndef SCALE_FFN
#define SCALE_FFN 1.0f
#endif
namespace mk {
#ifdef ZERO_SSD
constexpr float ZS = 0.f;
#elif defined(SC_SSD)
constexpr float ZS = SC_SSD;
#else
constexpr float ZS = 1.f;
#endif
#ifdef ZERO_FOX
constexpr float ZF = 0.f;
#elif defined(SC_FOX)
constexpr float ZF = SC_FOX;
#else
constexpr float ZF = 1.f;
#endif
#ifdef ZERO_SC
constexpr float ZC = 0.f;
#elif defined(SC_SC)
constexpr float ZC = SC_SC;
#else
constexpr float ZC = 1.f;
#endif
using pg8::bf16_t; using pg8::bf16x8; using pg8::f32x4; using pg8::u32x4;
typedef unsigned u32x2 __attribute__((ext_vector_type(2)));
constexpr int DM = 1024, BATCH = 4, SEQ = 4096, MROWS = BATCH * SEQ, DFF = 2816, NFF = 2 * DFF, NPROJ = 3072, NMOD = 9216;
constexpr int NT = 512, NW = 8;
constexpr float ALPHA = 1.4142135623730951f, LN_EPS = 1e-5f, RMS_EPS = 1e-5f, LOG2E = 1.4426950408889634f;
constexpr int PC_Z = 0, PC_XBC = 512, PC_Q = 1536, PC_K = 1792, PC_V = 2048, PC_SB = 2304, PC_SC = 2560, PC_SX = 2816;
constexpr size_t MiB = 1u << 20;
constexpr size_t WS_MOD = 0, WS_WMISC = 1 * MiB, WS_DTF = 2 * MiB, WS_CDEC = 3 * MiB, WS_BAR = 3 * MiB + 512 * 1024, WS_W = 4 * MiB;
constexpr size_t W_L = 41 * MiB;
constexpr size_t WO_1IN = 0, WO_1OUT = 11 * MiB, WO_MI = 11 * MiB + 5632 * 1024, WO_MO = WO_MI + 6 * MiB, WO_2IN = WO_MO + 2 * MiB, WO_2OUT = WO_2IN + 11 * MiB;
static_assert(WO_2OUT + 5632 * 1024 == W_L, "weight map");
constexpr size_t WS_HB = WS_W + 2 * W_L;
constexpr size_t WS_BIG = WS_HB + 32 * MiB;
constexpr size_t WS_YCAT = WS_BIG + 96 * MiB;
constexpr size_t WS_ST = WS_YCAT + 32 * MiB;
constexpr size_t WS_END = WS_ST + 32 * MiB;
constexpr int LDS_BYTES = 147456;

struct Args { const float* in[22]; float* out; unsigned char* ws; };
typedef const __attribute__((address_space(4))) Args* CArgsP;
__device__ __forceinline__ CArgsP get_args() { CArgsP p = (CArgsP)__builtin_amdgcn_kernarg_segment_ptr(); asm volatile("" : "+s"(p)); return p; }

typedef float f32x2_t __attribute__((ext_vector_type(2))); typedef __bf16 bf16x2_t __attribute__((ext_vector_type(2)));
__device__ __forceinline__ float bf_lo(unsigned w) { return __uint_as_float(w << 16); }
__device__ __forceinline__ float bf_hi(unsigned w) { return __uint_as_float(w & 0xffff0000u); }
__device__ __forceinline__ float bf2f(bf16_t v) { return __uint_as_float((unsigned)v << 16); }
#ifdef DEGRADE_BF16
__device__ __forceinline__ unsigned pk2(float lo, float hi) { return DEGRADE_OP(pg8::cvt_pk_bf16(lo, hi)); }
#elif defined(MANUAL_RNE)
__device__ __forceinline__ unsigned f2bf_rne_(float f) { unsigned u = __builtin_bit_cast(unsigned, f); return (u + 0x7fffu + ((u >> 16) & 1u)) >> 16; }
__device__ __forceinline__ unsigned pk2(float lo, float hi) { return f2bf_rne_(lo) | (f2bf_rne_(hi) << 16); }
#else
__device__ __forceinline__ unsigned pk2(float lo, float hi) { return pg8::cvt_pk_bf16(lo, hi); }
#endif
#ifdef DEGRADE_W
__device__ __forceinline__ unsigned pk2w(float lo, float hi) { return pg8::cvt_pk_bf16(lo, hi) & 0xFFFEFFFEu; }
#else
__device__ __forceinline__ unsigned pk2w(float lo, float hi) { return pg8::cvt_pk_bf16(lo, hi); }
#endif
__device__ __forceinline__ bf16_t f2bf(float f) { return (bf16_t)(pk2(f, 0.f) & 0xffffu); }
#ifndef DEG_SITES
#define DEG_SITES 0
#endif
template <int S> __device__ __forceinline__ unsigned pk2t(float lo, float hi) { unsigned r; if constexpr (S >= 2) { f32x2_t v_ = {lo, hi}; r = __builtin_bit_cast(unsigned, __builtin_convertvector(v_, bf16x2_t)); } else r = pg8::cvt_pk_bf16(lo, hi); if ((DEG_SITES >> S) & 1) r &= 0xFFFEFFFEu; return r; }
template <int S> __device__ __forceinline__ bf16_t f2bft(float f) { return (bf16_t)(pk2t<S>(f, 0.f) & 0xffffu); }
__device__ __forceinline__ float siluf(float v) { return v * __builtin_amdgcn_rcpf(1.f + __builtin_amdgcn_exp2f(-v * LOG2E)); }
__device__ __forceinline__ float wave_sum(float v) {
#pragma unroll
    for (int o = 1; o < 64; o <<= 1) v += __shfl_xor(v, o);
    return v;
}
__device__ __forceinline__ float wave_incl_scan(float v, int lane) {
#pragma unroll
    for (int o = 1; o < 64; o <<= 1) { const float t = __shfl_up(v, o); if (lane >= o) v += t; }
    return v;
}
__device__ __forceinline__ void unpack8(const u32x4 r, float (&f)[8]) {
    f[0] = bf_lo(r.x); f[1] = bf_hi(r.x); f[2] = bf_lo(r.y); f[3] = bf_hi(r.y); f[4] = bf_lo(r.z); f[5] = bf_hi(r.z); f[6] = bf_lo(r.w); f[7] = bf_hi(r.w);
}
template <class T> __device__ __forceinline__ T ldx(const T* p) {
    if constexpr (sizeof(T) == 16) { const unsigned long long* q = (const unsigned long long*)p; struct { unsigned long long a, b; } r;
        r.a = __hip_atomic_load(q, __ATOMIC_RELAXED, __HIP_MEMORY_SCOPE_AGENT); r.b = __hip_atomic_load(q + 1, __ATOMIC_RELAXED, __HIP_MEMORY_SCOPE_AGENT); return __builtin_bit_cast(T, r); }
    else if constexpr (sizeof(T) == 4) { const unsigned v = __hip_atomic_load((const unsigned*)p, __ATOMIC_RELAXED, __HIP_MEMORY_SCOPE_AGENT); return __builtin_bit_cast(T, v); }
    else { static_assert(sizeof(T) == 2, "ldx"); const unsigned short v = __hip_atomic_load((const unsigned short*)p, __ATOMIC_RELAXED, __HIP_MEMORY_SCOPE_AGENT); return __builtin_bit_cast(T, v); }
}
template <class T> __device__ __forceinline__ T ldxb(const void* ubase, unsigned off) {
    static_assert(sizeof(T) == 16, "ldxb");
    __amdgpu_buffer_rsrc_t r = __builtin_amdgcn_make_buffer_rsrc(const_cast<void*>(ubase), 0, 0x7fffffff, 0x00020000);
    return __builtin_bit_cast(T, __builtin_amdgcn_raw_buffer_load_b128(r, off, 0, 16));
}
#define LDS_WAIT() asm volatile("s_waitcnt lgkmcnt(0)" ::: "memory")

__device__ __forceinline__ int srcmap(int mode, int r0) {
    if (mode == 1) { const int pn = r0 >> 8, j = r0 & 255; return j < 128 ? pn * 128 + j : DFF + pn * 128 + (j - 128); }
    if (mode == 2) { return r0 < 1536 ? r0 : (r0 < 2304 ? r0 + 8 : r0 + 12); }
    return r0;
}
__device__ __forceinline__ void p0_item(const float* __restrict__ W, int K, int Nsrc, int Ndst, bf16_t* __restrict__ WT, int mode, float* scr, int item, int lane) {
    const int nblk = Ndst / 32, kb = item / nblk, nb = item % nblk, k0 = 64 * kb, r0 = 32 * nb, s0 = srcmap(mode, r0);
#pragma unroll 8
    for (int i = 0; i < 32; ++i) { const int kk = 2 * i + (lane >> 5); scr[kk * 33 + (lane & 31)] = W[(size_t)(k0 + kk) * Nsrc + s0 + (lane & 31)]; }
    LDS_WAIT();
    const int c = lane & 7;
#pragma unroll
    for (int j = 0; j < 4; ++j) { const int n = (lane >> 3) + 8 * j; const float* s = scr + (8 * c) * 33 + n;
        u32x4 o; o.x = pk2w(s[0 * 33], s[1 * 33]); o.y = pk2w(s[2 * 33], s[3 * 33]); o.z = pk2w(s[4 * 33], s[5 * 33]); o.w = pk2w(s[6 * 33], s[7 * 33]);
        *(u32x4*)(WT + (size_t)(r0 + n) * K + k0 + 8 * c) = o; }
    LDS_WAIT();
}
__device__ __forceinline__ void phase_p0(CArgsP a, unsigned char* lds, int tid, int wave, int lane) {
    float* mod = (float*)(a->ws + WS_MOD);
    float* sc = (float*)(lds + 69632);
    float* red = (float*)(lds + 69632 + 16384);
    for (int i = tid; i < 4096; i += NT) { const float v = a->in[1][i]; sc[i] = v / (1.f + expf(-v)); }
    __syncthreads();
    for (int it = blockIdx.x; it < 288; it += gridDim.x) {
        const int l = it / 144, cgp = it % 144, col = cgp * 64 + lane, k0 = wave * 128;
        const float* Wp = a->in[4] + (size_t)l * DM * NMOD + (size_t)k0 * NMOD + col;
        float a0 = 0.f, a1 = 0.f, a2 = 0.f, a3 = 0.f;
#pragma unroll 16
        for (int k = 0; k < 128; ++k) { const float w = Wp[(size_t)k * NMOD];
            a0 += sc[k0 + k] * w; a1 += sc[1024 + k0 + k] * w; a2 += sc[2048 + k0 + k] * w; a3 += sc[3072 + k0 + k] * w; }
        red[(wave * 4 + 0) * 64 + lane] = a0; red[(wave * 4 + 1) * 64 + lane] = a1; red[(wave * 4 + 2) * 64 + lane] = a2; red[(wave * 4 + 3) * 64 + lane] = a3;
        __syncthreads();
        if (tid < 256) { const int b = tid >> 6, ln = tid & 63; float s = 0.f;
#pragma unroll
            for (int w = 0; w < 8; ++w) s += red[(w * 4 + b) * 64 + ln];
            mod[(size_t)(l * 4 + b) * NMOD + cgp * 64 + ln] = s + a->in[5][l * NMOD + cgp * 64 + ln]; }
        __syncthreads();
    }
    { float* wm = (float*)(a->ws + WS_WMISC);
      for (int i = blockIdx.x * NT + tid; i < 2 * 12 * 1024; i += gridDim.x * NT) { const int l = i / 12288, r = i % 12288, j = r / 1024, k = r % 1024;
          const int colj = j < 8 ? 1536 + j : 2312 + (j - 8); wm[i] = a->in[8][(size_t)l * DM * 3084 + (size_t)k * 3084 + colj]; } }
    float* scr = (float*)(lds + wave * 8448);
    const int gw = blockIdx.x * NW + wave, NGW = gridDim.x * NW;
    constexpr int I_IN = 16 * (NFF / 32), I_OUT = (DFF / 64) * 32, I_MI = 16 * (NPROJ / 32), I_MO = 16 * 32, I_L = 2 * I_IN + 2 * I_OUT + I_MI + I_MO;
    for (int it = gw; it < 2 * I_L; it += NGW) {
        const int l = it / I_L; int r = it % I_L; unsigned char* wl = a->ws + WS_W + l * W_L;
        if (r < I_IN) { p0_item(a->in[6] + (size_t)l * DM * NFF, DM, NFF, NFF, (bf16_t*)(wl + WO_1IN), 1, scr, r, lane); continue; } r -= I_IN;
        if (r < I_IN) { p0_item(a->in[18] + (size_t)l * DM * NFF, DM, NFF, NFF, (bf16_t*)(wl + WO_2IN), 1, scr, r, lane); continue; } r -= I_IN;
        if (r < I_OUT) { p0_item(a->in[7] + (size_t)l * DFF * DM, DFF, DM, DM, (bf16_t*)(wl + WO_1OUT), 0, scr, r, lane); continue; } r -= I_OUT;
        if (r < I_OUT) { p0_item(a->in[19] + (size_t)l * DFF * DM, DFF, DM, DM, (bf16_t*)(wl + WO_2OUT), 0, scr, r, lane); continue; } r -= I_OUT;
        if (r < I_MI) { p0_item(a->in[8] + (size_t)l * DM * 3084, DM, 3084, NPROJ, (bf16_t*)(wl + WO_MI), 2, scr, r, lane); continue; } r -= I_MI;
        p0_item(a->in[9] + (size_t)l * DM * DM, DM, DM, DM, (bf16_t*)(wl + WO_MO), 0, scr, r, lane);
    }
}

template <bool MISC>
__device__ __forceinline__ void phase_ln(const float* src, float* X, bf16_t* Hb, const float* gamma, const float* beta, const float* modl, int sub, bool write_h,
                                         const float* wm, float* DTF, unsigned char* lds, int tid, int wave, int lane) {
    float* wml = (float*)lds;
    if (MISC) { for (int i = tid; i < 12288; i += NT) wml[i] = wm[i]; __syncthreads(); }
    const int gw = blockIdx.x * NW + wave, NGW = gridDim.x * NW;
    f32x4 g4[4], b4[4];
#pragma unroll
    for (int j = 0; j < 4; ++j) { g4[j] = *(const f32x4*)(gamma + 4 * lane + 256 * j); b4[j] = *(const f32x4*)(beta + 4 * lane + 256 * j); }
    for (int blk = gw; blk < MROWS / 8; blk += NGW) {
        const int m0 = blk * 8, b = m0 / SEQ;
        const float* shp = modl + (size_t)b * NMOD + (sub * 3 + 0) * DM; const float* scp = modl + (size_t)b * NMOD + (sub * 3 + 1) * DM;
        f32x4 sh4[4], sc4[4];
#pragma unroll
        for (int j = 0; j < 4; ++j) { if (write_h) { sh4[j] = *(const f32x4*)(shp + 4 * lane + 256 * j); sc4[j] = *(const f32x4*)(scp + 4 * lane + 256 * j) + 1.0f; } else { sh4[j] = (f32x4){0.f, 0.f, 0.f, 0.f}; sc4[j] = sh4[j]; } }
#pragma unroll 2
        for (int i = 0; i < 8; ++i) {
            const size_t m = (size_t)(m0 + i);
            f32x4 v[4]; float s = 0.f;
#pragma unroll
            for (int j = 0; j < 4; ++j) { v[j] = ldxb<f32x4>(src, (unsigned)((m * DM + 4 * lane + 256 * j) * 4)); s += (v[j].x + v[j].y) + (v[j].z + v[j].w); }
            const float mean = wave_sum(s) * (1.f / DM); float s2 = 0.f;
#pragma unroll
            for (int j = 0; j < 4; ++j) { v[j] = v[j] - mean; s2 += (v[j].x * v[j].x + v[j].y * v[j].y) + (v[j].z * v[j].z + v[j].w * v[j].w); }
            const float rstd = 1.f / sqrtf(wave_sum(s2) * (1.f / DM) + LN_EPS);
#pragma unroll
            for (int j = 0; j < 4; ++j) { v[j] = v[j] * rstd * g4[j] + b4[j]; *(f32x4*)(X + m * DM + 4 * lane + 256 * j) = v[j]; }
            if (write_h) {
#pragma unroll
                for (int j = 0; j < 4; ++j) { v[j] = v[j] * sc4[j] + sh4[j]; u32x2 w; w.x = pk2t<0>(v[j].x, v[j].y); w.y = pk2t<0>(v[j].z, v[j].w); *(u32x2*)(Hb + m * DM + 4 * lane + 256 * j) = w; }
                if (MISC) {
                    float keep = 0.f;
#pragma unroll
                    for (int jj = 0; jj < 12; ++jj) { float d = 0.f;
#pragma unroll
                        for (int j = 0; j < 4; ++j) { const f32x4 w4 = *(const f32x4*)(wml + jj * 1024 + 4 * lane + 256 * j); d += (v[j].x * w4.x + v[j].y * w4.y) + (v[j].z * w4.z + v[j].w * w4.w); }
                        d = wave_sum(d); if (lane == jj) keep = d; }
                    if (lane < 12) DTF[m * 12 + lane] = keep;
                }
            }
        }
    }
}

struct EpiMulti {
    static constexpr bool PERM = true, AFTER_DRAIN = false;
    int code;
    __device__ __forceinline__ void operator()(const f32x4 (&acc)[2][2][4][2], const pg8::Unit& u, int wr, int wc, int fr, int fq) const {
        CArgsP a = get_args(); int cd = code; asm volatile("" : "+s"(cd)); const int s = cd & 255, l = cd >> 8;
        unsigned char* ws = a->ws;
        if (s == 0 || s == 9) {
            bf16_t* O = (bf16_t*)(ws + WS_BIG);
            const int row0 = u.pm * 256 + wr * 64 + fr, col0 = u.pn * 128 + wc * 32 + 8 * fq;
#pragma unroll
            for (int ai = 0; ai < 2; ++ai)
#pragma unroll
                for (int m = 0; m < 4; ++m) {
                    const f32x4 g0 = acc[ai][0][m][0], g1 = acc[ai][0][m][1], u0 = acc[ai][1][m][0], u1 = acc[ai][1][m][1];
                    u32x4 w;
                    w.x = pk2t<1>(siluf(g0[0]) * u0[0], siluf(g0[1]) * u0[1]); w.y = pk2t<1>(siluf(g0[2]) * u0[2], siluf(g0[3]) * u0[3]);
                    w.z = pk2t<1>(siluf(g1[0]) * u1[0], siluf(g1[1]) * u1[1]); w.w = pk2t<1>(siluf(g1[2]) * u1[2], siluf(g1[3]) * u1[3]);
                    *(u32x4*)(O + (size_t)(row0 + ai * 128 + m * 16) * DFF + col0) = w;
                }
        } else if (s == 3) {
            bf16_t* O = (bf16_t*)(ws + WS_BIG);
            const int row0 = u.pm * 256 + wr * 64 + fr, col0 = u.pn * 256 + wc * 32 + 8 * fq;
#pragma unroll
            for (int ai = 0; ai < 2; ++ai)
#pragma unroll
                for (int m = 0; m < 4; ++m)
#pragma unroll
                    for (int bj = 0; bj < 2; ++bj) { const f32x4 v0 = acc[ai][bj][m][0], v1 = acc[ai][bj][m][1];
                        u32x4 w; w.x = pk2t<1>(v0[0], v0[1]); w.y = pk2t<1>(v0[2], v0[3]); w.z = pk2t<1>(v1[0], v1[1]); w.w = pk2t<1>(v1[2], v1[3]);
                        *(u32x4*)(O + (size_t)(row0 + ai * 128 + m * 16) * NPROJ + col0 + bj * 128) = w; }
        } else {
            const int sub = s == 1 ? 0 : (s == 7 ? 1 : 2);
#ifdef ZERO_FFN
            const float coef = s == 7 ? 1.0f : 0.0f;
#elif defined(ZERO_MIX)
            const float coef = s == 7 ? 0.0f : 0.5f;
#else
            const float coef = s == 7 ? 1.0f * SCALE_MIX : 0.5f * SCALE_FFN;
#endif
            float* X = a->out; const float* gate = (const float*)(ws + WS_MOD) + (size_t)l * 4 * NMOD + (sub * 3 + 2) * DM;
            const int b = u.pm >> 4, col0 = u.pn * 256 + wc * 32 + 8 * fq;
#pragma unroll
            for (int bj = 0; bj < 2; ++bj)
#pragma unroll
                for (int n = 0; n < 2; ++n) {
                    const int c = col0 + bj * 128 + n * 4;
                    const f32x4 gv = *(const f32x4*)(gate + (size_t)b * NMOD + c) * coef;
#pragma unroll
                    for (int ai = 0; ai < 2; ++ai)
#pragma unroll
                        for (int m = 0; m < 4; ++m) { float* p = X + (size_t)(u.pm * 256 + ai * 128 + wr * 64 + m * 16 + fr) * DM + c;
                            const f32x4 xv = ldxb<f32x4>(X, (unsigned)((size_t)(p - X) * 4));
#ifdef SKIP_T
                            const int rr_ = (u.pm * 256 + ai * 128 + wr * 64 + m * 16 + fr) & 4095; const float km_ = (s == 7 && rr_ >= SKIP_T0 && rr_ < SKIP_T) ? 0.f : 1.f;
                            *(f32x4*)p = xv * ALPHA + gv * acc[ai][bj][m][n] * km_; }
#else
                            *(f32x4*)p = xv * ALPHA + gv * acc[ai][bj][m][n]; }
#endif
                }
        }
    }
};

__device__ __forceinline__ void ssd_dt_acs(const float* DTF, const float* dt_bias, const float* a_log, int R0, int g, int wave, int lane, float* sDt, float* sAcs) {
    if (wave < 4) { const int h = g * 4 + wave; const float x = ldx(DTF + (size_t)(R0 + lane) * 12 + h) + dt_bias[h];
        const float dt = x > 20.f ? x : log1pf(expf(x)); const float av = -expf(a_log[h]) * dt; const float cs = wave_incl_scan(av, lane);
        sDt[wave * 64 + lane] = dt; sAcs[wave * 64 + lane] = cs; }
}
__device__ __forceinline__ void conv8(const bf16_t* PROJ, int b, int t, int cc, const float* cw, const float* cb, float (&o)[8]) {
    { const f32x4 b0 = *(const f32x4*)(cb + cc), b1 = *(const f32x4*)(cb + cc + 4); o[0] = b0.x; o[1] = b0.y; o[2] = b0.z; o[3] = b0.w; o[4] = b1.x; o[5] = b1.y; o[6] = b1.z; o[7] = b1.w; }
#pragma unroll
    for (int k = 0; k < 4; ++k) { const int tt = t - 3 + k;
        if (tt >= 0) { const u32x4 raw = ldxb<u32x4>(PROJ, (unsigned)(((size_t)(b * SEQ + tt) * NPROJ + PC_XBC + cc) * 2)); float x[8]; unpack8(raw, x);
            const f32x4 w0 = *(const f32x4*)(cw + k * 1024 + cc), w1 = *(const f32x4*)(cw + k * 1024 + cc + 4);
            o[0] += w0.x * x[0]; o[1] += w0.y * x[1]; o[2] += w0.z * x[2]; o[3] += w0.w * x[3]; o[4] += w1.x * x[4]; o[5] += w1.y * x[5]; o[6] += w1.z * x[6]; o[7] += w1.w * x[7]; } }
#pragma unroll
    for (int j = 0; j < 8; ++j) o[j] = siluf(o[j]);
}

__device__ __forceinline__ void phase_ma(CArgsP a, int l, unsigned char* lds, int tid, int wave, int lane) {
    const bf16_t* PROJ = (const bf16_t*)(a->ws + WS_BIG); bf16_t* YCAT = (bf16_t*)(a->ws + WS_YCAT); bf16_t* ST = (bf16_t*)(a->ws + WS_ST);
    const float* DTF = (const float*)(a->ws + WS_DTF); float* CDEC = (float*)(a->ws + WS_CDEC);
    const float* cw = a->in[10] + (size_t)l * 4 * 1024; const float* cb = a->in[11] + l * 1024; const float* dtb = a->in[12] + l * 8; const float* alog = a->in[13] + l * 8;
    const int fr = lane & 15, fq = lane >> 4;
    bf16_t* sBT = (bf16_t*)lds;
    bf16_t* sXT = (bf16_t*)(lds + 18432);
    float* sDt = (float*)(lds + 18432 + 36864);
    float* sAcs = sDt + 256;
    for (int it = blockIdx.x; it < 512; it += gridDim.x) {
        const int b = it >> 7, c = (it >> 1) & 63, g = it & 1, t0 = c * 64, R0 = b * SEQ + t0;
        ssd_dt_acs(DTF, dtb, alog, R0, g, wave, lane, sDt, sAcs);
        __syncthreads();
        if (wave < 4 && lane == 63) CDEC[(b * 64 + c) * 8 + g * 4 + wave] = expf(sAcs[wave * 64 + 63]);
#pragma unroll 2
        for (int o = tid; o < 3072; o += NT) {
            float v[8];
            if (o < 1024) { const int ll = o >> 4, n = (o & 15) * 8; conv8(PROJ, b, t0 + ll, 512 + g * 128 + n, cw, cb, v);
#pragma unroll
                for (int j = 0; j < 8; ++j) sBT[(n + j) * 72 + ll] = f2bft<2>(v[j]); }
            else { const int o2 = o - 1024, ll = o2 >> 5, ch = (o2 & 31) * 8, e = ch >> 6, p = ch & 63; conv8(PROJ, b, t0 + ll, g * 256 + ch, cw, cb, v);
                const float wgt = sDt[e * 64 + ll] * expf(sAcs[e * 64 + 63] - sAcs[e * 64 + ll]);
#pragma unroll
                for (int j = 0; j < 8; ++j) sXT[(e * 64 + p + j) * 72 + ll] = f2bft<2>(v[j] * wgt); }
        }
        __syncthreads();
        { const int e = wave >> 1, nh = wave & 1;
          f32x4 acc[4][4];
#pragma unroll
          for (int i = 0; i < 4; ++i)
#pragma unroll
              for (int j = 0; j < 4; ++j) acc[i][j] = (f32x4){0.f, 0.f, 0.f, 0.f};
#pragma unroll
          for (int kk = 0; kk < 2; ++kk) {
              bf16x8 af[4], bfr[4];
#pragma unroll
              for (int i = 0; i < 4; ++i) af[i] = *(const bf16x8*)(sBT + (nh * 64 + 16 * i + fr) * 72 + 32 * kk + 8 * fq);
#pragma unroll
              for (int j = 0; j < 4; ++j) bfr[j] = *(const bf16x8*)(sXT + (e * 64 + 16 * j + fr) * 72 + 32 * kk + 8 * fq);
#pragma unroll
              for (int i = 0; i < 4; ++i)
#pragma unroll
                  for (int j = 0; j < 4; ++j) acc[i][j] = __builtin_amdgcn_mfma_f32_16x16x32_bf16(af[i], bfr[j], acc[i][j], 0, 0, 0);
          }
          bf16_t* sp = ST + (size_t)((b * 64 + c) * 8 + g * 4 + e) * 8192;
#pragma unroll
          for (int i = 0; i < 4; ++i)
#pragma unroll
              for (int j = 0; j < 4; ++j) { u32x2 w; w.x = pk2t<2>(acc[i][j][0], acc[i][j][1]); w.y = pk2t<2>(acc[i][j][2], acc[i][j][3]);
                  *(u32x2*)(sp + (16 * j + fr) * 128 + nh * 64 + 16 * i + 4 * fq) = w; }
        }
        __syncthreads();
    }
    { const float* sw = a->in[17] + (size_t)l * 3 * 256;
      for (int op = blockIdx.x * NT + tid; op < MROWS * 32; op += gridDim.x * NT) {
          const int m = op >> 5, ch = (op & 31) * 8, t = m & (SEQ - 1);
          float acc[8];
#pragma unroll
          for (int j = 0; j < 8; ++j) acc[j] = 0.f;
#pragma unroll
          for (int k = 0; k < 3; ++k) { const int tt = t - 2 + k;
              if (tt >= 0) { const unsigned ro = (unsigned)((size_t)(m - 2 + k) * NPROJ * 2); float cg[8], xi[8]; unpack8(ldxb<u32x4>(PROJ, ro + (PC_SC + ch) * 2), cg); unpack8(ldxb<u32x4>(PROJ, ro + (PC_SX + ch) * 2), xi);
                  const f32x4 w0 = *(const f32x4*)(sw + k * 256 + ch), w1 = *(const f32x4*)(sw + k * 256 + ch + 4);
                  acc[0] += w0.x * (cg[0] * xi[0]); acc[1] += w0.y * (cg[1] * xi[1]); acc[2] += w0.z * (cg[2] * xi[2]); acc[3] += w0.w * (cg[3] * xi[3]);
                  acc[4] += w1.x * (cg[4] * xi[4]); acc[5] += w1.y * (cg[5] * xi[5]); acc[6] += w1.z * (cg[6] * xi[6]); acc[7] += w1.w * (cg[7] * xi[7]); } }
          float bg[8]; unpack8(ldxb<u32x4>(PROJ, (unsigned)(((size_t)m * NPROJ + PC_SB + ch) * 2)), bg);
#pragma unroll
          for (int j = 0; j < 8; ++j) bg[j] *= ZC;
          u32x4 w; w.x = pk2t<6>(bg[0] * acc[0], bg[1] * acc[1]); w.y = pk2t<6>(bg[2] * acc[2], bg[3] * acc[3]); w.z = pk2t<6>(bg[4] * acc[4], bg[5] * acc[5]); w.w = pk2t<6>(bg[6] * acc[6], bg[7] * acc[7]);
          *(u32x4*)(YCAT + (size_t)m * DM + 768 + ch) = w;
      } }
}

__device__ __forceinline__ void phase_mb(CArgsP a, int l, unsigned char* lds, int tid, int wave, int lane) {
    const bf16_t* PROJ = (const bf16_t*)(a->ws + WS_BIG); bf16_t* YCAT = (bf16_t*)(a->ws + WS_YCAT);
    const float* DTF = (const float*)(a->ws + WS_DTF); const float* CDEC = (const float*)(a->ws + WS_CDEC);
    { unsigned* ST = (unsigned*)(a->ws + WS_ST);
      for (int gid = blockIdx.x * NT + tid; gid < 32 * 4096; gid += gridDim.x * NT) {
          const int bh = gid >> 12, rem = gid & 4095, b = bh >> 3, h = bh & 7;
          float r0 = 0.f, r1 = 0.f;
          for (int c0 = 0; c0 < 64; c0 += 8) {
              unsigned w[8]; float d[8];
#pragma unroll
              for (int i = 0; i < 8; ++i) { w[i] = ldx(ST + (size_t)((b * 64 + c0 + i) * 8 + h) * 4096 + rem); d[i] = ldx(CDEC + (b * 64 + c0 + i) * 8 + h); }
#pragma unroll
              for (int i = 0; i < 8; ++i) { ST[(size_t)((b * 64 + c0 + i) * 8 + h) * 4096 + rem] = pk2t<3>(r0, r1); r0 = r0 * d[i] + bf_lo(w[i]); r1 = r1 * d[i] + bf_hi(w[i]); }
          }
      } }
#ifdef NAIVE_ATTN
    { const float* fbias_ = a->in[16] + l * 4;
      for (int row = blockIdx.x * NT + tid; row < 16 * SEQ; row += gridDim.x * NT) {
          const int bh = row >> 12, q = row & 4095, b = bh >> 2, h = bh & 3; const float fb = fbias_[h];
          float qv[64], o[64];
#pragma unroll
          for (int d = 0; d < 64; ++d) { qv[d] = bf2f(ldx(PROJ + (size_t)(b * SEQ + q) * NPROJ + PC_Q + h * 64 + d)); o[d] = 0.f; }
          float m = -INFINITY, lsum = 0.f, bias = 0.f;
          for (int k = q; k >= 0; --k) {
              const bf16_t* kp = PROJ + (size_t)(b * SEQ + k) * NPROJ + PC_K + h * 64;
              float s = 0.f;
#pragma unroll
              for (int d8 = 0; d8 < 8; ++d8) { float kv[8]; unpack8(ldx((const u32x4*)(kp + d8 * 8)), kv);
#pragma unroll
                  for (int j = 0; j < 8; ++j) s += qv[d8 * 8 + j] * kv[j]; }
              s = s * 0.125f + bias;
              const float mn = fmaxf(m, s), al = expf(m - mn), p = expf(s - mn);
              lsum = lsum * al + p; m = mn;
#pragma unroll
              for (int d8 = 0; d8 < 8; ++d8) { float vv[8]; unpack8(ldx((const u32x4*)(kp + (PC_V - PC_K) + d8 * 8)), vv);
#pragma unroll
                  for (int j = 0; j < 8; ++j) o[d8 * 8 + j] = o[d8 * 8 + j] * al + p * vv[j]; }
              const float x = ldx(DTF + (size_t)(b * SEQ + k) * 12 + 8 + h) + fb; bias += fminf(x, 0.f) - log1pf(expf(-fabsf(x)));
          }
          const float inv = 1.f / lsum;
#pragma unroll
          for (int d = 0; d < 64; ++d) YCAT[(size_t)(b * SEQ + q) * DM + 512 + h * 64 + d] = f2bft<4>(o[d] * inv);
      } }
#endif
    const int fr = lane & 15, fq = lane >> 4;
    float* cf2 = (float*)lds;
    bf16_t* sK = (bf16_t*)(lds + 16384);
    bf16_t* sV = (bf16_t*)(lds + 16384 + 18432);
    float* wtot = (float*)(lds + 16384 + 36864);
    const float* fbias = a->in[16] + l * 4;
    constexpr float C2 = 0.125f * LOG2E;
#ifdef NAIVE_ATTN
    for (int v = 256; v < 256; v += gridDim.x) {
#else
    for (int v = blockIdx.x; v < 256; v += gridDim.x) {
#endif
        const int bh = v >> 4, s = v & 15, b = bh >> 2, h = bh & 3;
        __syncthreads();
        { float vals[8]; float run = 0.f; const float fb = fbias[h];
#pragma unroll
          for (int i = 0; i < 8; ++i) { const float x = ldx(DTF + (size_t)(b * SEQ + tid * 8 + i) * 12 + 8 + h) + fb; const float ls = fminf(x, 0.f) - log1pf(expf(-fabsf(x))); run += ls * LOG2E; vals[i] = run; }
          const float inc = wave_incl_scan(run, lane); if (lane == 63) wtot[wave] = inc;
          __syncthreads();
          float off = inc - run; for (int w = 0; w < wave; ++w) off += wtot[w];
#pragma unroll
          for (int i = 0; i < 8; ++i) cf2[tid * 8 + i] = vals[i] + off;
          __syncthreads(); }
        for (int uu = 0; uu < 2; ++uu) {
            const int qb = uu ? 31 - s : s, q0 = qb * 128, nt = 2 * (qb + 1);
            const int qw0 = q0 + wave * 16, qrow = qw0 + fr;
            const bf16_t* qp = PROJ + (size_t)(b * SEQ + qrow) * NPROJ + PC_Q + h * 64 + fq * 8;
            const bf16x8 qf0 = ldxb<bf16x8>(PROJ, (unsigned)((size_t)(qp - PROJ) * 2)), qf1 = ldxb<bf16x8>(PROJ, (unsigned)((size_t)(qp - PROJ) * 2 + 64));
            const float cfq = cf2[qrow];
            float mrun = -INFINITY, lrun = 0.f; f32x4 o[4];
#pragma unroll
            for (int j = 0; j < 4; ++j) o[j] = (f32x4){0.f, 0.f, 0.f, 0.f};
            const int key = tid >> 3, dch = tid & 7;
            const bf16_t* kp = PROJ + (size_t)(b * SEQ + key) * NPROJ + PC_K + h * 64 + dch * 8;
            const unsigned kpo = (unsigned)((size_t)(kp - PROJ) * 2); u32x4 kreg = ldxb<u32x4>(PROJ, kpo), vreg = ldxb<u32x4>(PROJ, kpo + (PC_V - PC_K) * 2);
            for (int kt = 0; kt < nt; ++kt) {
                const int buf = kt & 1; bf16_t* sKb = sK + buf * 4608; bf16_t* sVb = sV + buf * 4608;
                *(u32x4*)(sKb + key * 72 + dch * 8) = kreg;
                { bf16_t* vd = sVb + (dch * 8) * 72 + key;
                  vd[0 * 72] = (bf16_t)(vreg.x & 0xffffu); vd[1 * 72] = (bf16_t)(vreg.x >> 16); vd[2 * 72] = (bf16_t)(vreg.y & 0xffffu); vd[3 * 72] = (bf16_t)(vreg.y >> 16);
                  vd[4 * 72] = (bf16_t)(vreg.z & 0xffffu); vd[5 * 72] = (bf16_t)(vreg.z >> 16); vd[6 * 72] = (bf16_t)(vreg.w & 0xffffu); vd[7 * 72] = (bf16_t)(vreg.w >> 16); }
                __syncthreads();
                if (kt + 1 < nt) { const unsigned kno = kpo + (unsigned)(kt + 1) * 64u * NPROJ * 2u; kreg = ldxb<u32x4>(PROJ, kno); vreg = ldxb<u32x4>(PROJ, kno + (PC_V - PC_K) * 2); }
                const int k0 = kt * 64;
#ifdef NOSKIP
                if (true) {
#else
                if (k0 <= qw0 + 15) {
#endif
                    f32x4 sc[4];
#pragma unroll
                    for (int j = 0; j < 4; ++j) { const bf16x8 a0 = *(const bf16x8*)(sKb + (16 * j + fr) * 72 + fq * 8), a1 = *(const bf16x8*)(sKb + (16 * j + fr) * 72 + 32 + fq * 8);
                        sc[j] = __builtin_amdgcn_mfma_f32_16x16x32_bf16(a0, qf0, (f32x4){0.f, 0.f, 0.f, 0.f}, 0, 0, 0);
                        sc[j] = __builtin_amdgcn_mfma_f32_16x16x32_bf16(a1, qf1, sc[j], 0, 0, 0); }
#pragma unroll
                    for (int j = 0; j < 4; ++j) { const f32x4 ck = *(const f32x4*)(cf2 + k0 + 16 * j + 4 * fq);
#pragma unroll
                        for (int r = 0; r < 4; ++r) sc[j][r] = sc[j][r] * C2 + (cfq - ck[r]); }
#ifdef NOSKIP
                    if (true) {
#else
                    if (k0 + 63 > qw0) {
#endif
#pragma unroll
                        for (int j = 0; j < 4; ++j)
#pragma unroll
                            for (int r = 0; r < 4; ++r) if (k0 + 16 * j + 4 * fq + r > qrow) sc[j][r] = -INFINITY;
                    }
                    float mx = fmaxf(fmaxf(sc[0][0], sc[0][1]), fmaxf(sc[0][2], sc[0][3]));
#pragma unroll
                    for (int j = 1; j < 4; ++j) mx = fmaxf(mx, fmaxf(fmaxf(sc[j][0], sc[j][1]), fmaxf(sc[j][2], sc[j][3])));
                    mx = fmaxf(mx, __shfl_xor(mx, 16)); mx = fmaxf(mx, __shfl_xor(mx, 32));
                    const float mnew = fmaxf(mrun, mx), alpha = __builtin_amdgcn_exp2f(mrun - mnew);
                    float ls = 0.f;
#pragma unroll
                    for (int j = 0; j < 4; ++j)
#pragma unroll
                        for (int r = 0; r < 4; ++r) { sc[j][r] = __builtin_amdgcn_exp2f(sc[j][r] - mnew); ls += sc[j][r]; }
                    lrun = lrun * alpha + ls; mrun = mnew;
#pragma unroll
                    for (int j = 0; j < 4; ++j) o[j] = o[j] * alpha;
#pragma unroll
                    for (int ks = 0; ks < 2; ++ks) {
                        u32x4 pw; pw.x = pk2t<4>(sc[2 * ks][0], sc[2 * ks][1]); pw.y = pk2t<4>(sc[2 * ks][2], sc[2 * ks][3]); pw.z = pk2t<4>(sc[2 * ks + 1][0], sc[2 * ks + 1][1]); pw.w = pk2t<4>(sc[2 * ks + 1][2], sc[2 * ks + 1][3]);
                        const bf16x8 pb = __builtin_bit_cast(bf16x8, pw);
#pragma unroll
                        for (int dj = 0; dj < 4; ++dj) { const bf16_t* vp = sVb + (16 * dj + fr) * 72 + 32 * ks + 4 * fq;
                            const u32x2 lo = *(const u32x2*)vp, hi = *(const u32x2*)(vp + 16); u32x4 vw; vw.x = lo.x; vw.y = lo.y; vw.z = hi.x; vw.w = hi.y;
                            o[dj] = __builtin_amdgcn_mfma_f32_16x16x32_bf16(__builtin_bit_cast(bf16x8, vw), pb, o[dj], 0, 0, 0); }
                    }
                }
            }
            float lt = lrun; lt += __shfl_xor(lt, 16); lt += __shfl_xor(lt, 32);
            const float inv = ZF / lt;
            bf16_t* op = YCAT + (size_t)(b * SEQ + qrow) * DM + 512 + h * 64 + 4 * fq;
#pragma unroll
            for (int dj = 0; dj < 4; ++dj) { u32x2 w; w.x = pk2t<4>(o[dj][0] * inv, o[dj][1] * inv); w.y = pk2t<4>(o[dj][2] * inv, o[dj][3] * inv); *(u32x2*)(op + 16 * dj) = w; }
            __syncthreads();
        }
    }
}

__device__ __forceinline__ void phase_mc(CArgsP a, int l, unsigned char* lds, int tid, int wave, int lane) {
    const bf16_t* PROJ = (const bf16_t*)(a->ws + WS_BIG); bf16_t* YCAT = (bf16_t*)(a->ws + WS_YCAT); const bf16_t* ST = (const bf16_t*)(a->ws + WS_ST);
    const float* DTF = (const float*)(a->ws + WS_DTF);
    const float* cw = a->in[10] + (size_t)l * 4 * 1024; const float* cb = a->in[11] + l * 1024; const float* dtb = a->in[12] + l * 8; const float* alog = a->in[13] + l * 8;
    const float* dsk = a->in[14] + l * 8; const float* ng = a->in[15] + l * 512;
    const int fr = lane & 15, fq = lane >> 4;
    bf16_t* sC = (bf16_t*)lds;
    bf16_t* sB = (bf16_t*)(lds + 17408);
    bf16_t* sXT = (bf16_t*)(lds + 34816);
    float* sCB = (float*)(lds + 71680);
    float* sDt = (float*)(lds + 89088);
    float* sAcs = sDt + 256;
    float* sRms = sAcs + 256;
    for (int it = blockIdx.x; it < 512; it += gridDim.x) {
        const int b = it >> 7, c = (it >> 1) & 63, g = it & 1, t0 = c * 64, R0 = b * SEQ + t0;
        ssd_dt_acs(DTF, dtb, alog, R0, g, wave, lane, sDt, sAcs);
#pragma unroll 2
        for (int o = tid; o < 4096; o += NT) {
            float v[8];
            if (o < 2048) { const int isC = o >> 10, o1 = o & 1023, ll = o1 >> 4, n = (o1 & 15) * 8; conv8(PROJ, b, t0 + ll, (isC ? 768 : 512) + g * 128 + n, cw, cb, v);
                u32x4 w; w.x = pk2t<5>(v[0], v[1]); w.y = pk2t<5>(v[2], v[3]); w.z = pk2t<5>(v[4], v[5]); w.w = pk2t<5>(v[6], v[7]);
                *(u32x4*)((isC ? sC : sB) + ll * 136 + n) = w; }
            else { const int o2 = o - 2048, ll = o2 >> 5, ch = (o2 & 31) * 8; conv8(PROJ, b, t0 + ll, g * 256 + ch, cw, cb, v);
#pragma unroll
                for (int j = 0; j < 8; ++j) sXT[(ch + j) * 72 + ll] = f2bft<5>(v[j]); }
        }
        __syncthreads();
        { const int li = wave >> 1;
#pragma unroll
          for (int q = 0; q < 2; ++q) { const int sj = 2 * (wave & 1) + q; f32x4 acc = (f32x4){0.f, 0.f, 0.f, 0.f};
#pragma unroll
              for (int kk = 0; kk < 4; ++kk) { const bf16x8 af = *(const bf16x8*)(sC + (16 * li + fr) * 136 + 32 * kk + 8 * fq), bfr = *(const bf16x8*)(sB + (16 * sj + fr) * 136 + 32 * kk + 8 * fq);
                  acc = __builtin_amdgcn_mfma_f32_16x16x32_bf16(af, bfr, acc, 0, 0, 0); }
#pragma unroll
              for (int r = 0; r < 4; ++r) sCB[(16 * li + 4 * fq + r) * 68 + 16 * sj + fr] = acc[r]; } }
        __syncthreads();
        { const int e = wave >> 1, lh = wave & 1, h = g * 4 + e;
          f32x4 yd[2][4], yo[2][4];
#pragma unroll
          for (int mi = 0; mi < 2; ++mi)
#pragma unroll
              for (int pj = 0; pj < 4; ++pj) { yd[mi][pj] = (f32x4){0.f, 0.f, 0.f, 0.f}; yo[mi][pj] = yd[mi][pj]; }
#ifdef NOSKIP
          for (int kk = 0; kk < 2; ++kk) {
#else
          for (int kk = 0; kk <= lh; ++kk) {
#endif
              bf16x8 bx[4];
#pragma unroll
              for (int pj = 0; pj < 4; ++pj) bx[pj] = *(const bf16x8*)(sXT + (e * 64 + 16 * pj + fr) * 72 + 32 * kk + 8 * fq);
#pragma unroll
              for (int mi = 0; mi < 2; ++mi) { const int lrow = 32 * lh + 16 * mi + fr, s0 = 32 * kk + 8 * fq; const float al = sAcs[e * 64 + lrow];
                  const f32x4 c0 = *(const f32x4*)(sCB + lrow * 68 + s0), c1 = *(const f32x4*)(sCB + lrow * 68 + s0 + 4);
                  const f32x4 as0 = *(const f32x4*)(sAcs + e * 64 + s0), as1 = *(const f32x4*)(sAcs + e * 64 + s0 + 4), d0 = *(const f32x4*)(sDt + e * 64 + s0), d1 = *(const f32x4*)(sDt + e * 64 + s0 + 4);
                  float gv[8];
#pragma unroll
                  for (int j = 0; j < 4; ++j) { gv[j] = (s0 + j <= lrow) ? c0[j] * d0[j] * __expf(al - as0[j]) : 0.f; gv[4 + j] = (s0 + 4 + j <= lrow) ? c1[j] * d1[j] * __expf(al - as1[j]) : 0.f; }
                  u32x4 gw; gw.x = pk2t<5>(gv[0], gv[1]); gw.y = pk2t<5>(gv[2], gv[3]); gw.z = pk2t<5>(gv[4], gv[5]); gw.w = pk2t<5>(gv[6], gv[7]);
                  const bf16x8 ga = __builtin_bit_cast(bf16x8, gw);
#pragma unroll
                  for (int pj = 0; pj < 4; ++pj) yd[mi][pj] = __builtin_amdgcn_mfma_f32_16x16x32_bf16(ga, bx[pj], yd[mi][pj], 0, 0, 0); }
          }
          const bf16_t* sp = ST + (size_t)((b * 64 + c) * 8 + h) * 8192;
#pragma unroll
          for (int kk = 0; kk < 4; ++kk) {
              bf16x8 bs[4], ca[2];
#pragma unroll
              for (int pj = 0; pj < 4; ++pj) bs[pj] = ldxb<bf16x8>(ST, (unsigned)(((size_t)(sp - ST) + (16 * pj + fr) * 128 + 32 * kk + 8 * fq) * 2));
#pragma unroll
              for (int mi = 0; mi < 2; ++mi) ca[mi] = *(const bf16x8*)(sC + (32 * lh + 16 * mi + fr) * 136 + 32 * kk + 8 * fq);
#pragma unroll
              for (int mi = 0; mi < 2; ++mi)
#pragma unroll
                  for (int pj = 0; pj < 4; ++pj) yo[mi][pj] = __builtin_amdgcn_mfma_f32_16x16x32_bf16(ca[mi], bs[pj], yo[mi][pj], 0, 0, 0);
          }
          const float dh = dsk[h];
          float ss[2][4];
#pragma unroll
          for (int mi = 0; mi < 2; ++mi) { const int lb = 32 * lh + 16 * mi + 4 * fq; const f32x4 ea = *(const f32x4*)(sAcs + e * 64 + lb);
#pragma unroll
              for (int r = 0; r < 4; ++r) ss[mi][r] = 0.f;
#pragma unroll
              for (int pj = 0; pj < 4; ++pj) { const int p = 16 * pj + fr; const u32x2 xw = *(const u32x2*)(sXT + (e * 64 + p) * 72 + lb);
                  const float xs[4] = {bf_lo(xw.x), bf_hi(xw.x), bf_lo(xw.y), bf_hi(xw.y)};
#pragma unroll
                  for (int r = 0; r < 4; ++r) { const float z = bf2f(ldx(PROJ + (size_t)(R0 + lb + r) * NPROJ + PC_Z + g * 256 + e * 64 + p));
                      float y = yd[mi][pj][r] + __expf(ea[r]) * yo[mi][pj][r] + dh * xs[r]; y *= siluf(z); yd[mi][pj][r] = y; ss[mi][r] += y * y; } } }
#pragma unroll
          for (int mi = 0; mi < 2; ++mi)
#pragma unroll
              for (int r = 0; r < 4; ++r) { float s = ss[mi][r]; s += __shfl_xor(s, 1); s += __shfl_xor(s, 2); s += __shfl_xor(s, 4); s += __shfl_xor(s, 8);
                  if (fr == 0) sRms[(32 * lh + 16 * mi + 4 * fq + r) * 4 + e] = s; }
          __syncthreads();
#pragma unroll
          for (int mi = 0; mi < 2; ++mi) { const int lb = 32 * lh + 16 * mi + 4 * fq;
#pragma unroll
              for (int r = 0; r < 4; ++r) { const f32x4 q4 = *(const f32x4*)(sRms + (lb + r) * 4); const float rstd = 1.f / sqrtf(((q4.x + q4.y) + (q4.z + q4.w)) * (1.f / 256.f) + RMS_EPS);
#pragma unroll
                  for (int pj = 0; pj < 4; ++pj) { const int ch = g * 256 + e * 64 + 16 * pj + fr; YCAT[(size_t)(R0 + lb + r) * DM + ch] = f2bft<5>(ZS * yd[mi][pj][r] * rstd * ng[ch]); } } }
        }
        __syncthreads();
    }
}
}


#define LAS __attribute__((address_space(3)))
#ifndef XB_ACQ_SCOPE
#define XB_ACQ_SCOPE ""
#endif
#define XB_TMO      128
#define XB_XCNT(j)  (256  + 64 * (j))
#define XB_XSUB(j)  (1280 + 64 * (j))
#define XB_XGEN(j)  (2304 + 64 * (j))
#define XB_TOP      3328
#define XB_TOPGEN   3392
#define XCD_BAR_WORDS 3456
#define XB_SPIN_CAP (1u << 18)

__device__ __forceinline__ unsigned xb_ld(unsigned* p)              { return __hip_atomic_load(p, __ATOMIC_RELAXED, __HIP_MEMORY_SCOPE_AGENT); }
__device__ __forceinline__ unsigned xb_add(unsigned* p, unsigned v) { return __hip_atomic_fetch_add(p, v, __ATOMIC_RELAXED, __HIP_MEMORY_SCOPE_AGENT); }
__device__ __forceinline__ unsigned xb_xcc_id() { return (unsigned)__builtin_amdgcn_s_getreg((3 << 11) | 20) & 0xFu; }
#define XB_SPIN(cond, bar) do { unsigned _sp = 0; while (cond) { __builtin_amdgcn_s_sleep(1); \
    if ((++_sp & 255u) == 0u) { if (xb_ld(&(bar)[XB_TMO])) break; if (_sp > XB_SPIN_CAP) { atomicAdd(&(bar)[XB_TMO], 1u); break; } } } } while (0)

struct XcdBarrier {
    unsigned* bar; unsigned x;
    volatile LAS unsigned* st;
};

__device__ __forceinline__ XcdBarrier xcd_barrier_post(unsigned* bar, volatile LAS unsigned* st) {
    XcdBarrier b; b.bar = bar; b.x = xb_xcc_id(); b.st = st;
    if (threadIdx.x == 0) (void)xb_add(&bar[XB_XCNT(b.x)], 1u);
    return b;
}
__device__ __forceinline__ void xcd_barrier_complete(unsigned* bar, unsigned x, unsigned& nloc, unsigned& nx) {
    const unsigned G = gridDim.x * gridDim.y * gridDim.z;
    unsigned sum, cnt, mine, sp = 0u;
    for (;;) {
        sum = 0u; cnt = 0u; mine = 0u;
#pragma unroll
        for (unsigned j = 0; j < 16; ++j) { const unsigned c = xb_ld(&bar[XB_XCNT(j)]); sum += c; cnt += (c > 0u) ? 1u : 0u; mine = (j == x) ? c : mine; }
        if (sum == G) break;
        __builtin_amdgcn_s_sleep(1);
        if ((++sp & 255u) == 0u) { if (xb_ld(&bar[XB_TMO])) break; if (sp > XB_SPIN_CAP) { atomicAdd(&bar[XB_TMO], 1u); break; } }
    }
    nloc = mine > 0u ? mine : 1u; nx = cnt > 0u ? cnt : 1u;
}

__device__ __forceinline__ void xcd_barrier(const XcdBarrier& b) {
    asm volatile("s_waitcnt vmcnt(0)" ::: "memory");
    __syncthreads();
    if (threadIdx.x == 0) {
        unsigned* bar = b.bar;
        __builtin_amdgcn_s_waitcnt(0);
        unsigned nloc = b.st[0], nx = b.st[1];
        if (nloc == 0u) { xcd_barrier_complete(bar, b.x, nloc, nx); b.st[0] = nloc; b.st[1] = nx; }
        const unsigned old = xb_add(&bar[XB_XSUB(b.x)], 1u);
        const unsigned gen = old / nloc;
        if (old + 1u == (gen + 1u) * nloc) {
            __builtin_amdgcn_fence(__ATOMIC_RELEASE, "agent");
            asm volatile("s_waitcnt vmcnt(0)" ::: "memory");
            const unsigned og = xb_add(&bar[XB_TOP], 1u);
            const unsigned tg = og / nx;
            if (og + 1u == (tg + 1u) * nx) xb_add(&bar[XB_TOPGEN], 1u);
            else XB_SPIN(xb_ld(&bar[XB_TOPGEN]) == tg, bar);
            __builtin_amdgcn_fence(__ATOMIC_ACQUIRE, "");
            asm volatile("s_waitcnt vmcnt(0)" ::: "memory");
            xb_add(&bar[XB_XGEN(b.x)], 1u);
            asm volatile("s_waitcnt vmcnt(0)" ::: "memory");
        } else {
            XB_SPIN(xb_ld(&bar[XB_XGEN(b.x)]) == gen, bar);
            __builtin_amdgcn_fence(__ATOMIC_ACQUIRE, "agent");
            asm volatile("s_waitcnt vmcnt(0)" ::: "memory");
        }
    }
    __syncthreads();
}


#ifndef MK_STOP_AFTER
#define MK_STOP_AFTER 1000
#endif
__global__ void __launch_bounds__(512, 2) mega_fwd(mk::Args a_unused) {
    using namespace mk;
    extern __shared__ __attribute__((aligned(16))) unsigned char lds[];
    cg::grid_group grid = cg::this_grid();
    volatile LAS unsigned* bst = (volatile LAS unsigned*)((LAS unsigned char*)lds + 131072 + 256);
#ifdef LDS_POISON
    for (int i = threadIdx.x; i < mk::LDS_BYTES / 4; i += 512) ((volatile unsigned*)lds)[i] = 0xFFFFFFFFu;
    __syncthreads();
#endif
    if (threadIdx.x < 8) bst[threadIdx.x] = 0u;
    __syncthreads();
    { CArgsP a0 = get_args(); (void)xcd_barrier_post((unsigned*)(a0->ws + WS_BAR), bst); }
    grid.sync();
#define GSYNC() do { CArgsP a_ = get_args(); XcdBarrier b_; b_.bar = (unsigned*)(a_->ws + WS_BAR); b_.x = xb_xcc_id(); b_.st = bst; xcd_barrier(b_); } while (0)
#pragma unroll 1
    for (int ph_ = 0; ph_ < (MK_STOP_AFTER < 25 ? MK_STOP_AFTER + 1 : 26); ++ph_) {
        int ph = ph_; asm volatile("" : "+s"(ph));
#ifdef TIME_CAT
        unsigned long long tc0_ = __builtin_amdgcn_s_memrealtime();
#endif
        int tid = threadIdx.x; asm volatile("" : "+v"(tid)); const int lane = tid & 63, wave = __builtin_amdgcn_readfirstlane(tid >> 6);
        CArgsP a = get_args();
        unsigned char* ws = a->ws;
        const int p = ph - 2, l = p < 0 ? 0 : p / 12, s = p < 0 ? -1 : p % 12;
        if (s == 0 || s == 1 || s == 3 || s == 7 || s == 9 || s == 10) {
#ifndef NO_G
            unsigned char* wl = ws + WS_W + (size_t)l * W_L;
            const size_t aoff = (s == 0 || s == 3 || s == 9) ? WS_HB : (s == 7 ? WS_YCAT : WS_BIG);
            const size_t boff = s == 0 ? WO_1IN : s == 1 ? WO_1OUT : s == 3 ? WO_MI : s == 7 ? WO_MO : s == 9 ? WO_2IN : WO_2OUT;
            const int N = (s == 0 || s == 9) ? NFF : (s == 3 ? NPROJ : DM), K = (s == 1 || s == 10) ? DFF : DM;
            pg8::Gemm g_{(const bf16_t*)(ws + aoff), (const bf16_t*)(wl + boff), MROWS, N, K}; pg8::StaticOrder S_; S_.init(MROWS, N, (int)gridDim.x, (int)blockIdx.x);
            EpiMulti E{s | (l << 8)};
            pg8::gemm_phase<EpiMulti, pg8::StaticOrder, true, true>((PG8_LAS unsigned char*)lds, g_, S_, E);
#endif
        } else if (ph == 0) {
#ifndef NO_P0
            phase_p0(a, lds, tid, wave, lane);
#endif
        } else if (ph == 1 || s == 8 || s == 11) {
            const float* modl = (const float*)(ws + WS_MOD) + (size_t)l * 4 * NMOD;
            const int li = s == 8 ? 1 : 2, sub = s == 8 ? 2 : 0; const bool wh = !(s == 11 && l == 1);
            const float* src = ph == 1 ? a->in[0] : (const float*)a->out;
            const float* gm = ph == 1 ? a->in[2] : a->in[20] + (l * 3 + li) * DM; const float* bt = ph == 1 ? a->in[3] : a->in[21] + (l * 3 + li) * DM;
            const float* md = (s == 11 && l == 0) ? modl + 4 * NMOD : modl;
            phase_ln<false>(src, a->out, (bf16_t*)(ws + WS_HB), gm, bt, md, sub, wh, nullptr, nullptr, lds, tid, wave, lane);
        } else if (s == 2) {
            const float* modl = (const float*)(ws + WS_MOD) + (size_t)l * 4 * NMOD;
            phase_ln<true>(a->out, a->out, (bf16_t*)(ws + WS_HB), a->in[20] + l * 3 * DM, a->in[21] + l * 3 * DM, modl, 1, true, (const float*)(ws + WS_WMISC) + l * 12288, (float*)(ws + WS_DTF), lds, tid, wave, lane);
        } else if (s == 4) {
#ifndef NO_MA
            phase_ma(a, l, lds, tid, wave, lane);
#endif
        } else if (s == 5) {
#ifndef NO_MB
            phase_mb(a, l, lds, tid, wave, lane);
#endif
        } else {
#ifndef NO_MC
            phase_mc(a, l, lds, tid, wave, lane);
#endif
        }
        if (ph_ < 25) GSYNC();
#ifdef TIME_CAT
        { const int p2_ = ph_ - 2, s2_ = p2_ < 0 ? -1 : p2_ % 12;
          const int cat_ = (s2_ == 0 || s2_ == 1 || s2_ == 3 || s2_ == 7 || s2_ == 9 || s2_ == 10) ? 1 : (ph_ == 0 ? 6 : ((ph_ == 1 || s2_ == 2 || s2_ == 8 || s2_ == 11) ? 2 : (s2_ == 4 ? 3 : (s2_ == 5 ? 4 : 5))));
          if (cat_ == TIME_CAT && threadIdx.x == 0) { volatile LAS unsigned* tacc = bst + 4; tacc[0] = tacc[0] + (unsigned)(__builtin_amdgcn_s_memrealtime() - tc0_); } }
#endif
    }
#ifdef TIME_CAT
    if (blockIdx.x == 0 && threadIdx.x == 0) { CArgsP a9 = get_args(); a9->out[0] = (float)bst[4] * 0.01f; }
#endif
}

extern "C" void kernel_launch(void* const* d_in, const int* in_sizes, int n_in, void* d_out, int out_size, void* d_ws, size_t ws_size, hipStream_t stream) {
    static int grid = 0;
    if (grid == 0) {
        if (n_in != 22 || out_size != mk::MROWS * mk::DM || ws_size < mk::WS_END) { fprintf(stderr, "kernel_launch: unexpected problem (n_in %d out %d ws %zu)\n", n_in, out_size, ws_size); grid = -1; return; }
        int dev = 0, cus = 0, per_cu = 0;
        (void)hipGetDevice(&dev); (void)hipDeviceGetAttribute(&cus, hipDeviceAttributeMultiprocessorCount, dev);
        (void)hipFuncSetAttribute((const void*)mega_fwd, hipFuncAttributeMaxDynamicSharedMemorySize, mk::LDS_BYTES);
        (void)hipOccupancyMaxActiveBlocksPerMultiprocessor(&per_cu, (const void*)mega_fwd, 512, mk::LDS_BYTES);
        (void)hipGetLastError();
        if (per_cu < 1) { fprintf(stderr, "kernel_launch: occupancy query says %d\n", per_cu); grid = -1; return; }
        grid = cus;
    }
    if (grid < 0) return;
#ifdef NAN_POISON
    (void)hipMemsetAsync(d_ws, 0xFF, mk::WS_END, stream); (void)hipMemsetAsync(d_out, 0xFF, (size_t)out_size * 4, stream);
#endif
    if (hipMemsetAsync((char*)d_ws + mk::WS_BAR, 0, 16384, stream) != hipSuccess) { fprintf(stderr, "kernel_launch: memset failed\n"); return; }
    mk::Args a{};
    for (int i = 0; i < 22; ++i) a.in[i] = (const float*)d_in[i];
    a.out = (float*)d_out; a.ws = (unsigned char*)d_ws;
    void* args[] = {&a};
    hipError_t e = hipLaunchCooperativeKernel((const void*)mega_fwd, dim3(grid), dim3(512), args, mk::LDS_BYTES, stream);
    if (e != hipSuccess) fprintf(stderr, "cooperative launch failed: %s (grid %d)\n", hipGetErrorString(e), grid);
}
```

```cpp
#include <hip/hip_runtime.h>
#include <hip/hip_cooperative_groups.h>
#include <cstdio>
#include <cstdint>
namespace cg = cooperative_groups;
#ifndef PG8_A_AUX
#define PG8_A_AUX 16
#endif
namespace pg8 {
#define PG8_LAS __attribute__((address_space(3)))
typedef unsigned short bf16_t;
typedef short bf16x8 __attribute__((ext_vector_type(8)));
typedef float f32x4 __attribute__((ext_vector_type(4)));
typedef unsigned u32x4 __attribute__((ext_vector_type(4)));
constexpr int BM = 256, BK = 64, HALF = 128, HTB = HALF * BK * 2  , STAGE_BYTES = 8 * HTB, NXCD = 8, WGM = 8;

__host__ __device__ __forceinline__ int lds_byte(int r, int c) { const int st = (r >> 4) * 2 + (c >> 5), rr = r & 15, cc = c & 31, ob = rr * 64 + cc * 2; return st * 1024 + (ob ^ (((ob >> 9) & 1) << 5)); }
__host__ __device__ __forceinline__ void stage_rc(int b, int& R, int& C) { const int st = b / 1024, sb = b % 1024, swz = sb ^ (((sb >> 9) & 1) << 5); R = (st >> 1) * 16 + swz / 64; C = (st & 1) * 32 + (swz % 64) / 2; }
__host__ __device__ __forceinline__ int perm32(int rho) { const int n = rho >> 4, i = rho & 15; return 8 * (i >> 2) + 4 * n + (i & 3); }

struct Unit { int pm, pn; };
struct Gemm { const bf16_t* A; const bf16_t* Bt; int M, N, K; };

struct StaticOrder {
    int nM, nN, nwg, G, c;
    __host__ __device__ void init(int M, int N, int G_, int c_) { nM = M / BM; nN = N / BM; nwg = nM * nN; G = G_; c = c_; }
    __host__ __device__ bool next(int i, Unit& u) const {
        const long L = (long)i * G + c; if (L >= nwg) return false;
        int wgid = (int)L; { const int q = nwg / NXCD, r = nwg % NXCD, xcd = wgid % NXCD, off = wgid / NXCD; wgid = (xcd < r ? xcd * (q + 1) : r * (q + 1) + (xcd - r) * q) + off; }
        const int nig = WGM * nN, gid = wgid / nig, fm = gid * WGM, gsz = (nM - fm) < WGM ? (nM - fm) : WGM;
        u.pm = fm + ((wgid % nig) % gsz); u.pn = (wgid % nig) / gsz; return true;
    }
    __device__ __forceinline__ void a_ready(const Unit&) const {}
    __device__ __forceinline__ void done(const Unit&) const {}
};

__device__ __forceinline__ unsigned cvt_pk_bf16(float lo, float hi) { unsigned r; asm volatile("v_cvt_pk_bf16_f32 %0, %1, %2" : "=v"(r) : "v"(lo), "v"(hi)); return r; }
typedef float f32x2 __attribute__((ext_vector_type(2)));
__device__ __forceinline__ f32x2 gelu_pk(f32x2 v) {
    const f32x2 av = __builtin_elementwise_abs(v), d = av * 0.2316418882f + 1.0f;
    f32x2 t; t.x = __builtin_amdgcn_rcpf(d.x); t.y = __builtin_amdgcn_rcpf(d.y);
    f32x2 q = t * 0.5307027145f + (-0.7265760135f); q = q * t + 0.7107068705f; q = q * t + (-0.142248368f); q = q * t + 0.127414796f; q = q * t;
    const f32x2 s = (v * v) * (-0.72134752044f);
    f32x2 e; e.x = __builtin_amdgcn_exp2f(s.x); e.y = __builtin_amdgcn_exp2f(s.y);
    const f32x2 m = v * (q * e), r = v - m;
    f32x2 o; o.x = v.x < 0.f ? m.x : r.x; o.y = v.y < 0.f ? m.y : r.y; return o;
}

template <int ACT  > struct EpiBf16 {
    static constexpr bool PERM = true, AFTER_DRAIN = false; static_assert(ACT == 0 || ACT == 1, "EpiBf16: ACT is 0 (none) or 1 (gelu_pk)");
    bf16_t* O; int ldc; const float* bias; int split_cols; size_t split_stride; float scale0;
    __device__ __forceinline__ void operator()(const f32x4 (&acc)[2][2][4][2], const Unit& u, int wr, int wc, int fr, int fq) const {
        const int row0 = u.pm * BM + wr * 64 + fr; int colt = u.pn * BM; bf16_t* base = O;
        float sc = 1.f; if (split_cols) { const int t = colt / split_cols; base += (size_t)t * split_stride; colt -= t * split_cols; if (t == 0) sc = scale0; }
        const int col0 = colt + wc * 32 + 8 * fq, bcol0 = u.pn * BM + wc * 32 + 8 * fq;
        f32x4 bv[2][2];
#pragma unroll
        for (int bj = 0; bj < 2; ++bj)
#pragma unroll
            for (int n = 0; n < 2; ++n) bv[bj][n] = bias ? *(const f32x4*)(bias + bcol0 + bj * HALF + 4 * n) : (f32x4){0.f, 0.f, 0.f, 0.f};
#pragma unroll
        for (int ai = 0; ai < 2; ++ai)
#pragma unroll
            for (int m = 0; m < 4; ++m) { bf16_t* rowp = base + (size_t)(row0 + ai * HALF + m * 16) * ldc + col0;
#pragma unroll
                for (int bj = 0; bj < 2; ++bj) { f32x4 v0 = acc[ai][bj][m][0] + bv[bj][0], v1 = acc[ai][bj][m][1] + bv[bj][1];
                    if (ACT == 1) { f32x2 a = gelu_pk((f32x2){v0[0], v0[1]}), b = gelu_pk((f32x2){v0[2], v0[3]}), c = gelu_pk((f32x2){v1[0], v1[1]}), d = gelu_pk((f32x2){v1[2], v1[3]});
                        v0 = (f32x4){a.x, a.y, b.x, b.y}; v1 = (f32x4){c.x, c.y, d.x, d.y}; }
                    v0 = v0 * sc; v1 = v1 * sc; u32x4 w; w.x = cvt_pk_bf16(v0[0], v0[1]); w.y = cvt_pk_bf16(v0[2], v0[3]); w.z = cvt_pk_bf16(v1[0], v1[1]); w.w = cvt_pk_bf16(v1[2], v1[3]);
                    *(u32x4*)(rowp + bj * HALF) = w; } }
    }
};

struct PanelStats {
    unsigned* xbuf;
    unsigned* cnt;
    unsigned* tmo;
    int ntn; float eps;
    unsigned code;
    __device__ __forceinline__ bool run(const f32x4 (&v)[2][2][4][2], const Unit& u, int wr, int wc, int fr, int fq, PG8_LAS unsigned char* lds, int wid, int lane) const {
        typedef float f32x2v __attribute__((ext_vector_type(2)));
        PG8_LAS f32x2v* P = (PG8_LAS f32x2v*)lds;
        PG8_LAS f32x2v* S = (PG8_LAS f32x2v*)(lds + 8192);
        PG8_LAS unsigned* flag = (PG8_LAS unsigned*)(lds + 8192 + 2048);
#pragma unroll
        for (int ai = 0; ai < 2; ++ai)
#pragma unroll
            for (int m = 0; m < 4; ++m) {
                float s = 0.f;
#pragma unroll
                for (int bj = 0; bj < 2; ++bj)
#pragma unroll
                    for (int n = 0; n < 2; ++n) { const f32x4 x = v[ai][bj][m][n]; s += (x[0] + x[1]) + (x[2] + x[3]); }
                s += __shfl_xor(s, 16); s += __shfl_xor(s, 32);
                const float mw = s * (1.0f / 64.0f); float q = 0.f;
#pragma unroll
                for (int bj = 0; bj < 2; ++bj)
#pragma unroll
                    for (int n = 0; n < 2; ++n) { const f32x4 d = v[ai][bj][m][n] - mw; q += (d[0] * d[0] + d[1] * d[1]) + (d[2] * d[2] + d[3] * d[3]); }
                q += __shfl_xor(q, 16); q += __shfl_xor(q, 32);
                if (fq == 0) P[(ai * HALF + wr * 64 + m * 16 + fr) * 4 + wc] = (f32x2v){mw, q};
            }
        asm volatile("s_waitcnt lgkmcnt(0)" ::: "memory"); __builtin_amdgcn_s_barrier(); asm volatile("" ::: "memory");
#if defined(BROKEN_EXCHANGE_NO_WAIT)
#warning BROKEN CONTROL BUILD: the row-statistics exchange does not wait; results are wrong by design
        if (blockIdx.x >= 64) { const long long t0_ = clock64(); while (clock64() - t0_ < 60000) __builtin_amdgcn_s_sleep(8); }
#endif
        const int row = wid * 32 + (lane & 31);
        if (lane < 32) {
            const f32x2v a = P[row * 4 + 0], b = P[row * 4 + 1], c = P[row * 4 + 2], d = P[row * 4 + 3];
            const float mt = (a.x + b.x + c.x + d.x) * 0.25f;
            const float da = a.x - mt, db = b.x - mt, dc = c.x - mt, dd = d.x - mt;
            const float m2 = (a.y + b.y) + (c.y + d.y) + 64.0f * ((da * da + db * db) + (dc * dc + dd * dd));
            unsigned long long* slot = (unsigned long long*)xbuf + ((size_t)(u.pm * BM + row) * 4 + u.pn);
            __hip_atomic_store(slot, ((unsigned long long)__float_as_uint(m2) << 32) | __float_as_uint(mt), __ATOMIC_RELAXED, __HIP_MEMORY_SCOPE_AGENT);
        }
        asm volatile("s_waitcnt vmcnt(0)" ::: "memory");
        if (lane == 0) __hip_atomic_fetch_add(cnt + 64 * u.pm, 1u, __ATOMIC_RELAXED, __HIP_MEMORY_SCOPE_AGENT);
        if (wid == 0) {
            bool dead = false; const unsigned long long t0 = __builtin_amdgcn_s_memrealtime(); const unsigned want = 8u * (unsigned)ntn;
            for (;;) {
#if defined(BROKEN_EXCHANGE_NO_WAIT)
                break;
#endif
                if ((unsigned)__builtin_amdgcn_readfirstlane(__hip_atomic_load(cnt + 64 * u.pm, __ATOMIC_RELAXED, __HIP_MEMORY_SCOPE_AGENT)) >= want) break;
                if (__builtin_amdgcn_s_memrealtime() - t0 > 2000000ull) {
                    if (lane == 0) { unsigned expect = 0u; __hip_atomic_compare_exchange_strong(tmo + 1, &expect, code | (unsigned)(u.pm & 0xff), __ATOMIC_RELAXED, __ATOMIC_RELAXED, __HIP_MEMORY_SCOPE_AGENT);
                                     __hip_atomic_store(tmo, 1u, __ATOMIC_RELAXED, __HIP_MEMORY_SCOPE_AGENT); }
                    dead = true; break; }
                __builtin_amdgcn_s_sleep(2);
            }
            __builtin_amdgcn_fence(__ATOMIC_ACQUIRE, "agent");
            if (lane == 0) flag[0] = dead ? 1u : 0u;
        }
        asm volatile("s_waitcnt vmcnt(0) lgkmcnt(0)" ::: "memory"); __builtin_amdgcn_s_barrier(); asm volatile("" ::: "memory");
        const bool bad = flag[0] != 0u;
        if (lane < 32) {
            const unsigned long long* slot = (const unsigned long long*)xbuf + (size_t)(u.pm * BM + row) * 4; float mt[4], m2[4]; float ms = 0.f;
#pragma unroll
            for (int t = 0; t < 4; ++t) { if (t < ntn) { const unsigned long long w = __hip_atomic_load(slot + t, __ATOMIC_RELAXED, __HIP_MEMORY_SCOPE_AGENT); mt[t] = __uint_as_float((unsigned)w); m2[t] = __uint_as_float((unsigned)(w >> 32)); } else { mt[t] = 0.f; m2[t] = 0.f; } ms += mt[t]; }
            const float mean = ms / (float)ntn; float q = 0.f;
#pragma unroll
            for (int t = 0; t < 4; ++t) if (t < ntn) { const float dm = mt[t] - mean; q += m2[t] + 256.0f * dm * dm; }
            S[row] = (f32x2v){mean, 1.0f / sqrtf(q / (256.0f * (float)ntn) + eps)};
        }
        asm volatile("s_waitcnt lgkmcnt(0)" ::: "memory"); __builtin_amdgcn_s_barrier(); asm volatile("" ::: "memory");
        return bad;
    }
};
struct EpiLnRes {
    static constexpr bool PERM = false, AFTER_DRAIN = true;
    const float* base; float* out; int ldc; const float* bias; PanelStats st; unsigned poison;
    __device__ __forceinline__ void fused(f32x4 (&acc)[2][2][4][2], const Unit& u, int wr, int wc, int fr, int fq, PG8_LAS unsigned char* lds, int wid, int lane) const {
        typedef float f32x2v __attribute__((ext_vector_type(2)));
        const PG8_LAS f32x2v* S = (const PG8_LAS f32x2v*)(lds + 8192);
        const int col0 = u.pn * BM + wc * 32 + 4 * fq;
#pragma unroll
        for (int bj = 0; bj < 2; ++bj)
#pragma unroll
            for (int n = 0; n < 2; ++n) { const f32x4 bv = bias ? *(const f32x4*)(bias + col0 + bj * HALF + n * 16) : (f32x4){0.f, 0.f, 0.f, 0.f};
#pragma unroll
                for (int ai = 0; ai < 2; ++ai)
#pragma unroll
                    for (int m = 0; m < 4; ++m) acc[ai][bj][m][n] += bv; }
        f32x4 pre[4][2][2];
#pragma unroll
        for (int m = 0; m < 4; ++m) { const size_t off = (size_t)(u.pm * BM + wr * 64 + m * 16 + fr) * ldc + col0;
#pragma unroll
            for (int bj = 0; bj < 2; ++bj)
#pragma unroll
                for (int n = 0; n < 2; ++n) pre[m][bj][n] = *(const f32x4*)(base + off + bj * HALF + n * 16); }
        const bool bad = st.run(acc, u, wr, wc, fr, fq, lds, wid, lane) || poison != 0u;
        const float qnan = __builtin_nanf("");
#pragma unroll
        for (int ai = 0; ai < 2; ++ai)
#pragma unroll
            for (int m = 0; m < 4; ++m) { const int r = ai * HALF + wr * 64 + m * 16 + fr; const f32x2v sr = S[r]; const size_t off = (size_t)(u.pm * BM + r) * ldc + col0;
#pragma unroll
                for (int bj = 0; bj < 2; ++bj)
#pragma unroll
                    for (int n = 0; n < 2; ++n) { const f32x4 bs = ai == 0 ? pre[m][bj][n] : *(const f32x4*)(base + off + bj * HALF + n * 16); f32x4 o = bs + (acc[ai][bj][m][n] - sr.x) * sr.y;
                        if (bad) o = (f32x4){qnan, qnan, qnan, qnan}; *(f32x4*)(out + off + bj * HALF + n * 16) = o; }
                if (m & 1) asm volatile("" ::: "memory"); }
    }
};
struct EpiLnResLn {
    static constexpr bool PERM = false, AFTER_DRAIN = true;
    const float* base; float* out; bf16_t* xn; int ldc; const float* bias; PanelStats st1, st2; unsigned poison;
    __device__ __forceinline__ void fused(f32x4 (&acc)[2][2][4][2], const Unit& u, int wr, int wc, int fr, int fq, PG8_LAS unsigned char* lds, int wid, int lane) const {
        typedef float f32x2v __attribute__((ext_vector_type(2))); typedef unsigned u32x2v __attribute__((ext_vector_type(2)));
        const PG8_LAS f32x2v* S = (const PG8_LAS f32x2v*)(lds + 8192);
        const int col0 = u.pn * BM + wc * 32 + 4 * fq;
#pragma unroll
        for (int bj = 0; bj < 2; ++bj)
#pragma unroll
            for (int n = 0; n < 2; ++n) { const f32x4 bv = bias ? *(const f32x4*)(bias + col0 + bj * HALF + n * 16) : (f32x4){0.f, 0.f, 0.f, 0.f};
#pragma unroll
                for (int ai = 0; ai < 2; ++ai)
#pragma unroll
                    for (int m = 0; m < 4; ++m) acc[ai][bj][m][n] += bv; }
        bool bad = st1.run(acc, u, wr, wc, fr, fq, lds, wid, lane) || poison != 0u;
        const float qnan = __builtin_nanf("");
#pragma unroll
        for (int ai = 0; ai < 2; ++ai)
#pragma unroll
            for (int m = 0; m < 4; ++m) { const int r = ai * HALF + wr * 64 + m * 16 + fr; const f32x2v sr = S[r]; const size_t off = (size_t)(u.pm * BM + r) * ldc + col0;
#pragma unroll
                for (int bj = 0; bj < 2; ++bj)
#pragma unroll
                    for (int n = 0; n < 2; ++n) { const f32x4 bs = *(const f32x4*)(base + off + bj * HALF + n * 16); acc[ai][bj][m][n] = bs + (acc[ai][bj][m][n] - sr.x) * sr.y; }
                asm volatile("" : "+v"(acc[ai][0][m][0]), "+v"(acc[ai][0][m][1]), "+v"(acc[ai][1][m][0]), "+v"(acc[ai][1][m][1]));
                if (m & 1) asm volatile("" ::: "memory"); }
        const bool bad1 = bad;
        bad = st2.run(acc, u, wr, wc, fr, fq, lds, wid, lane) || bad;
#pragma unroll
        for (int ai = 0; ai < 2; ++ai)
#pragma unroll
            for (int m = 0; m < 4; ++m) { const int r = ai * HALF + wr * 64 + m * 16 + fr; const f32x2v sr = S[r]; const size_t off = (size_t)(u.pm * BM + r) * ldc + col0;
#pragma unroll
                for (int bj = 0; bj < 2; ++bj)
#pragma unroll
                    for (int n = 0; n < 2; ++n) { const f32x4 x1 = acc[ai][bj][m][n]; *(f32x4*)(out + off + bj * HALF + n * 16) = bad1 ? (f32x4){qnan, qnan, qnan, qnan} : x1;
                        const f32x4 o = (x1 - sr.x) * sr.y; u32x2v w; w.x = cvt_pk_bf16(o[0], o[1]); w.y = cvt_pk_bf16(o[2], o[3]);
                        if (bad) { w.x = 0x7fc07fc0u; w.y = 0x7fc07fc0u; } *(u32x2v*)(xn + off + bj * HALF + n * 16) = w; }
                asm volatile("" ::: "memory"); }
    }
};

template <class Epi, class Sched, bool ALIGN_EPI = false, bool SP2 = false>
__device__ __forceinline__ void gemm_phase(PG8_LAS unsigned char* lds, const Gemm g, const Sched& S, const Epi& E) {
    int tid_ = threadIdx.x; asm volatile("" : "+v"(tid_)); const int tid = tid_, wid = __builtin_amdgcn_readfirstlane(tid >> 6), lane = tid & 63, wr = wid >> 2, wc = wid & 3, fr = lane & 15, fq = lane >> 4;
    const int K = g.K, nt = K / BK;
    unsigned voffA[2], voffB[2];
#pragma unroll
    for (int i = 0; i < 2; ++i) { int R, C; stage_rc(tid * 16 + i * 8192, R, C); const int Rb = Epi::PERM ? ((R & ~31) + perm32(R & 31)) : R;
        voffA[i] = (unsigned)(R * K + C) * 2u; voffB[i] = (unsigned)(Rb * K + C) * 2u; }
    const size_t kstep = (size_t)(BK * 2);
    const size_t hstep = (size_t)HALF * K * 2;
    const size_t tstep = 2 * hstep;
    const unsigned ldsw = (unsigned)wid * 1024u;
    const int aoff = lds_byte(wr * 64 + fr, fq * 8), boff = lds_byte(wc * 32 + fr, fq * 8);
#define PG8_SA(b, h) (((b) * 2 + (h)) * HTB)
#define PG8_SB(b, h) ((4 + (b) * 2 + (h)) * HTB)
#define PG8_STAGE_X(bufoff, gbase, voff, aux) do { _Pragma("unroll") for (int _i = 0; _i < 2; ++_i) \
        __builtin_amdgcn_global_load_lds((const unsigned*)((const char*)(gbase) + (voff)[_i]), (PG8_LAS unsigned*)(lds + (bufoff) + ldsw + _i * 8192), 16, 0, aux); } while (0)
#define PG8_STAGE(bufoff, gbase, voff) PG8_STAGE_X(bufoff, gbase, voff, 0)
#define PG8_STAGE_A(bufoff, gbase, voff) PG8_STAGE_X(bufoff, gbase, voff, PG8_A_AUX)
#define PG8_LDA(dst, b, h) do { _Pragma("unroll") for (int m = 0; m < 4; ++m) _Pragma("unroll") for (int k = 0; k < 2; ++k) dst[m][k] = *(const PG8_LAS bf16x8*)(lds + PG8_SA(b, h) + aoff + m * 2048 + k * 1024); } while (0)
#define PG8_LDB(dst, b, h) do { _Pragma("unroll") for (int n = 0; n < 2; ++n) _Pragma("unroll") for (int k = 0; k < 2; ++k) dst[n][k] = *(const PG8_LAS bf16x8*)(lds + PG8_SB(b, h) + boff + n * 2048 + k * 1024); } while (0)
#define PG8_MMA(ai, bj, At, Bt) do { __builtin_amdgcn_s_setprio(1); _Pragma("unroll") for (int m = 0; m < 4; ++m) _Pragma("unroll") for (int n = 0; n < 2; ++n) _Pragma("unroll") for (int k = 0; k < 2; ++k) \
        acc[ai][bj][m][n] = __builtin_amdgcn_mfma_f32_16x16x32_bf16(Bt[n][k], At[m][k], acc[ai][bj][m][n], 0, 0, 0); __builtin_amdgcn_s_setprio(0); } while (0)
#define PG8_WAIT_V(n) asm volatile("s_waitcnt vmcnt(" #n ")" ::: "memory")
#define PG8_WAIT_L(n) asm volatile("s_waitcnt lgkmcnt(" #n ")" ::: "memory")
#define PG8_BAR __builtin_amdgcn_s_barrier()
#define PG8_SCHED __builtin_amdgcn_sched_barrier(0)
    Unit cur, nxt; int ui = 0;
    if (!S.next(0, cur)) return;
    f32x4 acc[2][2][4][2];
#pragma unroll
    for (int a = 0; a < 2; ++a)
#pragma unroll
        for (int b = 0; b < 2; ++b)
#pragma unroll
            for (int m = 0; m < 4; ++m)
#pragma unroll
                for (int n = 0; n < 2; ++n) acc[a][b][m][n] = (f32x4){0.f, 0.f, 0.f, 0.f};
    bf16x8 At[4][2], B0[2][2], B1[2][2];
    const char* cA = (const char*)g.A + (size_t)cur.pm * tstep; const char* cB = (const char*)g.Bt + (size_t)cur.pn * tstep;
    S.a_ready(cur);
    if constexpr (SP2) {
        PG8_STAGE(PG8_SB(0, 0), cB, voffB); PG8_STAGE(PG8_SB(0, 1), cB + hstep, voffB); PG8_STAGE_A(PG8_SA(0, 0), cA, voffA); PG8_STAGE_A(PG8_SA(0, 1), cA + hstep, voffA);
        if (wr == 1) PG8_BAR;
        PG8_WAIT_V(2); PG8_BAR;
        PG8_STAGE(PG8_SB(1, 0), cB + kstep, voffB); PG8_STAGE_A(PG8_SA(1, 0), cA + kstep, voffA); PG8_STAGE(PG8_SB(1, 1), cB + hstep + kstep, voffB);
        PG8_WAIT_V(6); PG8_BAR;
    } else {
        PG8_STAGE(PG8_SB(0, 0), cB, voffB); PG8_STAGE_A(PG8_SA(0, 0), cA, voffA); PG8_STAGE(PG8_SB(0, 1), cB + hstep, voffB); PG8_STAGE_A(PG8_SA(0, 1), cA + hstep, voffA);
        if (wr == 1) PG8_BAR;
        PG8_WAIT_V(4); PG8_BAR;
        PG8_STAGE(PG8_SB(1, 0), cB + kstep, voffB); PG8_STAGE_A(PG8_SA(1, 0), cA + kstep, voffA); PG8_STAGE(PG8_SB(1, 1), cB + hstep + kstep, voffB);
        PG8_WAIT_V(6); PG8_BAR;
    }
    for (;;) {
        const bool has_next = S.next(ui + 1, nxt);
        const char* nA = has_next ? (const char*)g.A + (size_t)nxt.pm * tstep : cA; const char* nB = has_next ? (const char*)g.Bt + (size_t)nxt.pn * tstep : cB;
        for (int t = 0; t < nt; t += 2) {
            const bool last = (t == nt - 2);
            const char* a1 = cA + (size_t)(t + 1) * kstep;
            const char* a2 = last ? nA : cA + (size_t)(t + 2) * kstep; const char* b2 = last ? nB : cB + (size_t)(t + 2) * kstep;
            const char* a3 = a2 + kstep; const char* b3 = b2 + kstep;
            if (last && has_next) S.a_ready(nxt);
            if constexpr (SP2) {
            PG8_LDB(B0, 0, 0); PG8_LDB(B1, 0, 1); PG8_SCHED; PG8_LDA(At, 0, 0); PG8_STAGE_A(PG8_SA(1, 1), a1 + hstep, voffA);
            PG8_WAIT_V(8); PG8_WAIT_L(0); PG8_BAR; PG8_MMA(0, 0, At, B0); PG8_MMA(0, 1, At, B1); PG8_BAR; PG8_SCHED;
            PG8_LDA(At, 0, 1); PG8_STAGE(PG8_SB(0, 0), b2, voffB); PG8_STAGE(PG8_SB(0, 1), b2 + hstep, voffB); PG8_STAGE_A(PG8_SA(0, 0), a2, voffA);
            PG8_WAIT_V(8); PG8_WAIT_L(0); PG8_BAR; PG8_MMA(1, 0, At, B0); PG8_MMA(1, 1, At, B1); PG8_BAR; PG8_SCHED;
            PG8_LDB(B0, 1, 0); PG8_LDB(B1, 1, 1); PG8_SCHED; PG8_LDA(At, 1, 0); PG8_STAGE_A(PG8_SA(0, 1), a2 + hstep, voffA);
            PG8_WAIT_V(8); PG8_WAIT_L(0); PG8_BAR; PG8_MMA(0, 0, At, B0); PG8_MMA(0, 1, At, B1); PG8_BAR; PG8_SCHED;
            PG8_LDA(At, 1, 1); PG8_STAGE(PG8_SB(1, 0), b3, voffB); PG8_STAGE(PG8_SB(1, 1), b3 + hstep, voffB); PG8_STAGE_A(PG8_SA(1, 0), a3, voffA);
            PG8_WAIT_V(8); PG8_WAIT_L(0); PG8_BAR; PG8_MMA(1, 0, At, B0); PG8_MMA(1, 1, At, B1); PG8_BAR; PG8_SCHED;
            } else {
            PG8_LDB(B0, 0, 0); PG8_SCHED; PG8_LDA(At, 0, 0); PG8_STAGE_A(PG8_SA(1, 1), a1 + hstep, voffA);
            PG8_WAIT_L(8); PG8_BAR; PG8_WAIT_L(0); PG8_MMA(0, 0, At, B0); PG8_BAR; PG8_SCHED;
            PG8_LDB(B1, 0, 1); PG8_STAGE(PG8_SB(0, 0), b2, voffB);
            PG8_BAR; PG8_WAIT_L(0); PG8_MMA(0, 1, At, B1); PG8_BAR;
            PG8_LDA(At, 0, 1); PG8_STAGE_A(PG8_SA(0, 0), a2, voffA);
            PG8_BAR; PG8_WAIT_L(0); PG8_MMA(1, 0, At, B0); PG8_BAR; PG8_SCHED;
            PG8_STAGE(PG8_SB(0, 1), b2 + hstep, voffB);
            PG8_WAIT_V(6); PG8_BAR; PG8_MMA(1, 1, At, B1); PG8_BAR;
            PG8_LDB(B0, 1, 0); PG8_SCHED; PG8_LDA(At, 1, 0); PG8_STAGE_A(PG8_SA(0, 1), a2 + hstep, voffA);
            PG8_WAIT_L(8); PG8_BAR; PG8_WAIT_L(0); PG8_MMA(0, 0, At, B0); PG8_BAR; PG8_SCHED;
            PG8_LDB(B1, 1, 1); PG8_STAGE(PG8_SB(1, 0), b3, voffB);
            PG8_BAR; PG8_WAIT_L(0); PG8_MMA(0, 1, At, B1); PG8_BAR;
            PG8_LDA(At, 1, 1); PG8_STAGE_A(PG8_SA(1, 0), a3, voffA);
            PG8_BAR; PG8_WAIT_L(0); PG8_MMA(1, 0, At, B0); PG8_BAR; PG8_SCHED;
            PG8_STAGE(PG8_SB(1, 1), b3 + hstep, voffB);
            PG8_WAIT_V(6); PG8_BAR; PG8_MMA(1, 1, At, B1); PG8_BAR;
            }
        }
        if constexpr (ALIGN_EPI) { if (wr == 0) PG8_BAR; }
        if constexpr (!Epi::AFTER_DRAIN) { E(acc, cur, wr, wc, fr, fq); S.done(cur); }
        if (!has_next) break;
#pragma unroll
        for (int a = 0; a < 2; ++a)
#pragma unroll
            for (int b = 0; b < 2; ++b)
#pragma unroll
                for (int m = 0; m < 4; ++m)
#pragma unroll
                    for (int n = 0; n < 2; ++n) acc[a][b][m][n] = (f32x4){0.f, 0.f, 0.f, 0.f};
        cur = nxt; cA = nA; cB = nB; ++ui;
        if constexpr (ALIGN_EPI) { if (wr == 1) PG8_BAR; }
    }
    PG8_WAIT_V(0);
    if constexpr (!ALIGN_EPI) { if (wr == 0) PG8_BAR; }
    PG8_BAR;
    if constexpr (Epi::AFTER_DRAIN) { E.fused(acc, cur, wr, wc, fr, fq, lds, wid, lane); S.done(cur); }
#undef PG8_SA
#undef PG8_SB
#undef PG8_STAGE
#undef PG8_STAGE_A
#undef PG8_STAGE_X
#undef PG8_LDA
#undef PG8_LDB
#undef PG8_MMA
#undef PG8_WAIT_V
#undef PG8_WAIT_L
#undef PG8_BAR
#undef PG8_SCHED
}
}

#ifndef SCALE_MIX
#define SCALE_MIX 1.0f
#endif
#ifndef SCALE_FFN
#define SCALE_FFN 1.0f
#endif
namespace mk {
#ifdef ZERO_SSD
constexpr float ZS = 0.f;
#elif defined(SC_SSD)
constexpr float ZS = SC_SSD;
#else
constexpr float ZS = 1.f;
#endif
#ifdef ZERO_FOX
constexpr float ZF = 0.f;
#elif defined(SC_FOX)
constexpr float ZF = SC_FOX;
#else
constexpr float ZF = 1.f;
#endif
#ifdef ZERO_SC
constexpr float ZC = 0.f;
#elif defined(SC_SC)
constexpr float ZC = SC_SC;
#else
constexpr float ZC = 1.f;
#endif
using pg8::bf16_t; using pg8::bf16x8; using pg8::f32x4; using pg8::u32x4;
typedef unsigned u32x2 __attribute__((ext_vector_type(2)));
constexpr int DM = 1024, BATCH = 4, SEQ = 4096, MROWS = BATCH * SEQ, DFF = 2816, NFF = 2 * DFF, NPROJ = 3072, NMOD = 9216;
constexpr int NT = 512, NW = 8;
constexpr float ALPHA = 1.4142135623730951f, LN_EPS = 1e-5f, RMS_EPS = 1e-5f, LOG2E = 1.4426950408889634f;
constexpr int PC_Z = 0, PC_XBC = 512, PC_Q = 1536, PC_K = 1792, PC_V = 2048, PC_SB = 2304, PC_SC = 2560, PC_SX = 2816;
constexpr size_t MiB = 1u << 20;
constexpr size_t WS_MOD = 0, WS_WMISC = 1 * MiB, WS_DTF = 2 * MiB, WS_CDEC = 3 * MiB, WS_BAR = 3 * MiB + 512 * 1024, WS_W = 4 * MiB;
constexpr size_t W_L = 41 * MiB;
constexpr size_t WO_1IN = 0, WO_1OUT = 11 * MiB, WO_MI = 11 * MiB + 5632 * 1024, WO_MO = WO_MI + 6 * MiB, WO_2IN = WO_MO + 2 * MiB, WO_2OUT = WO_2IN + 11 * MiB;
static_assert(WO_2OUT + 5632 * 1024 == W_L, "weight map");
constexpr size_t WS_HB = WS_W + 2 * W_L;
constexpr size_t WS_BIG = WS_HB + 32 * MiB;
constexpr size_t WS_YCAT = WS_BIG + 96 * MiB;
constexpr size_t WS_ST = WS_YCAT + 32 * MiB;
constexpr size_t WS_VT = WS_ST + 32 * MiB;
constexpr size_t WS_END = WS_VT + 8 * MiB;
constexpr int LDS_BYTES = 147456;

struct Args { const float* in[22]; float* out; unsigned char* ws; };
typedef const __attribute__((address_space(4))) Args* CArgsP;
__device__ __forceinline__ CArgsP get_args() { CArgsP p = (CArgsP)__builtin_amdgcn_kernarg_segment_ptr(); asm volatile("" : "+s"(p)); return p; }

typedef float f32x2_t __attribute__((ext_vector_type(2))); typedef __bf16 bf16x2_t __attribute__((ext_vector_type(2)));
__device__ __forceinline__ float bf_lo(unsigned w) { return __uint_as_float(w << 16); }
__device__ __forceinline__ float bf_hi(unsigned w) { return __uint_as_float(w & 0xffff0000u); }
__device__ __forceinline__ float bf2f(bf16_t v) { return __uint_as_float((unsigned)v << 16); }
#ifdef DEGRADE_BF16
__device__ __forceinline__ unsigned pk2(float lo, float hi) { return DEGRADE_OP(pg8::cvt_pk_bf16(lo, hi)); }
#elif defined(MANUAL_RNE)
__device__ __forceinline__ unsigned f2bf_rne_(float f) { unsigned u = __builtin_bit_cast(unsigned, f); return (u + 0x7fffu + ((u >> 16) & 1u)) >> 16; }
__device__ __forceinline__ unsigned pk2(float lo, float hi) { return f2bf_rne_(lo) | (f2bf_rne_(hi) << 16); }
#else
__device__ __forceinline__ unsigned pk2(float lo, float hi) { return pg8::cvt_pk_bf16(lo, hi); }
#endif
#ifdef DEGRADE_W
__device__ __forceinline__ unsigned pk2w(float lo, float hi) { return pg8::cvt_pk_bf16(lo, hi) & 0xFFFEFFFEu; }
#else
__device__ __forceinline__ unsigned pk2w(float lo, float hi) { return pg8::cvt_pk_bf16(lo, hi); }
#endif
__device__ __forceinline__ bf16_t f2bf(float f) { return (bf16_t)(pk2(f, 0.f) & 0xffffu); }
#ifndef DEG_SITES
#define DEG_SITES 0
#endif
template <int S> __device__ __forceinline__ unsigned pk2t(float lo, float hi) { unsigned r; if constexpr (S >= 2) { f32x2_t v_ = {lo, hi}; r = __builtin_bit_cast(unsigned, __builtin_convertvector(v_, bf16x2_t)); } else r = pg8::cvt_pk_bf16(lo, hi); if ((DEG_SITES >> S) & 1) r &= 0xFFFEFFFEu; return r; }
template <int S> __device__ __forceinline__ bf16_t f2bft(float f) { return (bf16_t)(pk2t<S>(f, 0.f) & 0xffffu); }
__device__ __forceinline__ float siluf(float v) { return v * __builtin_amdgcn_rcpf(1.f + __builtin_amdgcn_exp2f(-v * LOG2E)); }
__device__ __forceinline__ float wave_sum(float v) {
#pragma unroll
    for (int o = 1; o < 64; o <<= 1) v += __shfl_xor(v, o);
    return v;
}
__device__ __forceinline__ float wave_incl_scan(float v, int lane) {
#pragma unroll
    for (int o = 1; o < 64; o <<= 1) { const float t = __shfl_up(v, o); if (lane >= o) v += t; }
    return v;
}
__device__ __forceinline__ void unpack8(const u32x4 r, float (&f)[8]) {
    f[0] = bf_lo(r.x); f[1] = bf_hi(r.x); f[2] = bf_lo(r.y); f[3] = bf_hi(r.y); f[4] = bf_lo(r.z); f[5] = bf_hi(r.z); f[6] = bf_lo(r.w); f[7] = bf_hi(r.w);
}
template <class T> __device__ __forceinline__ T ldx(const T* p) {
    if constexpr (sizeof(T) == 16) { const unsigned long long* q = (const unsigned long long*)p; struct { unsigned long long a, b; } r;
        r.a = __hip_atomic_load(q, __ATOMIC_RELAXED, __HIP_MEMORY_SCOPE_AGENT); r.b = __hip_atomic_load(q + 1, __ATOMIC_RELAXED, __HIP_MEMORY_SCOPE_AGENT); return __builtin_bit_cast(T, r); }
    else if constexpr (sizeof(T) == 4) { const unsigned v = __hip_atomic_load((const unsigned*)p, __ATOMIC_RELAXED, __HIP_MEMORY_SCOPE_AGENT); return __builtin_bit_cast(T, v); }
    else { static_assert(sizeof(T) == 2, "ldx"); const unsigned short v = __hip_atomic_load((const unsigned short*)p, __ATOMIC_RELAXED, __HIP_MEMORY_SCOPE_AGENT); return __builtin_bit_cast(T, v); }
}
template <class T> __device__ __forceinline__ T ldxb(const void* ubase, unsigned off) {
    static_assert(sizeof(T) == 16, "ldxb");
    __amdgpu_buffer_rsrc_t r = __builtin_amdgcn_make_buffer_rsrc(const_cast<void*>(ubase), 0, 0x7fffffff, 0x00020000);
    return __builtin_bit_cast(T, __builtin_amdgcn_raw_buffer_load_b128(r, off, 0, 16));
}
#define LDS_WAIT() asm volatile("s_waitcnt lgkmcnt(0)" ::: "memory")

__device__ __forceinline__ int srcmap(int mode, int r0) {
    if (mode == 1) { const int pn = r0 >> 8, j = r0 & 255; return j < 128 ? pn * 128 + j : DFF + pn * 128 + (j - 128); }
    if (mode == 2) { return r0 < 1536 ? r0 : (r0 < 2304 ? r0 + 8 : r0 + 12); }
    return r0;
}
__device__ __forceinline__ void p0_item(const float* __restrict__ W, int K, int Nsrc, int Ndst, bf16_t* __restrict__ WT, int mode, float* scr, int item, int lane) {
    const int nblk = Ndst / 32, kb = item / nblk, nb = item % nblk, k0 = 64 * kb, r0 = 32 * nb, s0 = srcmap(mode, r0);
#pragma unroll
    for (int i = 0; i < 8; ++i) { const int kk = 8 * i + (lane >> 3), c4 = 4 * (lane & 7); const f32x4 v = *(const f32x4*)(W + (size_t)(k0 + kk) * Nsrc + s0 + c4);
        scr[kk * 33 + c4] = v.x; scr[kk * 33 + c4 + 1] = v.y; scr[kk * 33 + c4 + 2] = v.z; scr[kk * 33 + c4 + 3] = v.w; }
    LDS_WAIT();
    const int c = lane & 7;
#pragma unroll
    for (int j = 0; j < 4; ++j) { const int n = (lane >> 3) + 8 * j; const float* s = scr + (8 * c) * 33 + n;
        u32x4 o; o.x = pk2w(s[0 * 33], s[1 * 33]); o.y = pk2w(s[2 * 33], s[3 * 33]); o.z = pk2w(s[4 * 33], s[5 * 33]); o.w = pk2w(s[6 * 33], s[7 * 33]);
        *(u32x4*)(WT + (size_t)(r0 + n) * K + k0 + 8 * c) = o; }
    LDS_WAIT();
}
__device__ __forceinline__ void phase_p0(CArgsP a, unsigned char* lds, int tid, int wave, int lane) {
    float* mod = (float*)(a->ws + WS_MOD);
    float* sc = (float*)(lds + 69632);
    float* red = (float*)(lds + 69632 + 16384);
    for (int i = tid; i < 4096; i += NT) { const float v = a->in[1][i]; sc[i] = v / (1.f + expf(-v)); }
    __syncthreads();
    for (int it = blockIdx.x; it < 288; it += gridDim.x) {
        const int l = it / 144, cgp = it % 144, col = cgp * 64 + lane, k0 = wave * 128;
        const float* Wp = a->in[4] + (size_t)l * DM * NMOD + (size_t)k0 * NMOD + col;
        float a0 = 0.f, a1 = 0.f, a2 = 0.f, a3 = 0.f;
#pragma unroll 16
        for (int k = 0; k < 128; ++k) { const float w = Wp[(size_t)k * NMOD];
            a0 += sc[k0 + k] * w; a1 += sc[1024 + k0 + k] * w; a2 += sc[2048 + k0 + k] * w; a3 += sc[3072 + k0 + k] * w; }
        red[(wave * 4 + 0) * 64 + lane] = a0; red[(wave * 4 + 1) * 64 + lane] = a1; red[(wave * 4 + 2) * 64 + lane] = a2; red[(wave * 4 + 3) * 64 + lane] = a3;
        __syncthreads();
        if (tid < 256) { const int b = tid >> 6, ln = tid & 63; float s = 0.f;
#pragma unroll
            for (int w = 0; w < 8; ++w) s += red[(w * 4 + b) * 64 + ln];
            mod[(size_t)(l * 4 + b) * NMOD + cgp * 64 + ln] = s + a->in[5][l * NMOD + cgp * 64 + ln]; }
        __syncthreads();
    }
    { float* wm = (float*)(a->ws + WS_WMISC);
      for (int i = blockIdx.x * NT + tid; i < 2 * 12 * 1024; i += gridDim.x * NT) { const int l = i / 12288, r = i % 12288, j = r / 1024, k = r % 1024;
          const int colj = j < 8 ? 1536 + j : 2312 + (j - 8); wm[i] = a->in[8][(size_t)l * DM * 3084 + (size_t)k * 3084 + colj]; } }
    float* scr = (float*)(lds + wave * 8448);
    const int gw = blockIdx.x * NW + wave, NGW = gridDim.x * NW;
    constexpr int I_IN = 16 * (NFF / 32), I_OUT = (DFF / 64) * 32, I_MI = 16 * (NPROJ / 32), I_MO = 16 * 32, I_L = 2 * I_IN + 2 * I_OUT + I_MI + I_MO;
    for (int it = gw; it < 2 * I_L; it += NGW) {
        const int l = it / I_L; int r = it % I_L; unsigned char* wl = a->ws + WS_W + l * W_L;
        if (r < I_IN) { p0_item(a->in[6] + (size_t)l * DM * NFF, DM, NFF, NFF, (bf16_t*)(wl + WO_1IN), 1, scr, r, lane); continue; } r -= I_IN;
        if (r < I_IN) { p0_item(a->in[18] + (size_t)l * DM * NFF, DM, NFF, NFF, (bf16_t*)(wl + WO_2IN), 1, scr, r, lane); continue; } r -= I_IN;
        if (r < I_OUT) { p0_item(a->in[7] + (size_t)l * DFF * DM, DFF, DM, DM, (bf16_t*)(wl + WO_1OUT), 0, scr, r, lane); continue; } r -= I_OUT;
        if (r < I_OUT) { p0_item(a->in[19] + (size_t)l * DFF * DM, DFF, DM, DM, (bf16_t*)(wl + WO_2OUT), 0, scr, r, lane); continue; } r -= I_OUT;
        if (r < I_MI) { p0_item(a->in[8] + (size_t)l * DM * 3084, DM, 3084, NPROJ, (bf16_t*)(wl + WO_MI), 2, scr, r, lane); continue; } r -= I_MI;
        p0_item(a->in[9] + (size_t)l * DM * DM, DM, DM, DM, (bf16_t*)(wl + WO_MO), 0, scr, r, lane);
    }
}

template <bool MISC>
__device__ __forceinline__ void phase_ln(const float* src, float* X, bf16_t* Hb, const float* gamma, const float* beta, const float* modl, int sub, bool write_h,
                                         const float* wm, float* DTF, unsigned char* lds, int tid, int wave, int lane) {
    float* wml = (float*)lds;
    if (MISC) { for (int i = tid; i < 12288; i += NT) wml[i] = wm[i]; __syncthreads(); }
    const int gw = blockIdx.x * NW + wave, NGW = gridDim.x * NW;
    f32x4 g4[4], b4[4];
#pragma unroll
    for (int j = 0; j < 4; ++j) { g4[j] = *(const f32x4*)(gamma + 4 * lane + 256 * j); b4[j] = *(const f32x4*)(beta + 4 * lane + 256 * j); }
    for (int blk = gw; blk < MROWS / 8; blk += NGW) {
        const int m0 = blk * 8, b = m0 / SEQ;
        const float* shp = modl + (size_t)b * NMOD + (sub * 3 + 0) * DM; const float* scp = modl + (size_t)b * NMOD + (sub * 3 + 1) * DM;
        f32x4 sh4[4], sc4[4];
#pragma unroll
        for (int j = 0; j < 4; ++j) { if (write_h) { sh4[j] = *(const f32x4*)(shp + 4 * lane + 256 * j); sc4[j] = *(const f32x4*)(scp + 4 * lane + 256 * j) + 1.0f; } else { sh4[j] = (f32x4){0.f, 0.f, 0.f, 0.f}; sc4[j] = sh4[j]; } }
#pragma unroll 2
        for (int i = 0; i < 8; ++i) {
            const size_t m = (size_t)(m0 + i);
            f32x4 v[4]; float s = 0.f;
#pragma unroll
            for (int j = 0; j < 4; ++j) { v[j] = ldxb<f32x4>(src, (unsigned)((m * DM + 4 * lane + 256 * j) * 4)); s += (v[j].x + v[j].y) + (v[j].z + v[j].w); }
            const float mean = wave_sum(s) * (1.f / DM); float s2 = 0.f;
#pragma unroll
            for (int j = 0; j < 4; ++j) { v[j] = v[j] - mean; s2 += (v[j].x * v[j].x + v[j].y * v[j].y) + (v[j].z * v[j].z + v[j].w * v[j].w); }
            const float rstd = 1.f / sqrtf(wave_sum(s2) * (1.f / DM) + LN_EPS);
#pragma unroll
            for (int j = 0; j < 4; ++j) { v[j] = v[j] * rstd * g4[j] + b4[j]; *(f32x4*)(X + m * DM + 4 * lane + 256 * j) = v[j]; }
            if (write_h) {
#pragma unroll
                for (int j = 0; j < 4; ++j) { v[j] = v[j] * sc4[j] + sh4[j]; u32x2 w; w.x = pk2t<0>(v[j].x, v[j].y); w.y = pk2t<0>(v[j].z, v[j].w); *(u32x2*)(Hb + m * DM + 4 * lane + 256 * j) = w; }
                if (MISC) {
                    float keep = 0.f;
#pragma unroll
                    for (int jj = 0; jj < 12; ++jj) { float d = 0.f;
#pragma unroll
                        for (int j = 0; j < 4; ++j) { const f32x4 w4 = *(const f32x4*)(wml + jj * 1024 + 4 * lane + 256 * j); d += (v[j].x * w4.x + v[j].y * w4.y) + (v[j].z * w4.z + v[j].w * w4.w); }
                        d = wave_sum(d); if (lane == jj) keep = d; }
                    if (lane < 12) DTF[m * 12 + lane] = keep;
                }
            }
        }
    }
}

struct EpiMulti {
    static constexpr bool PERM = true, AFTER_DRAIN = false;
    int code;
    __device__ __forceinline__ void operator()(const f32x4 (&acc)[2][2][4][2], const pg8::Unit& u, int wr, int wc, int fr, int fq) const {
        CArgsP a = get_args(); int cd = code; asm volatile("" : "+s"(cd)); const int s = cd & 255, l = cd >> 8;
        unsigned char* ws = a->ws;
        if (s == 0 || s == 9) {
            bf16_t* O = (bf16_t*)(ws + WS_BIG);
            const int row0 = u.pm * 256 + wr * 64 + fr, col0 = u.pn * 128 + wc * 32 + 8 * fq;
#pragma unroll
            for (int ai = 0; ai < 2; ++ai)
#pragma unroll
                for (int m = 0; m < 4; ++m) {
                    const f32x4 g0 = acc[ai][0][m][0], g1 = acc[ai][0][m][1], u0 = acc[ai][1][m][0], u1 = acc[ai][1][m][1];
                    u32x4 w;
                    w.x = pk2t<1>(siluf(g0[0]) * u0[0], siluf(g0[1]) * u0[1]); w.y = pk2t<1>(siluf(g0[2]) * u0[2], siluf(g0[3]) * u0[3]);
                    w.z = pk2t<1>(siluf(g1[0]) * u1[0], siluf(g1[1]) * u1[1]); w.w = pk2t<1>(siluf(g1[2]) * u1[2], siluf(g1[3]) * u1[3]);
                    *(u32x4*)(O + (size_t)(row0 + ai * 128 + m * 16) * DFF + col0) = w;
                }
        } else if (s == 3) {
            bf16_t* O = (bf16_t*)(ws + WS_BIG);
            const int row0 = u.pm * 256 + wr * 64 + fr, col0 = u.pn * 256 + wc * 32 + 8 * fq;
#pragma unroll
            for (int ai = 0; ai < 2; ++ai)
#pragma unroll
                for (int m = 0; m < 4; ++m)
#pragma unroll
                    for (int bj = 0; bj < 2; ++bj) { const f32x4 v0 = acc[ai][bj][m][0], v1 = acc[ai][bj][m][1];
                        u32x4 w; w.x = pk2t<1>(v0[0], v0[1]); w.y = pk2t<1>(v0[2], v0[3]); w.z = pk2t<1>(v1[0], v1[1]); w.w = pk2t<1>(v1[2], v1[3]);
                        *(u32x4*)(O + (size_t)(row0 + ai * 128 + m * 16) * NPROJ + col0 + bj * 128) = w; }
        } else {
            const int sub = s == 1 ? 0 : (s == 7 ? 1 : 2);
#ifdef ZERO_FFN
            const float coef = s == 7 ? 1.0f : 0.0f;
#elif defined(ZERO_MIX)
            const float coef = s == 7 ? 0.0f : 0.5f;
#else
            const float coef = s == 7 ? 1.0f * SCALE_MIX : 0.5f * SCALE_FFN;
#endif
            float* X = a->out; const float* gate = (const float*)(ws + WS_MOD) + (size_t)l * 4 * NMOD + (sub * 3 + 2) * DM;
            const int b = u.pm >> 4, col0 = u.pn * 256 + wc * 32 + 8 * fq;
#pragma unroll
            for (int bj = 0; bj < 2; ++bj)
#pragma unroll
                for (int n = 0; n < 2; ++n) {
                    const int c = col0 + bj * 128 + n * 4;
                    const f32x4 gv = *(const f32x4*)(gate + (size_t)b * NMOD + c) * coef;
#pragma unroll
                    for (int ai = 0; ai < 2; ++ai)
#pragma unroll
                        for (int m = 0; m < 4; ++m) { float* p = X + (size_t)(u.pm * 256 + ai * 128 + wr * 64 + m * 16 + fr) * DM + c;
                            const f32x4 xv = ldxb<f32x4>(X, (unsigned)((size_t)(p - X) * 4));
#ifdef SKIP_T
                            const int rr_ = (u.pm * 256 + ai * 128 + wr * 64 + m * 16 + fr) & 4095; const float km_ = (s == 7 && rr_ >= SKIP_T0 && rr_ < SKIP_T) ? 0.f : 1.f;
                            *(f32x4*)p = xv * ALPHA + gv * acc[ai][bj][m][n] * km_; }
#else
                            *(f32x4*)p = xv * ALPHA + gv * acc[ai][bj][m][n]; }
#endif
                }
        }
    }
};

__device__ __forceinline__ void ssd_dt_acs(const float* DTF, const float* dt_bias, const float* a_log, int R0, int g, int wave, int lane, float* sDt, float* sAcs) {
    if (wave < 4) { const int h = g * 4 + wave; const float x = ldx(DTF + (size_t)(R0 + lane) * 12 + h) + dt_bias[h];
        const float dt = x > 20.f ? x : log1pf(expf(x)); const float av = -expf(a_log[h]) * dt; const float cs = wave_incl_scan(av, lane);
        sDt[wave * 64 + lane] = dt; sAcs[wave * 64 + lane] = cs; }
}
__device__ __forceinline__ void conv8(const bf16_t* PROJ, int b, int t, int cc, const float* cw, const float* cb, float (&o)[8]) {
    { const f32x4 b0 = *(const f32x4*)(cb + cc), b1 = *(const f32x4*)(cb + cc + 4); o[0] = b0.x; o[1] = b0.y; o[2] = b0.z; o[3] = b0.w; o[4] = b1.x; o[5] = b1.y; o[6] = b1.z; o[7] = b1.w; }
#pragma unroll
    for (int k = 0; k < 4; ++k) { const int tt = t - 3 + k;
        if (tt >= 0) { const u32x4 raw = ldxb<u32x4>(PROJ, (unsigned)(((size_t)(b * SEQ + tt) * NPROJ + PC_XBC + cc) * 2)); float x[8]; unpack8(raw, x);
            const f32x4 w0 = *(const f32x4*)(cw + k * 1024 + cc), w1 = *(const f32x4*)(cw + k * 1024 + cc + 4);
            o[0] += w0.x * x[0]; o[1] += w0.y * x[1]; o[2] += w0.z * x[2]; o[3] += w0.w * x[3]; o[4] += w1.x * x[4]; o[5] += w1.y * x[5]; o[6] += w1.z * x[6]; o[7] += w1.w * x[7]; } }
#pragma unroll
    for (int j = 0; j < 8; ++j) o[j] = siluf(o[j]);
}

__device__ __forceinline__ void phase_ma(CArgsP a, int l, unsigned char* lds, int tid, int wave, int lane) {
    const bf16_t* PROJ = (const bf16_t*)(a->ws + WS_BIG); bf16_t* YCAT = (bf16_t*)(a->ws + WS_YCAT); bf16_t* ST = (bf16_t*)(a->ws + WS_ST);
    const float* DTF = (const float*)(a->ws + WS_DTF); float* CDEC = (float*)(a->ws + WS_CDEC);
    const float* cw = a->in[10] + (size_t)l * 4 * 1024; const float* cb = a->in[11] + l * 1024; const float* dtb = a->in[12] + l * 8; const float* alog = a->in[13] + l * 8;
    const int fr = lane & 15, fq = lane >> 4;
    bf16_t* sBT = (bf16_t*)lds;
    bf16_t* sXT = (bf16_t*)(lds + 18432);
    float* sDt = (float*)(lds + 18432 + 36864);
    float* sAcs = sDt + 256;
    for (int it = blockIdx.x; it < 512; it += gridDim.x) {
        const int b = it >> 7, c = (it >> 1) & 63, g = it & 1, t0 = c * 64, R0 = b * SEQ + t0;
        ssd_dt_acs(DTF, dtb, alog, R0, g, wave, lane, sDt, sAcs);
        __syncthreads();
        if (wave < 4 && lane == 63) CDEC[(b * 64 + c) * 8 + g * 4 + wave] = expf(sAcs[wave * 64 + 63]);
#pragma unroll 2
        for (int o = tid; o < 3072; o += NT) {
            float v[8];
            if (o < 1024) { const int ll = o >> 4, n = (o & 15) * 8; conv8(PROJ, b, t0 + ll, 512 + g * 128 + n, cw, cb, v);
#pragma unroll
                for (int j = 0; j < 8; ++j) sBT[(n + j) * 72 + ll] = f2bft<2>(v[j]); }
            else { const int o2 = o - 1024, ll = o2 >> 5, ch = (o2 & 31) * 8, e = ch >> 6, p = ch & 63; conv8(PROJ, b, t0 + ll, g * 256 + ch, cw, cb, v);
                const float wgt = sDt[e * 64 + ll] * expf(sAcs[e * 64 + 63] - sAcs[e * 64 + ll]);
#pragma unroll
                for (int j = 0; j < 8; ++j) sXT[(e * 64 + p + j) * 72 + ll] = f2bft<2>(v[j] * wgt); }
        }
        __syncthreads();
        { const int e = wave >> 1, nh = wave & 1;
          f32x4 acc[4][4];
#pragma unroll
          for (int i = 0; i < 4; ++i)
#pragma unroll
              for (int j = 0; j < 4; ++j) acc[i][j] = (f32x4){0.f, 0.f, 0.f, 0.f};
#pragma unroll
          for (int kk = 0; kk < 2; ++kk) {
              bf16x8 af[4], bfr[4];
#pragma unroll
              for (int i = 0; i < 4; ++i) af[i] = *(const bf16x8*)(sBT + (nh * 64 + 16 * i + fr) * 72 + 32 * kk + 8 * fq);
#pragma unroll
              for (int j = 0; j < 4; ++j) bfr[j] = *(const bf16x8*)(sXT + (e * 64 + 16 * j + fr) * 72 + 32 * kk + 8 * fq);
#pragma unroll
              for (int i = 0; i < 4; ++i)
#pragma unroll
                  for (int j = 0; j < 4; ++j) acc[i][j] = __builtin_amdgcn_mfma_f32_16x16x32_bf16(af[i], bfr[j], acc[i][j], 0, 0, 0);
          }
          bf16_t* sp = ST + (size_t)((b * 64 + c) * 8 + g * 4 + e) * 8192;
#pragma unroll
          for (int i = 0; i < 4; ++i)
#pragma unroll
              for (int j = 0; j < 4; ++j) { u32x2 w; w.x = pk2t<2>(acc[i][j][0], acc[i][j][1]); w.y = pk2t<2>(acc[i][j][2], acc[i][j][3]);
                  *(u32x2*)(sp + (16 * j + fr) * 128 + nh * 64 + 16 * i + 4 * fq) = w; }
        }
        __syncthreads();
    }
    { const float* sw = a->in[17] + (size_t)l * 3 * 256;
      for (int op = blockIdx.x * NT + tid; op < MROWS * 32; op += gridDim.x * NT) {
          const int m = op >> 5, ch = (op & 31) * 8, t = m & (SEQ - 1);
          float acc[8];
#pragma unroll
          for (int j = 0; j < 8; ++j) acc[j] = 0.f;
#pragma unroll
          for (int k = 0; k < 3; ++k) { const int tt = t - 2 + k;
              if (tt >= 0) { const unsigned ro = (unsigned)((size_t)(m - 2 + k) * NPROJ * 2); float cg[8], xi[8]; unpack8(ldxb<u32x4>(PROJ, ro + (PC_SC + ch) * 2), cg); unpack8(ldxb<u32x4>(PROJ, ro + (PC_SX + ch) * 2), xi);
                  const f32x4 w0 = *(const f32x4*)(sw + k * 256 + ch), w1 = *(const f32x4*)(sw + k * 256 + ch + 4);
                  acc[0] += w0.x * (cg[0] * xi[0]); acc[1] += w0.y * (cg[1] * xi[1]); acc[2] += w0.z * (cg[2] * xi[2]); acc[3] += w0.w * (cg[3] * xi[3]);
                  acc[4] += w1.x * (cg[4] * xi[4]); acc[5] += w1.y * (cg[5] * xi[5]); acc[6] += w1.z * (cg[6] * xi[6]); acc[7] += w1.w * (cg[7] * xi[7]); } }
          float bg[8]; unpack8(ldxb<u32x4>(PROJ, (unsigned)(((size_t)m * NPROJ + PC_SB + ch) * 2)), bg);
#pragma unroll
          for (int j = 0; j < 8; ++j) bg[j] *= ZC;
          u32x4 w; w.x = pk2t<6>(bg[0] * acc[0], bg[1] * acc[1]); w.y = pk2t<6>(bg[2] * acc[2], bg[3] * acc[3]); w.z = pk2t<6>(bg[4] * acc[4], bg[5] * acc[5]); w.w = pk2t<6>(bg[6] * acc[6], bg[7] * acc[7]);
          *(u32x4*)(YCAT + (size_t)m * DM + 768 + ch) = w;
      } }
    { bf16_t* VT = (bf16_t*)(a->ws + WS_VT); bf16_t* sT = (bf16_t*)lds;
      __syncthreads();
      for (int it = blockIdx.x; it < 1024; it += gridDim.x) {
          const int bh = it >> 6, kt = it & 63, b = bh >> 2, h = bh & 3, key = tid >> 3, dch = tid & 7;
          const u32x4 vreg = ldxb<u32x4>(PROJ, (unsigned)(((size_t)(b * SEQ + kt * 64 + key) * NPROJ + PC_V + h * 64 + dch * 8) * 2));
          bf16_t* vd = sT + (dch * 8) * 72 + key;
          vd[0 * 72] = (bf16_t)(vreg.x & 0xffffu); vd[1 * 72] = (bf16_t)(vreg.x >> 16); vd[2 * 72] = (bf16_t)(vreg.y & 0xffffu); vd[3 * 72] = (bf16_t)(vreg.y >> 16);
          vd[4 * 72] = (bf16_t)(vreg.z & 0xffffu); vd[5 * 72] = (bf16_t)(vreg.z >> 16); vd[6 * 72] = (bf16_t)(vreg.w & 0xffffu); vd[7 * 72] = (bf16_t)(vreg.w >> 16);
          __syncthreads();
          const u32x4 o = *(const u32x4*)(sT + key * 72 + dch * 8);
          *(u32x4*)(VT + ((size_t)bh * 64 + key) * SEQ + kt * 64 + dch * 8) = o;
          __syncthreads();
      } }
}

__device__ __forceinline__ void attn_tile(const bf16_t* sKb, const bf16_t* sVb, const float* cf2, int kt, int qw0, int qrow, int fr, int fq, float cfq,
                                          const bf16x8 qf0, const bf16x8 qf1, float& mrun, float& lrun, f32x4 (&o)[4]) {
    constexpr float C2 = 0.125f * LOG2E;
                const int k0 = kt * 64;
                if (k0 <= qw0 + 15) {
                    f32x4 sc[4];
#pragma unroll
                    for (int j = 0; j < 4; ++j) { const bf16x8 a0 = *(const bf16x8*)(sKb + (16 * j + fr) * 72 + fq * 8), a1 = *(const bf16x8*)(sKb + (16 * j + fr) * 72 + 32 + fq * 8);
                        sc[j] = __builtin_amdgcn_mfma_f32_16x16x32_bf16(a0, qf0, (f32x4){0.f, 0.f, 0.f, 0.f}, 0, 0, 0);
                        sc[j] = __builtin_amdgcn_mfma_f32_16x16x32_bf16(a1, qf1, sc[j], 0, 0, 0); }
#pragma unroll
                    for (int j = 0; j < 4; ++j) { const f32x4 ck = *(const f32x4*)(cf2 + k0 + 16 * j + 4 * fq);
#pragma unroll
                        for (int r = 0; r < 4; ++r) sc[j][r] = sc[j][r] * C2 + (cfq - ck[r]); }
                    if (k0 + 63 > qw0) {
#pragma unroll
                        for (int j = 0; j < 4; ++j)
#pragma unroll
                            for (int r = 0; r < 4; ++r) if (k0 + 16 * j + 4 * fq + r > qrow) sc[j][r] = -INFINITY;
                    }
                    float mx = fmaxf(fmaxf(sc[0][0], sc[0][1]), fmaxf(sc[0][2], sc[0][3]));
#pragma unroll
                    for (int j = 1; j < 4; ++j) mx = fmaxf(mx, fmaxf(fmaxf(sc[j][0], sc[j][1]), fmaxf(sc[j][2], sc[j][3])));
                    mx = fmaxf(mx, __shfl_xor(mx, 16)); mx = fmaxf(mx, __shfl_xor(mx, 32));
                    const float mnew = fmaxf(mrun, mx), alpha = __builtin_amdgcn_exp2f(mrun - mnew);
                    float ls = 0.f;
#pragma unroll
                    for (int j = 0; j < 4; ++j)
#pragma unroll
                        for (int r = 0; r < 4; ++r) { sc[j][r] = __builtin_amdgcn_exp2f(sc[j][r] - mnew); ls += sc[j][r]; }
                    lrun = lrun * alpha + ls; mrun = mnew;
#pragma unroll
                    for (int j = 0; j < 4; ++j) o[j] = o[j] * alpha;
#pragma unroll
                    for (int ks = 0; ks < 2; ++ks) {
                        u32x4 pw; pw.x = pk2t<4>(sc[2 * ks][0], sc[2 * ks][1]); pw.y = pk2t<4>(sc[2 * ks][2], sc[2 * ks][3]); pw.z = pk2t<4>(sc[2 * ks + 1][0], sc[2 * ks + 1][1]); pw.w = pk2t<4>(sc[2 * ks + 1][2], sc[2 * ks + 1][3]);
                        const bf16x8 pb = __builtin_bit_cast(bf16x8, pw);
#pragma unroll
                        for (int dj = 0; dj < 4; ++dj) { const bf16_t* vp = sVb + (16 * dj + fr) * 72 + 32 * ks + 4 * fq;
                            const u32x2 lo = *(const u32x2*)vp, hi = *(const u32x2*)(vp + 16); u32x4 vw; vw.x = lo.x; vw.y = lo.y; vw.z = hi.x; vw.w = hi.y;
                            o[dj] = __builtin_amdgcn_mfma_f32_16x16x32_bf16(__builtin_bit_cast(bf16x8, vw), pb, o[dj], 0, 0, 0); }
                    }
                }
}
__device__ __forceinline__ void phase_mb(CArgsP a, int l, unsigned char* lds, int tid, int wave, int lane, bool do_scan) {
    const bf16_t* PROJ = (const bf16_t*)(a->ws + WS_BIG); bf16_t* YCAT = (bf16_t*)(a->ws + WS_YCAT);
    const float* DTF = (const float*)(a->ws + WS_DTF); const float* CDEC = (const float*)(a->ws + WS_CDEC);
    if (do_scan) { unsigned* ST = (unsigned*)(a->ws + WS_ST);
      for (int gid = blockIdx.x * NT + tid; gid < 32 * 4096; gid += gridDim.x * NT) {
          const int bh = gid >> 12, rem = gid & 4095, b = bh >> 3, h = bh & 7;
          float r0 = 0.f, r1 = 0.f;
          for (int c0 = 0; c0 < 64; c0 += 8) {
              unsigned w[8]; float d[8];
#pragma unroll
              for (int i = 0; i < 8; ++i) { w[i] = ldx(ST + (size_t)((b * 64 + c0 + i) * 8 + h) * 4096 + rem); d[i] = ldx(CDEC + (b * 64 + c0 + i) * 8 + h); }
#pragma unroll
              for (int i = 0; i < 8; ++i) { ST[(size_t)((b * 64 + c0 + i) * 8 + h) * 4096 + rem] = pk2t<3>(r0, r1); r0 = r0 * d[i] + bf_lo(w[i]); r1 = r1 * d[i] + bf_hi(w[i]); }
          }
      } }
#ifdef NAIVE_ATTN
    { const float* fbias_ = a->in[16] + l * 4;
      for (int row = blockIdx.x * NT + tid; row < 16 * SEQ; row += gridDim.x * NT) {
          const int bh = row >> 12, q = row & 4095, b = bh >> 2, h = bh & 3; const float fb = fbias_[h];
          float qv[64], o[64];
#pragma unroll
          for (int d = 0; d < 64; ++d) { qv[d] = bf2f(ldx(PROJ + (size_t)(b * SEQ + q) * NPROJ + PC_Q + h * 64 + d)); o[d] = 0.f; }
          float m = -INFINITY, lsum = 0.f, bias = 0.f;
          for (int k = q; k >= 0; --k) {
              const bf16_t* kp = PROJ + (size_t)(b * SEQ + k) * NPROJ + PC_K + h * 64;
              float s = 0.f;
#pragma unroll
              for (int d8 = 0; d8 < 8; ++d8) { float kv[8]; unpack8(ldx((const u32x4*)(kp + d8 * 8)), kv);
#pragma unroll
                  for (int j = 0; j < 8; ++j) s += qv[d8 * 8 + j] * kv[j]; }
              s = s * 0.125f + bias;
              const float mn = fmaxf(m, s), al = expf(m - mn), p = expf(s - mn);
              lsum = lsum * al + p; m = mn;
#pragma unroll
              for (int d8 = 0; d8 < 8; ++d8) { float vv[8]; unpack8(ldx((const u32x4*)(kp + (PC_V - PC_K) + d8 * 8)), vv);
#pragma unroll
                  for (int j = 0; j < 8; ++j) o[d8 * 8 + j] = o[d8 * 8 + j] * al + p * vv[j]; }
              const float x = ldx(DTF + (size_t)(b * SEQ + k) * 12 + 8 + h) + fb; bias += fminf(x, 0.f) - log1pf(expf(-fabsf(x)));
          }
          const float inv = 1.f / lsum;
#pragma unroll
          for (int d = 0; d < 64; ++d) YCAT[(size_t)(b * SEQ + q) * DM + 512 + h * 64 + d] = f2bft<4>(o[d] * inv);
      } }
#endif
    const int fr = lane & 15, fq = lane >> 4;
    float* cf2 = (float*)lds;
    bf16_t* sK = (bf16_t*)(lds + 16384);
    bf16_t* sV = (bf16_t*)(lds + 16384 + 18432);
    float* wtot = (float*)(lds + 16384 + 36864);
    const float* fbias = a->in[16] + l * 4;
    constexpr float C2 = 0.125f * LOG2E;
#ifdef NAIVE_ATTN
    for (int v = 256; v < 256; v += gridDim.x) {
#else
    for (int v = blockIdx.x; v < 256; v += gridDim.x) {
#endif
        const int bh = v >> 4, s = v & 15, b = bh >> 2, h = bh & 3;
        __syncthreads();
        { float vals[8]; float run = 0.f; const float fb = fbias[h];
#pragma unroll
          for (int i = 0; i < 8; ++i) { const float x = ldx(DTF + (size_t)(b * SEQ + tid * 8 + i) * 12 + 8 + h) + fb; const float ls = fminf(x, 0.f) - log1pf(expf(-fabsf(x))); run += ls * LOG2E; vals[i] = run; }
          const float inc = wave_incl_scan(run, lane); if (lane == 63) wtot[wave] = inc;
          __syncthreads();
          float off = inc - run; for (int w = 0; w < wave; ++w) off += wtot[w];
#pragma unroll
          for (int i = 0; i < 8; ++i) cf2[tid * 8 + i] = vals[i] + off;
          __syncthreads(); }
        for (int uu = 0; uu < 2; ++uu) {
            const int qb = uu ? 31 - s : s, q0 = qb * 128, nt = 2 * (qb + 1);
            const int qw0 = q0 + wave * 16, qrow = qw0 + fr;
            const bf16_t* qp = PROJ + (size_t)(b * SEQ + qrow) * NPROJ + PC_Q + h * 64 + fq * 8;
            const bf16x8 qf0 = ldxb<bf16x8>(PROJ, (unsigned)((size_t)(qp - PROJ) * 2)), qf1 = ldxb<bf16x8>(PROJ, (unsigned)((size_t)(qp - PROJ) * 2 + 64));
            const float cfq = cf2[qrow];
            float mrun = -INFINITY, lrun = 0.f; f32x4 o[4];
#pragma unroll
            for (int j = 0; j < 4; ++j) o[j] = (f32x4){0.f, 0.f, 0.f, 0.f};
            const int key = tid >> 3, dch = tid & 7;
            const bf16_t* VT = (const bf16_t*)(a->ws + WS_VT);
            const unsigned kpo = (unsigned)(((size_t)(b * SEQ + key) * NPROJ + PC_K + h * 64 + dch * 8) * 2);
            const unsigned vpo = (unsigned)((((size_t)bh * 64 + key) * SEQ + dch * 8) * 2);
            u32x4 kA = ldxb<u32x4>(PROJ, kpo), vA = ldxb<u32x4>(VT, vpo);
            u32x4 kB = ldxb<u32x4>(PROJ, kpo + 64u * NPROJ * 2u), vB = ldxb<u32x4>(VT, vpo + 128u);
#define ATT_STEP(KT, KR, VR, BUFI) do { const int kt = (KT); bf16_t* sKb = sK + (BUFI) * 4608; bf16_t* sVb = sV + (BUFI) * 4608; \
                *(u32x4*)(sKb + key * 72 + dch * 8) = KR; *(u32x4*)(sVb + key * 72 + dch * 8) = VR; \
                __syncthreads(); \
                if (kt + 2 < nt) { KR = ldxb<u32x4>(PROJ, kpo + (unsigned)(kt + 2) * 64u * NPROJ * 2u); VR = ldxb<u32x4>(VT, vpo + (unsigned)(kt + 2) * 128u); } \
                ATT_COMPUTE } while (0)
#define ATT_COMPUTE attn_tile(sKb, sVb, cf2, kt, qw0, qrow, fr, fq, cfq, qf0, qf1, mrun, lrun, o);
            for (int kt2 = 0; kt2 < nt; kt2 += 2) { ATT_STEP(kt2, kA, vA, 0); ATT_STEP(kt2 + 1, kB, vB, 1); }
#undef ATT_STEP
#undef ATT_COMPUTE
            float lt = lrun; lt += __shfl_xor(lt, 16); lt += __shfl_xor(lt, 32);
            const float inv = ZF / lt;
            bf16_t* op = YCAT + (size_t)(b * SEQ + qrow) * DM + 512 + h * 64 + 4 * fq;
#pragma unroll
            for (int dj = 0; dj < 4; ++dj) { u32x2 w; w.x = pk2t<4>(o[dj][0] * inv, o[dj][1] * inv); w.y = pk2t<4>(o[dj][2] * inv, o[dj][3] * inv); *(u32x2*)(op + 16 * dj) = w; }
            __syncthreads();
        }
    }
}

__device__ __forceinline__ void phase_mc(CArgsP a, int l, unsigned char* lds, int tid, int wave, int lane) {
    const bf16_t* PROJ = (const bf16_t*)(a->ws + WS_BIG); bf16_t* YCAT = (bf16_t*)(a->ws + WS_YCAT); const bf16_t* ST = (const bf16_t*)(a->ws + WS_ST);
    const float* DTF = (const float*)(a->ws + WS_DTF);
    const float* cw = a->in[10] + (size_t)l * 4 * 1024; const float* cb = a->in[11] + l * 1024; const float* dtb = a->in[12] + l * 8; const float* alog = a->in[13] + l * 8;
    const float* dsk = a->in[14] + l * 8; const float* ng = a->in[15] + l * 512;
    const int fr = lane & 15, fq = lane >> 4;
    bf16_t* sC = (bf16_t*)lds;
    bf16_t* sB = (bf16_t*)(lds + 17408);
    bf16_t* sXT = (bf16_t*)(lds + 34816);
    float* sCB = (float*)(lds + 71680);
    float* sDt = (float*)(lds + 89088);
    float* sAcs = sDt + 256;
    float* sRms = sAcs + 256;
    for (int it = blockIdx.x; it < 512; it += gridDim.x) {
        const int b = it >> 7, c = (it >> 1) & 63, g = it & 1, t0 = c * 64, R0 = b * SEQ + t0;
        ssd_dt_acs(DTF, dtb, alog, R0, g, wave, lane, sDt, sAcs);
#pragma unroll 2
        for (int o = tid; o < 4096; o += NT) {
            float v[8];
            if (o < 2048) { const int isC = o >> 10, o1 = o & 1023, ll = o1 >> 4, n = (o1 & 15) * 8; conv8(PROJ, b, t0 + ll, (isC ? 768 : 512) + g * 128 + n, cw, cb, v);
                u32x4 w; w.x = pk2t<5>(v[0], v[1]); w.y = pk2t<5>(v[2], v[3]); w.z = pk2t<5>(v[4], v[5]); w.w = pk2t<5>(v[6], v[7]);
                *(u32x4*)((isC ? sC : sB) + ll * 136 + n) = w; }
            else { const int o2 = o - 2048, ll = o2 >> 5, ch = (o2 & 31) * 8; conv8(PROJ, b, t0 + ll, g * 256 + ch, cw, cb, v);
#pragma unroll
                for (int j = 0; j < 8; ++j) sXT[(ch + j) * 72 + ll] = f2bft<5>(v[j]); }
        }
        __syncthreads();
        { const int li = wave >> 1;
#pragma unroll
          for (int q = 0; q < 2; ++q) { const int sj = 2 * (wave & 1) + q; f32x4 acc = (f32x4){0.f, 0.f, 0.f, 0.f};
#pragma unroll
              for (int kk = 0; kk < 4; ++kk) { const bf16x8 af = *(const bf16x8*)(sC + (16 * li + fr) * 136 + 32 * kk + 8 * fq), bfr = *(const bf16x8*)(sB + (16 * sj + fr) * 136 + 32 * kk + 8 * fq);
                  acc = __builtin_amdgcn_mfma_f32_16x16x32_bf16(af, bfr, acc, 0, 0, 0); }
#pragma unroll
              for (int r = 0; r < 4; ++r) sCB[(16 * li + 4 * fq + r) * 68 + 16 * sj + fr] = acc[r]; } }
        __syncthreads();
        { const int e = wave >> 1, lh = wave & 1, h = g * 4 + e;
          f32x4 yd[2][4], yo[2][4];
#pragma unroll
          for (int mi = 0; mi < 2; ++mi)
#pragma unroll
              for (int pj = 0; pj < 4; ++pj) { yd[mi][pj] = (f32x4){0.f, 0.f, 0.f, 0.f}; yo[mi][pj] = yd[mi][pj]; }
#ifdef NOSKIP
          for (int kk = 0; kk < 2; ++kk) {
#else
          for (int kk = 0; kk <= lh; ++kk) {
#endif
              bf16x8 bx[4];
#pragma unroll
              for (int pj = 0; pj < 4; ++pj) bx[pj] = *(const bf16x8*)(sXT + (e * 64 + 16 * pj + fr) * 72 + 32 * kk + 8 * fq);
#pragma unroll
              for (int mi = 0; mi < 2; ++mi) { const int lrow = 32 * lh + 16 * mi + fr, s0 = 32 * kk + 8 * fq; const float al = sAcs[e * 64 + lrow];
                  const f32x4 c0 = *(const f32x4*)(sCB + lrow * 68 + s0), c1 = *(const f32x4*)(sCB + lrow * 68 + s0 + 4);
                  const f32x4 as0 = *(const f32x4*)(sAcs + e * 64 + s0), as1 = *(const f32x4*)(sAcs + e * 64 + s0 + 4), d0 = *(const f32x4*)(sDt + e * 64 + s0), d1 = *(const f32x4*)(sDt + e * 64 + s0 + 4);
                  float gv[8];
#pragma unroll
                  for (int j = 0; j < 4; ++j) { gv[j] = (s0 + j <= lrow) ? c0[j] * d0[j] * __expf(al - as0[j]) : 0.f; gv[4 + j] = (s0 + 4 + j <= lrow) ? c1[j] * d1[j] * __expf(al - as1[j]) : 0.f; }
                  u32x4 gw; gw.x = pk2t<5>(gv[0], gv[1]); gw.y = pk2t<5>(gv[2], gv[3]); gw.z = pk2t<5>(gv[4], gv[5]); gw.w = pk2t<5>(gv[6], gv[7]);
                  const bf16x8 ga = __builtin_bit_cast(bf16x8, gw);
#pragma unroll
                  for (int pj = 0; pj < 4; ++pj) yd[mi][pj] = __builtin_amdgcn_mfma_f32_16x16x32_bf16(ga, bx[pj], yd[mi][pj], 0, 0, 0); }
          }
          const bf16_t* sp = ST + (size_t)((b * 64 + c) * 8 + h) * 8192;
#pragma unroll
          for (int kk = 0; kk < 4; ++kk) {
              bf16x8 bs[4], ca[2];
#pragma unroll
              for (int pj = 0; pj < 4; ++pj) bs[pj] = ldxb<bf16x8>(ST, (unsigned)(((size_t)(sp - ST) + (16 * pj + fr) * 128 + 32 * kk + 8 * fq) * 2));
#pragma unroll
              for (int mi = 0; mi < 2; ++mi) ca[mi] = *(const bf16x8*)(sC + (32 * lh + 16 * mi + fr) * 136 + 32 * kk + 8 * fq);
#pragma unroll
              for (int mi = 0; mi < 2; ++mi)
#pragma unroll
                  for (int pj = 0; pj < 4; ++pj) yo[mi][pj] = __builtin_amdgcn_mfma_f32_16x16x32_bf16(ca[mi], bs[pj], yo[mi][pj], 0, 0, 0);
          }
          const float dh = dsk[h];
          float ss[2][4];
#pragma unroll
          for (int mi = 0; mi < 2; ++mi) { const int lb = 32 * lh + 16 * mi + 4 * fq; const f32x4 ea = *(const f32x4*)(sAcs + e * 64 + lb);
#pragma unroll
              for (int r = 0; r < 4; ++r) ss[mi][r] = 0.f;
#pragma unroll
              for (int pj = 0; pj < 4; ++pj) { const int p = 16 * pj + fr; const u32x2 xw = *(const u32x2*)(sXT + (e * 64 + p) * 72 + lb);
                  const float xs[4] = {bf_lo(xw.x), bf_hi(xw.x), bf_lo(xw.y), bf_hi(xw.y)};
#pragma unroll
                  for (int r = 0; r < 4; ++r) { const float z = bf2f(ldx(PROJ + (size_t)(R0 + lb + r) * NPROJ + PC_Z + g * 256 + e * 64 + p));
                      float y = yd[mi][pj][r] + __expf(ea[r]) * yo[mi][pj][r] + dh * xs[r]; y *= siluf(z); yd[mi][pj][r] = y; ss[mi][r] += y * y; } } }
#pragma unroll
          for (int mi = 0; mi < 2; ++mi)
#pragma unroll
              for (int r = 0; r < 4; ++r) { float s = ss[mi][r]; s += __shfl_xor(s, 1); s += __shfl_xor(s, 2); s += __shfl_xor(s, 4); s += __shfl_xor(s, 8);
                  if (fr == 0) sRms[(32 * lh + 16 * mi + 4 * fq + r) * 4 + e] = s; }
          __syncthreads();
#pragma unroll
          for (int mi = 0; mi < 2; ++mi) { const int lb = 32 * lh + 16 * mi + 4 * fq;
#pragma unroll
              for (int r = 0; r < 4; ++r) { const f32x4 q4 = *(const f32x4*)(sRms + (lb + r) * 4); const float rstd = 1.f / sqrtf(((q4.x + q4.y) + (q4.z + q4.w)) * (1.f / 256.f) + RMS_EPS);
#pragma unroll
                  for (int pj = 0; pj < 4; ++pj) { const int ch = g * 256 + e * 64 + 16 * pj + fr; YCAT[(size_t)(R0 + lb + r) * DM + ch] = f2bft<5>(ZS * yd[mi][pj][r] * rstd * ng[ch]); } } }
        }
        __syncthreads();
    }
}
}


#define LAS __attribute__((address_space(3)))
#ifndef XB_ACQ_SCOPE
#define XB_ACQ_SCOPE ""
#endif
#define XB_TMO      128
#define XB_XCNT(j)  (256  + 64 * (j))
#define XB_XSUB(j)  (1280 + 64 * (j))
#define XB_XGEN(j)  (2304 + 64 * (j))
#define XB_TOP      3328
#define XB_TOPGEN   3392
#define XCD_BAR_WORDS 3456
#define XB_SPIN_CAP (1u << 18)

__device__ __forceinline__ unsigned xb_ld(unsigned* p)              { return __hip_atomic_load(p, __ATOMIC_RELAXED, __HIP_MEMORY_SCOPE_AGENT); }
__device__ __forceinline__ unsigned xb_add(unsigned* p, unsigned v) { return __hip_atomic_fetch_add(p, v, __ATOMIC_RELAXED, __HIP_MEMORY_SCOPE_AGENT); }
__device__ __forceinline__ unsigned xb_xcc_id() { return (unsigned)__builtin_amdgcn_s_getreg((3 << 11) | 20) & 0xFu; }
#define XB_SPIN(cond, bar) do { unsigned _sp = 0; while (cond) { __builtin_amdgcn_s_sleep(1); \
    if ((++_sp & 255u) == 0u) { if (xb_ld(&(bar)[XB_TMO])) break; if (_sp > XB_SPIN_CAP) { atomicAdd(&(bar)[XB_TMO], 1u); break; } } } } while (0)

struct XcdBarrier {
    unsigned* bar; unsigned x;
    volatile LAS unsigned* st;
};

__device__ __forceinline__ XcdBarrier xcd_barrier_post(unsigned* bar, volatile LAS unsigned* st) {
    XcdBarrier b; b.bar = bar; b.x = xb_xcc_id(); b.st = st;
    if (threadIdx.x == 0) (void)xb_add(&bar[XB_XCNT(b.x)], 1u);
    return b;
}
__device__ __forceinline__ void xcd_barrier_complete(unsigned* bar, unsigned x, unsigned& nloc, unsigned& nx) {
    const unsigned G = gridDim.x * gridDim.y * gridDim.z;
    unsigned sum, cnt, mine, sp = 0u;
    for (;;) {
        sum = 0u; cnt = 0u; mine = 0u;
#pragma unroll
        for (unsigned j = 0; j < 16; ++j) { const unsigned c = xb_ld(&bar[XB_XCNT(j)]); sum += c; cnt += (c > 0u) ? 1u : 0u; mine = (j == x) ? c : mine; }
        if (sum == G) break;
        __builtin_amdgcn_s_sleep(1);
        if ((++sp & 255u) == 0u) { if (xb_ld(&bar[XB_TMO])) break; if (sp > XB_SPIN_CAP) { atomicAdd(&bar[XB_TMO], 1u); break; } }
    }
    nloc = mine > 0u ? mine : 1u; nx = cnt > 0u ? cnt : 1u;
}

__device__ __forceinline__ void xcd_barrier(const XcdBarrier& b) {
    asm volatile("s_waitcnt vmcnt(0)" ::: "memory");
    __syncthreads();
    if (threadIdx.x == 0) {
        unsigned* bar = b.bar;
        __builtin_amdgcn_s_waitcnt(0);
        unsigned nloc = b.st[0], nx = b.st[1];
        if (nloc == 0u) { xcd_barrier_complete(bar, b.x, nloc, nx); b.st[0] = nloc; b.st[1] = nx; }
        const unsigned old = xb_add(&bar[XB_XSUB(b.x)], 1u);
        const unsigned gen = old / nloc;
        if (old + 1u == (gen + 1u) * nloc) {
            __builtin_amdgcn_fence(__ATOMIC_RELEASE, "agent");
            asm volatile("s_waitcnt vmcnt(0)" ::: "memory");
            const unsigned og = xb_add(&bar[XB_TOP], 1u);
            const unsigned tg = og / nx;
            if (og + 1u == (tg + 1u) * nx) xb_add(&bar[XB_TOPGEN], 1u);
            else XB_SPIN(xb_ld(&bar[XB_TOPGEN]) == tg, bar);
            __builtin_amdgcn_fence(__ATOMIC_ACQUIRE, "");
            asm volatile("s_waitcnt vmcnt(0)" ::: "memory");
            xb_add(&bar[XB_XGEN(b.x)], 1u);
            asm volatile("s_waitcnt vmcnt(0)" ::: "memory");
        } else {
            XB_SPIN(xb_ld(&bar[XB_XGEN(b.x)]) == gen, bar);
            __builtin_amdgcn_fence(__ATOMIC_ACQUIRE, "agent");
            asm volatile("s_waitcnt vmcnt(0)" ::: "memory");
        }
    }
    __syncthreads();
}


#ifndef MK_STOP_AFTER
#define MK_STOP_AFTER 1000
#endif
__global__ void __launch_bounds__(512, 2) mega_fwd(mk::Args a_unused) {
    using namespace mk;
    extern __shared__ __attribute__((aligned(16))) unsigned char lds[];
    cg::grid_group grid = cg::this_grid();
    volatile LAS unsigned* bst = (volatile LAS unsigned*)((LAS unsigned char*)lds + 131072 + 256);
#ifdef LDS_POISON
    for (int i = threadIdx.x; i < mk::LDS_BYTES / 4; i += 512) ((volatile unsigned*)lds)[i] = 0xFFFFFFFFu;
    __syncthreads();
#endif
    if (threadIdx.x < 8) bst[threadIdx.x] = 0u;
    __syncthreads();
    { CArgsP a0 = get_args(); (void)xcd_barrier_post((unsigned*)(a0->ws + WS_BAR), bst); }
    grid.sync();
#define GSYNC() do { CArgsP a_ = get_args(); XcdBarrier b_; b_.bar = (unsigned*)(a_->ws + WS_BAR); b_.x = xb_xcc_id(); b_.st = bst; xcd_barrier(b_); } while (0)
#pragma unroll 1
    for (int ph_ = 0; ph_ < (MK_STOP_AFTER < 25 ? MK_STOP_AFTER + 1 : 26); ++ph_) {
        int ph = ph_; asm volatile("" : "+s"(ph));
#ifdef TIME_CAT
        unsigned long long tc0_ = __builtin_amdgcn_s_memrealtime();
#endif
        int tid = threadIdx.x; asm volatile("" : "+v"(tid)); const int lane = tid & 63, wave = __builtin_amdgcn_readfirstlane(tid >> 6);
        CArgsP a = get_args();
        unsigned char* ws = a->ws;
        const int p = ph - 2, l = p < 0 ? 0 : p / 12, s = p < 0 ? -1 : p % 12;
        if (s == 0 || s == 1 || s == 3 || s == 7 || s == 9 || s == 10) {
#ifndef NO_G
            unsigned char* wl = ws + WS_W + (size_t)l * W_L;
            const size_t aoff = (s == 0 || s == 3 || s == 9) ? WS_HB : (s == 7 ? WS_YCAT : WS_BIG);
            const size_t boff = s == 0 ? WO_1IN : s == 1 ? WO_1OUT : s == 3 ? WO_MI : s == 7 ? WO_MO : s == 9 ? WO_2IN : WO_2OUT;
            const int N = (s == 0 || s == 9) ? NFF : (s == 3 ? NPROJ : DM), K = (s == 1 || s == 10) ? DFF : DM;
            pg8::Gemm g_{(const bf16_t*)(ws + aoff), (const bf16_t*)(wl + boff), MROWS, N, K}; pg8::StaticOrder S_; S_.init(MROWS, N, (int)gridDim.x, (int)blockIdx.x);
            EpiMulti E{s | (l << 8)};
            pg8::gemm_phase<EpiMulti, pg8::StaticOrder, true, true>((PG8_LAS unsigned char*)lds, g_, S_, E);
#ifdef DUP_G0
            if (s == 0 || s == 9) { __syncthreads(); pg8::gemm_phase<EpiMulti, pg8::StaticOrder, true, true>((PG8_LAS unsigned char*)lds, g_, S_, E); }
#endif
#endif
        } else if (ph == 0) {
#ifndef NO_P0
            phase_p0(a, lds, tid, wave, lane);
#ifdef DUP_P0
            __syncthreads(); phase_p0(a, lds, tid, wave, lane);
#endif
#endif
        } else if (ph == 1 || s == 8 || s == 11) {
            const float* modl = (const float*)(ws + WS_MOD) + (size_t)l * 4 * NMOD;
            const int li = s == 8 ? 1 : 2, sub = s == 8 ? 2 : 0; const bool wh = !(s == 11 && l == 1);
            const float* src = ph == 1 ? a->in[0] : (const float*)a->out;
            const float* gm = ph == 1 ? a->in[2] : a->in[20] + (l * 3 + li) * DM; const float* bt = ph == 1 ? a->in[3] : a->in[21] + (l * 3 + li) * DM;
            const float* md = (s == 11 && l == 0) ? modl + 4 * NMOD : modl;
            phase_ln<false>(src, a->out, (bf16_t*)(ws + WS_HB), gm, bt, md, sub, wh, nullptr, nullptr, lds, tid, wave, lane);
#ifdef DUP_LN1
            if (ph == 1) { phase_ln<false>(src, a->out, (bf16_t*)(ws + WS_HB), gm, bt, md, sub, wh, nullptr, nullptr, lds, tid, wave, lane); phase_ln<false>(src, a->out, (bf16_t*)(ws + WS_HB), gm, bt, md, sub, wh, nullptr, nullptr, lds, tid, wave, lane); phase_ln<false>(src, a->out, (bf16_t*)(ws + WS_HB), gm, bt, md, sub, wh, nullptr, nullptr, lds, tid, wave, lane); }
#endif
        } else if (s == 2) {
            const float* modl = (const float*)(ws + WS_MOD) + (size_t)l * 4 * NMOD;
            phase_ln<true>(a->out, a->out, (bf16_t*)(ws + WS_HB), a->in[20] + l * 3 * DM, a->in[21] + l * 3 * DM, modl, 1, true, (const float*)(ws + WS_WMISC) + l * 12288, (float*)(ws + WS_DTF), lds, tid, wave, lane);
        } else if (s == 4) {
            phase_ma(a, l, lds, tid, wave, lane);
#if defined(DUP_MIX) && (DUP_MIX & 1)
            __syncthreads(); phase_ma(a, l, lds, tid, wave, lane);
#endif
        } else if (s == 5) {
            phase_mb(a, l, lds, tid, wave, lane, true);
#if defined(DUP_MIX) && (DUP_MIX & 2)
            __syncthreads(); phase_mb(a, l, lds, tid, wave, lane, false);
#endif
        } else {
            phase_mc(a, l, lds, tid, wave, lane);
#if defined(DUP_MIX) && (DUP_MIX & 4)
            __syncthreads(); phase_mc(a, l, lds, tid, wave, lane);
#endif
        }
        if (ph_ < 25) GSYNC();
#ifdef DUP_BAR
        if (ph_ < 25) { GSYNC(); GSYNC(); }
#endif
#ifdef TIME_CAT
        { const int p2_ = ph_ - 2, s2_ = p2_ < 0 ? -1 : p2_ % 12;
          const int cat_ = (s2_ == 0 || s2_ == 1 || s2_ == 3 || s2_ == 7 || s2_ == 9 || s2_ == 10) ? 1 : (ph_ == 0 ? 6 : ((ph_ == 1 || s2_ == 2 || s2_ == 8 || s2_ == 11) ? 2 : (s2_ == 4 ? 3 : (s2_ == 5 ? 4 : 5))));
          if (cat_ == TIME_CAT && threadIdx.x == 0) { volatile LAS unsigned* tacc = bst + 4; tacc[0] = tacc[0] + (unsigned)(__builtin_amdgcn_s_memrealtime() - tc0_); } }
#endif
    }
#ifdef TIME_CAT
    if (blockIdx.x == 0 && threadIdx.x == 0) { CArgsP a9 = get_args(); a9->out[0] = (float)bst[4] * 0.01f; }
#endif
}

extern "C" void kernel_launch(void* const* d_in, const int* in_sizes, int n_in, void* d_out, int out_size, void* d_ws, size_t ws_size, hipStream_t stream) {
    static int grid = 0;
    if (grid == 0) {
        if (n_in != 22 || out_size != mk::MROWS * mk::DM || ws_size < mk::WS_END) { fprintf(stderr, "kernel_launch: unexpected problem (n_in %d out %d ws %zu)\n", n_in, out_size, ws_size); grid = -1; return; }
        int dev = 0, cus = 0, per_cu = 0;
        (void)hipGetDevice(&dev); (void)hipDeviceGetAttribute(&cus, hipDeviceAttributeMultiprocessorCount, dev);
        (void)hipFuncSetAttribute((const void*)mega_fwd, hipFuncAttributeMaxDynamicSharedMemorySize, mk::LDS_BYTES);
        (void)hipOccupancyMaxActiveBlocksPerMultiprocessor(&per_cu, (const void*)mega_fwd, 512, mk::LDS_BYTES);
        (void)hipGetLastError();
        if (per_cu < 1) { fprintf(stderr, "kernel_launch: occupancy query says %d\n", per_cu); grid = -1; return; }
        grid = cus;
    }
    if (grid < 0) return;
#ifdef NAN_POISON
    (void)hipMemsetAsync(d_ws, 0xFF, mk::WS_END, stream); (void)hipMemsetAsync(d_out, 0xFF, (size_t)out_size * 4, stream);
#endif
    if (hipMemsetAsync((char*)d_ws + mk::WS_BAR, 0, 16384, stream) != hipSuccess) { fprintf(stderr, "kernel_launch: memset failed\n"); return; }
    mk::Args a{};
    for (int i = 0; i < 22; ++i) a.in[i] = (const float*)d_in[i];
    a.out = (float*)d_out; a.ws = (unsigned char*)d_ws;
    void* args[] = {&a};
    hipError_t e = hipLaunchCooperativeKernel((const void*)mega_fwd, dim3(grid), dim3(512), args, mk::LDS_BYTES, stream);
    if (e != hipSuccess) fprintf(stderr, "cooperative launch failed: %s (grid %d)\n", hipGetErrorString(e), grid);
}
```

```cpp
#include <hip/hip_runtime.h>
#include <hip/hip_cooperative_groups.h>
#include <cstdio>
#include <cstdint>
namespace cg = cooperative_groups;
#ifndef PG8_A_AUX
#define PG8_A_AUX 16
#endif
namespace pg8 {
#define PG8_LAS __attribute__((address_space(3)))
typedef unsigned short bf16_t;
typedef short bf16x8 __attribute__((ext_vector_type(8)));
typedef float f32x4 __attribute__((ext_vector_type(4)));
typedef unsigned u32x4 __attribute__((ext_vector_type(4)));
constexpr int BM = 256, BK = 64, HALF = 128, HTB = HALF * BK * 2  , STAGE_BYTES = 8 * HTB, NXCD = 8, WGM = 8;

__host__ __device__ __forceinline__ int lds_byte(int r, int c) { const int st = (r >> 4) * 2 + (c >> 5), rr = r & 15, cc = c & 31, ob = rr * 64 + cc * 2; return st * 1024 + (ob ^ (((ob >> 9) & 1) << 5)); }
__host__ __device__ __forceinline__ void stage_rc(int b, int& R, int& C) { const int st = b / 1024, sb = b % 1024, swz = sb ^ (((sb >> 9) & 1) << 5); R = (st >> 1) * 16 + swz / 64; C = (st & 1) * 32 + (swz % 64) / 2; }
__host__ __device__ __forceinline__ int perm32(int rho) { const int n = rho >> 4, i = rho & 15; return 8 * (i >> 2) + 4 * n + (i & 3); }

struct Unit { int pm, pn; };
struct Gemm { const bf16_t* A; const bf16_t* Bt; int M, N, K; };

struct StaticOrder {
    int nM, nN, nwg, G, c;
    __host__ __device__ void init(int M, int N, int G_, int c_) { nM = M / BM; nN = N / BM; nwg = nM * nN; G = G_; c = c_; }
    __host__ __device__ bool next(int i, Unit& u) const {
        const long L = (long)i * G + c; if (L >= nwg) return false;
        int wgid = (int)L; { const int q = nwg / NXCD, r = nwg % NXCD, xcd = wgid % NXCD, off = wgid / NXCD; wgid = (xcd < r ? xcd * (q + 1) : r * (q + 1) + (xcd - r) * q) + off; }
        const int nig = WGM * nN, gid = wgid / nig, fm = gid * WGM, gsz = (nM - fm) < WGM ? (nM - fm) : WGM;
        u.pm = fm + ((wgid % nig) % gsz); u.pn = (wgid % nig) / gsz; return true;
    }
    __device__ __forceinline__ void a_ready(const Unit&) const {}
    __device__ __forceinline__ void done(const Unit&) const {}
};

__device__ __forceinline__ unsigned cvt_pk_bf16(float lo, float hi) { unsigned r; asm volatile("v_cvt_pk_bf16_f32 %0, %1, %2" : "=v"(r) : "v"(lo), "v"(hi)); return r; }
typedef float f32x2 __attribute__((ext_vector_type(2)));
__device__ __forceinline__ f32x2 gelu_pk(f32x2 v) {
    const f32x2 av = __builtin_elementwise_abs(v), d = av * 0.2316418882f + 1.0f;
    f32x2 t; t.x = __builtin_amdgcn_rcpf(d.x); t.y = __builtin_amdgcn_rcpf(d.y);
    f32x2 q = t * 0.5307027145f + (-0.7265760135f); q = q * t + 0.7107068705f; q = q * t + (-0.142248368f); q = q * t + 0.127414796f; q = q * t;
    const f32x2 s = (v * v) * (-0.72134752044f);
    f32x2 e; e.x = __builtin_amdgcn_exp2f(s.x); e.y = __builtin_amdgcn_exp2f(s.y);
    const f32x2 m = v * (q * e), r = v - m;
    f32x2 o; o.x = v.x < 0.f ? m.x : r.x; o.y = v.y < 0.f ? m.y : r.y; return o;
}

template <int ACT  > struct EpiBf16 {
    static constexpr bool PERM = true, AFTER_DRAIN = false; static_assert(ACT == 0 || ACT == 1, "EpiBf16: ACT is 0 (none) or 1 (gelu_pk)");
    bf16_t* O; int ldc; const float* bias; int split_cols; size_t split_stride; float scale0;
    __device__ __forceinline__ void operator()(const f32x4 (&acc)[2][2][4][2], const Unit& u, int wr, int wc, int fr, int fq) const {
        const int row0 = u.pm * BM + wr * 64 + fr; int colt = u.pn * BM; bf16_t* base = O;
        float sc = 1.f; if (split_cols) { const int t = colt / split_cols; base += (size_t)t * split_stride; colt -= t * split_cols; if (t == 0) sc = scale0; }
        const int col0 = colt + wc * 32 + 8 * fq, bcol0 = u.pn * BM + wc * 32 + 8 * fq;
        f32x4 bv[2][2];
#pragma unroll
        for (int bj = 0; bj < 2; ++bj)
#pragma unroll
            for (int n = 0; n < 2; ++n) bv[bj][n] = bias ? *(const f32x4*)(bias + bcol0 + bj * HALF + 4 * n) : (f32x4){0.f, 0.f, 0.f, 0.f};
#pragma unroll
        for (int ai = 0; ai < 2; ++ai)
#pragma unroll
            for (int m = 0; m < 4; ++m) { bf16_t* rowp = base + (size_t)(row0 + ai * HALF + m * 16) * ldc + col0;
#pragma unroll
                for (int bj = 0; bj < 2; ++bj) { f32x4 v0 = acc[ai][bj][m][0] + bv[bj][0], v1 = acc[ai][bj][m][1] + bv[bj][1];
                    if (ACT == 1) { f32x2 a = gelu_pk((f32x2){v0[0], v0[1]}), b = gelu_pk((f32x2){v0[2], v0[3]}), c = gelu_pk((f32x2){v1[0], v1[1]}), d = gelu_pk((f32x2){v1[2], v1[3]});
                        v0 = (f32x4){a.x, a.y, b.x, b.y}; v1 = (f32x4){c.x, c.y, d.x, d.y}; }
                    v0 = v0 * sc; v1 = v1 * sc; u32x4 w; w.x = cvt_pk_bf16(v0[0], v0[1]); w.y = cvt_pk_bf16(v0[2], v0[3]); w.z = cvt_pk_bf16(v1[0], v1[1]); w.w = cvt_pk_bf16(v1[2], v1[3]);
                    *(u32x4*)(rowp + bj * HALF) = w; } }
    }
};

struct PanelStats {
    unsigned* xbuf;
    unsigned* cnt;
    unsigned* tmo;
    int ntn; float eps;
    unsigned code;
    __device__ __forceinline__ bool run(const f32x4 (&v)[2][2][4][2], const Unit& u, int wr, int wc, int fr, int fq, PG8_LAS unsigned char* lds, int wid, int lane) const {
        typedef float f32x2v __attribute__((ext_vector_type(2)));
        PG8_LAS f32x2v* P = (PG8_LAS f32x2v*)lds;
        PG8_LAS f32x2v* S = (PG8_LAS f32x2v*)(lds + 8192);
        PG8_LAS unsigned* flag = (PG8_LAS unsigned*)(lds + 8192 + 2048);
#pragma unroll
        for (int ai = 0; ai < 2; ++ai)
#pragma unroll
            for (int m = 0; m < 4; ++m) {
                float s = 0.f;
#pragma unroll
                for (int bj = 0; bj < 2; ++bj)
#pragma unroll
                    for (int n = 0; n < 2; ++n) { const f32x4 x = v[ai][bj][m][n]; s += (x[0] + x[1]) + (x[2] + x[3]); }
                s += __shfl_xor(s, 16); s += __shfl_xor(s, 32);
                const float mw = s * (1.0f / 64.0f); float q = 0.f;
#pragma unroll
                for (int bj = 0; bj < 2; ++bj)
#pragma unroll
                    for (int n = 0; n < 2; ++n) { const f32x4 d = v[ai][bj][m][n] - mw; q += (d[0] * d[0] + d[1] * d[1]) + (d[2] * d[2] + d[3] * d[3]); }
                q += __shfl_xor(q, 16); q += __shfl_xor(q, 32);
                if (fq == 0) P[(ai * HALF + wr * 64 + m * 16 + fr) * 4 + wc] = (f32x2v){mw, q};
            }
        asm volatile("s_waitcnt lgkmcnt(0)" ::: "memory"); __builtin_amdgcn_s_barrier(); asm volatile("" ::: "memory");
#if defined(BROKEN_EXCHANGE_NO_WAIT)
#warning BROKEN CONTROL BUILD: the row-statistics exchange does not wait; results are wrong by design
        if (blockIdx.x >= 64) { const long long t0_ = clock64(); while (clock64() - t0_ < 60000) __builtin_amdgcn_s_sleep(8); }
#endif
        const int row = wid * 32 + (lane & 31);
        if (lane < 32) {
            const f32x2v a = P[row * 4 + 0], b = P[row * 4 + 1], c = P[row * 4 + 2], d = P[row * 4 + 3];
            const float mt = (a.x + b.x + c.x + d.x) * 0.25f;
            const float da = a.x - mt, db = b.x - mt, dc = c.x - mt, dd = d.x - mt;
            const float m2 = (a.y + b.y) + (c.y + d.y) + 64.0f * ((da * da + db * db) + (dc * dc + dd * dd));
            unsigned long long* slot = (unsigned long long*)xbuf + ((size_t)(u.pm * BM + row) * 4 + u.pn);
            __hip_atomic_store(slot, ((unsigned long long)__float_as_uint(m2) << 32) | __float_as_uint(mt), __ATOMIC_RELAXED, __HIP_MEMORY_SCOPE_AGENT);
        }
        asm volatile("s_waitcnt vmcnt(0)" ::: "memory");
        if (lane == 0) __hip_atomic_fetch_add(cnt + 64 * u.pm, 1u, __ATOMIC_RELAXED, __HIP_MEMORY_SCOPE_AGENT);
        if (wid == 0) {
            bool dead = false; const unsigned long long t0 = __builtin_amdgcn_s_memrealtime(); const unsigned want = 8u * (unsigned)ntn;
            for (;;) {
#if defined(BROKEN_EXCHANGE_NO_WAIT)
                break;
#endif
                if ((unsigned)__builtin_amdgcn_readfirstlane(__hip_atomic_load(cnt + 64 * u.pm, __ATOMIC_RELAXED, __HIP_MEMORY_SCOPE_AGENT)) >= want) break;
                if (__builtin_amdgcn_s_memrealtime() - t0 > 2000000ull) {
                    if (lane == 0) { unsigned expect = 0u; __hip_atomic_compare_exchange_strong(tmo + 1, &expect, code | (unsigned)(u.pm & 0xff), __ATOMIC_RELAXED, __ATOMIC_RELAXED, __HIP_MEMORY_SCOPE_AGENT);
                                     __hip_atomic_store(tmo, 1u, __ATOMIC_RELAXED, __HIP_MEMORY_SCOPE_AGENT); }
                    dead = true; break; }
                __builtin_amdgcn_s_sleep(2);
            }
            __builtin_amdgcn_fence(__ATOMIC_ACQUIRE, "agent");
            if (lane == 0) flag[0] = dead ? 1u : 0u;
        }
        asm volatile("s_waitcnt vmcnt(0) lgkmcnt(0)" ::: "memory"); __builtin_amdgcn_s_barrier(); asm volatile("" ::: "memory");
        const bool bad = flag[0] != 0u;
        if (lane < 32) {
            const unsigned long long* slot = (const unsigned long long*)xbuf + (size_t)(u.pm * BM + row) * 4; float mt[4], m2[4]; float ms = 0.f;
#pragma unroll
            for (int t = 0; t < 4; ++t) { if (t < ntn) { const unsigned long long w = __hip_atomic_load(slot + t, __ATOMIC_RELAXED, __HIP_MEMORY_SCOPE_AGENT); mt[t] = __uint_as_float((unsigned)w); m2[t] = __uint_as_float((unsigned)(w >> 32)); } else { mt[t] = 0.f; m2[t] = 0.f; } ms += mt[t]; }
            const float mean = ms / (float)ntn; float q = 0.f;
#pragma unroll
            for (int t = 0; t < 4; ++t) if (t < ntn) { const float dm = mt[t] - mean; q += m2[t] + 256.0f * dm * dm; }
            S[row] = (f32x2v){mean, 1.0f / sqrtf(q / (256.0f * (float)ntn) + eps)};
        }
        asm volatile("s_waitcnt lgkmcnt(0)" ::: "memory"); __builtin_amdgcn_s_barrier(); asm volatile("" ::: "memory");
        return bad;
    }
};
struct EpiLnRes {
    static constexpr bool PERM = false, AFTER_DRAIN = true;
    const float* base; float* out; int ldc; const float* bias; PanelStats st; unsigned poison;
    __device__ __forceinline__ void fused(f32x4 (&acc)[2][2][4][2], const Unit& u, int wr, int wc, int fr, int fq, PG8_LAS unsigned char* lds, int wid, int lane) const {
        typedef float f32x2v __attribute__((ext_vector_type(2)));
        const PG8_LAS f32x2v* S = (const PG8_LAS f32x2v*)(lds + 8192);
        const int col0 = u.pn * BM + wc * 32 + 4 * fq;
#pragma unroll
        for (int bj = 0; bj < 2; ++bj)
#pragma unroll
            for (int n = 0; n < 2; ++n) { const f32x4 bv = bias ? *(const f32x4*)(bias + col0 + bj * HALF + n * 16) : (f32x4){0.f, 0.f, 0.f, 0.f};
#pragma unroll
                for (int ai = 0; ai < 2; ++ai)
#pragma unroll
                    for (int m = 0; m < 4; ++m) acc[ai][bj][m][n] += bv; }
        f32x4 pre[4][2][2];
#pragma unroll
        for (int m = 0; m < 4; ++m) { const size_t off = (size_t)(u.pm * BM + wr * 64 + m * 16 + fr) * ldc + col0;
#pragma unroll
            for (int bj = 0; bj < 2; ++bj)
#pragma unroll
                for (int n = 0; n < 2; ++n) pre[m][bj][n] = *(const f32x4*)(base + off + bj * HALF + n * 16); }
        const bool bad = st.run(acc, u, wr, wc, fr, fq, lds, wid, lane) || poison != 0u;
        const float qnan = __builtin_nanf("");
#pragma unroll
        for (int ai = 0; ai < 2; ++ai)
#pragma unroll
            for (int m = 0; m < 4; ++m) { const int r = ai * HALF + wr * 64 + m * 16 + fr; const f32x2v sr = S[r]; const size_t off = (size_t)(u.pm * BM + r) * ldc + col0;
#pragma unroll
                for (int bj = 0; bj < 2; ++bj)
#pragma unroll
                    for (int n = 0; n < 2; ++n) { const f32x4 bs = ai == 0 ? pre[m][bj][n] : *(const f32x4*)(base + off + bj * HALF + n * 16); f32x4 o = bs + (acc[ai][bj][m][n] - sr.x) * sr.y;
                        if (bad) o = (f32x4){qnan, qnan, qnan, qnan}; *(f32x4*)(out + off + bj * HALF + n * 16) = o; }
                if (m & 1) asm volatile("" ::: "memory"); }
    }
};
struct EpiLnResLn {
    static constexpr bool PERM = false, AFTER_DRAIN = true;
    const float* base; float* out; bf16_t* xn; int ldc; const float* bias; PanelStats st1, st2; unsigned poison;
    __device__ __forceinline__ void fused(f32x4 (&acc)[2][2][4][2], const Unit& u, int wr, int wc, int fr, int fq, PG8_LAS unsigned char* lds, int wid, int lane) const {
        typedef float f32x2v __attribute__((ext_vector_type(2))); typedef unsigned u32x2v __attribute__((ext_vector_type(2)));
        const PG8_LAS f32x2v* S = (const PG8_LAS f32x2v*)(lds + 8192);
        const int col0 = u.pn * BM + wc * 32 + 4 * fq;
#pragma unroll
        for (int bj = 0; bj < 2; ++bj)
#pragma unroll
            for (int n = 0; n < 2; ++n) { const f32x4 bv = bias ? *(const f32x4*)(bias + col0 + bj * HALF + n * 16) : (f32x4){0.f, 0.f, 0.f, 0.f};
#pragma unroll
                for (int ai = 0; ai < 2; ++ai)
#pragma unroll
                    for (int m = 0; m < 4; ++m) acc[ai][bj][m][n] += bv; }
        bool bad = st1.run(acc, u, wr, wc, fr, fq, lds, wid, lane) || poison != 0u;
        const float qnan = __builtin_nanf("");
#pragma unroll
        for (int ai = 0; ai < 2; ++ai)
#pragma unroll
            for (int m = 0; m < 4; ++m) { const int r = ai * HALF + wr * 64 + m * 16 + fr; const f32x2v sr = S[r]; const size_t off = (size_t)(u.pm * BM + r) * ldc + col0;
#pragma unroll
                for (int bj = 0; bj < 2; ++bj)
#pragma unroll
                    for (int n = 0; n < 2; ++n) { const f32x4 bs = *(const f32x4*)(base + off + bj * HALF + n * 16); acc[ai][bj][m][n] = bs + (acc[ai][bj][m][n] - sr.x) * sr.y; }
                asm volatile("" : "+v"(acc[ai][0][m][0]), "+v"(acc[ai][0][m][1]), "+v"(acc[ai][1][m][0]), "+v"(acc[ai][1][m][1]));
                if (m & 1) asm volatile("" ::: "memory"); }
        const bool bad1 = bad;
        bad = st2.run(acc, u, wr, wc, fr, fq, lds, wid, lane) || bad;
#pragma unroll
        for (int ai = 0; ai < 2; ++ai)
#pragma unroll
            for (int m = 0; m < 4; ++m) { const int r = ai * HALF + wr * 64 + m * 16 + fr; const f32x2v sr = S[r]; const size_t off = (size_t)(u.pm * BM + r) * ldc + col0;
#pragma unroll
                for (int bj = 0; bj < 2; ++bj)
#pragma unroll
                    for (int n = 0; n < 2; ++n) { const f32x4 x1 = acc[ai][bj][m][n]; *(f32x4*)(out + off + bj * HALF + n * 16) = bad1 ? (f32x4){qnan, qnan, qnan, qnan} : x1;
                        const f32x4 o = (x1 - sr.x) * sr.y; u32x2v w; w.x = cvt_pk_bf16(o[0], o[1]); w.y = cvt_pk_bf16(o[2], o[3]);
                        if (bad) { w.x = 0x7fc07fc0u; w.y = 0x7fc07fc0u; } *(u32x2v*)(xn + off + bj * HALF + n * 16) = w; }
                asm volatile("" ::: "memory"); }
    }
};

template <class Epi, class Sched, bool ALIGN_EPI = false, bool SP2 = false>
__device__ __forceinline__ void gemm_phase(PG8_LAS unsigned char* lds, const Gemm g, const Sched& S, const Epi& E) {
    int tid_ = threadIdx.x; asm volatile("" : "+v"(tid_)); const int tid = tid_, wid = __builtin_amdgcn_readfirstlane(tid >> 6), lane = tid & 63, wr = wid >> 2, wc = wid & 3, fr = lane & 15, fq = lane >> 4;
    const int K = g.K, nt = K / BK;
    unsigned voffA[2], voffB[2];
#pragma unroll
    for (int i = 0; i < 2; ++i) { int R, C; stage_rc(tid * 16 + i * 8192, R, C); const int Rb = Epi::PERM ? ((R & ~31) + perm32(R & 31)) : R;
        voffA[i] = (unsigned)(R * K + C) * 2u; voffB[i] = (unsigned)(Rb * K + C) * 2u; }
    const size_t kstep = (size_t)(BK * 2);
    const size_t hstep = (size_t)HALF * K * 2;
    const size_t tstep = 2 * hstep;
    const unsigned ldsw = (unsigned)wid * 1024u;
    const int aoff = lds_byte(wr * 64 + fr, fq * 8), boff = lds_byte(wc * 32 + fr, fq * 8);
#define PG8_SA(b, h) (((b) * 2 + (h)) * HTB)
#define PG8_SB(b, h) ((4 + (b) * 2 + (h)) * HTB)
#define PG8_STAGE_X(bufoff, gbase, voff, aux) do { _Pragma("unroll") for (int _i = 0; _i < 2; ++_i) \
        __builtin_amdgcn_global_load_lds((const unsigned*)((const char*)(gbase) + (voff)[_i]), (PG8_LAS unsigned*)(lds + (bufoff) + ldsw + _i * 8192), 16, 0, aux); } while (0)
#define PG8_STAGE(bufoff, gbase, voff) PG8_STAGE_X(bufoff, gbase, voff, 0)
#define PG8_STAGE_A(bufoff, gbase, voff) PG8_STAGE_X(bufoff, gbase, voff, PG8_A_AUX)
#define PG8_LDA(dst, b, h) do { _Pragma("unroll") for (int m = 0; m < 4; ++m) _Pragma("unroll") for (int k = 0; k < 2; ++k) dst[m][k] = *(const PG8_LAS bf16x8*)(lds + PG8_SA(b, h) + aoff + m * 2048 + k * 1024); } while (0)
#define PG8_LDB(dst, b, h) do { _Pragma("unroll") for (int n = 0; n < 2; ++n) _Pragma("unroll") for (int k = 0; k < 2; ++k) dst[n][k] = *(const PG8_LAS bf16x8*)(lds + PG8_SB(b, h) + boff + n * 2048 + k * 1024); } while (0)
#define PG8_MMA(ai, bj, At, Bt) do { __builtin_amdgcn_s_setprio(1); _Pragma("unroll") for (int m = 0; m < 4; ++m) _Pragma("unroll") for (int n = 0; n < 2; ++n) _Pragma("unroll") for (int k = 0; k < 2; ++k) \
        acc[ai][bj][m][n] = __builtin_amdgcn_mfma_f32_16x16x32_bf16(Bt[n][k], At[m][k], acc[ai][bj][m][n], 0, 0, 0); __builtin_amdgcn_s_setprio(0); } while (0)
#define PG8_WAIT_V(n) asm volatile("s_waitcnt vmcnt(" #n ")" ::: "memory")
#define PG8_WAIT_L(n) asm volatile("s_waitcnt lgkmcnt(" #n ")" ::: "memory")
#define PG8_BAR __builtin_amdgcn_s_barrier()
#define PG8_SCHED __builtin_amdgcn_sched_barrier(0)
    Unit cur, nxt; int ui = 0;
    if (!S.next(0, cur)) return;
    f32x4 acc[2][2][4][2];
#pragma unroll
    for (int a = 0; a < 2; ++a)
#pragma unroll
        for (int b = 0; b < 2; ++b)
#pragma unroll
            for (int m = 0; m < 4; ++m)
#pragma unroll
                for (int n = 0; n < 2; ++n) acc[a][b][m][n] = (f32x4){0.f, 0.f, 0.f, 0.f};
    bf16x8 At[4][2], B0[2][2], B1[2][2];
    const char* cA = (const char*)g.A + (size_t)cur.pm * tstep; const char* cB = (const char*)g.Bt + (size_t)cur.pn * tstep;
    S.a_ready(cur);
    if constexpr (SP2) {
        PG8_STAGE(PG8_SB(0, 0), cB, voffB); PG8_STAGE(PG8_SB(0, 1), cB + hstep, voffB); PG8_STAGE_A(PG8_SA(0, 0), cA, voffA); PG8_STAGE_A(PG8_SA(0, 1), cA + hstep, voffA);
        if (wr == 1) PG8_BAR;
        PG8_WAIT_V(2); PG8_BAR;
        PG8_STAGE(PG8_SB(1, 0), cB + kstep, voffB); PG8_STAGE_A(PG8_SA(1, 0), cA + kstep, voffA); PG8_STAGE(PG8_SB(1, 1), cB + hstep + kstep, voffB);
        PG8_WAIT_V(6); PG8_BAR;
    } else {
        PG8_STAGE(PG8_SB(0, 0), cB, voffB); PG8_STAGE_A(PG8_SA(0, 0), cA, voffA); PG8_STAGE(PG8_SB(0, 1), cB + hstep, voffB); PG8_STAGE_A(PG8_SA(0, 1), cA + hstep, voffA);
        if (wr == 1) PG8_BAR;
        PG8_WAIT_V(4); PG8_BAR;
        PG8_STAGE(PG8_SB(1, 0), cB + kstep, voffB); PG8_STAGE_A(PG8_SA(1, 0), cA + kstep, voffA); PG8_STAGE(PG8_SB(1, 1), cB + hstep + kstep, voffB);
        PG8_WAIT_V(6); PG8_BAR;
    }
    for (;;) {
        const bool has_next = S.next(ui + 1, nxt);
        const char* nA = has_next ? (const char*)g.A + (size_t)nxt.pm * tstep : cA; const char* nB = has_next ? (const char*)g.Bt + (size_t)nxt.pn * tstep : cB;
        for (int t = 0; t < nt; t += 2) {
            const bool last = (t == nt - 2);
            const char* a1 = cA + (size_t)(t + 1) * kstep;
            const char* a2 = last ? nA : cA + (size_t)(t + 2) * kstep; const char* b2 = last ? nB : cB + (size_t)(t + 2) * kstep;
            const char* a3 = a2 + kstep; const char* b3 = b2 + kstep;
            if (last && has_next) S.a_ready(nxt);
            if constexpr (SP2) {
            PG8_LDB(B0, 0, 0); PG8_LDB(B1, 0, 1); PG8_SCHED; PG8_LDA(At, 0, 0); PG8_STAGE_A(PG8_SA(1, 1), a1 + hstep, voffA);
            PG8_WAIT_V(8); PG8_WAIT_L(0); PG8_BAR; PG8_MMA(0, 0, At, B0); PG8_MMA(0, 1, At, B1); PG8_BAR; PG8_SCHED;
            PG8_LDA(At, 0, 1); PG8_STAGE(PG8_SB(0, 0), b2, voffB); PG8_STAGE(PG8_SB(0, 1), b2 + hstep, voffB); PG8_STAGE_A(PG8_SA(0, 0), a2, voffA);
            PG8_WAIT_V(8); PG8_WAIT_L(0); PG8_BAR; PG8_MMA(1, 0, At, B0); PG8_MMA(1, 1, At, B1); PG8_BAR; PG8_SCHED;
            PG8_LDB(B0, 1, 0); PG8_LDB(B1, 1, 1); PG8_SCHED; PG8_LDA(At, 1, 0); PG8_STAGE_A(PG8_SA(0, 1), a2 + hstep, voffA);
            PG8_WAIT_V(8); PG8_WAIT_L(0); PG8_BAR; PG8_MMA(0, 0, At, B0); PG8_MMA(0, 1, At, B1); PG8_BAR; PG8_SCHED;
            PG8_LDA(At, 1, 1); PG8_STAGE(PG8_SB(1, 0), b3, voffB); PG8_STAGE(PG8_SB(1, 1), b3 + hstep, voffB); PG8_STAGE_A(PG8_SA(1, 0), a3, voffA);
            PG8_WAIT_V(8); PG8_WAIT_L(0); PG8_BAR; PG8_MMA(1, 0, At, B0); PG8_MMA(1, 1, At, B1); PG8_BAR; PG8_SCHED;
            } else {
            PG8_LDB(B0, 0, 0); PG8_SCHED; PG8_LDA(At, 0, 0); PG8_STAGE_A(PG8_SA(1, 1), a1 + hstep, voffA);
            PG8_WAIT_L(8); PG8_BAR; PG8_WAIT_L(0); PG8_MMA(0, 0, At, B0); PG8_BAR; PG8_SCHED;
            PG8_LDB(B1, 0, 1); PG8_STAGE(PG8_SB(0, 0), b2, voffB);
            PG8_BAR; PG8_WAIT_L(0); PG8_MMA(0, 1, At, B1); PG8_BAR;
            PG8_LDA(At, 0, 1); PG8_STAGE_A(PG8_SA(0, 0), a2, voffA);
            PG8_BAR; PG8_WAIT_L(0); PG8_MMA(1, 0, At, B0); PG8_BAR; PG8_SCHED;
            PG8_STAGE(PG8_SB(0, 1), b2 + hstep, voffB);
            PG8_WAIT_V(6); PG8_BAR; PG8_MMA(1, 1, At, B1); PG8_BAR;
            PG8_LDB(B0, 1, 0); PG8_SCHED; PG8_LDA(At, 1, 0); PG8_STAGE_A(PG8_SA(0, 1), a2 + hstep, voffA);
            PG8_WAIT_L(8); PG8_BAR; PG8_WAIT_L(0); PG8_MMA(0, 0, At, B0); PG8_BAR; PG8_SCHED;
            PG8_LDB(B1, 1, 1); PG8_STAGE(PG8_SB(1, 0), b3, voffB);
            PG8_BAR; PG8_WAIT_L(0); PG8_MMA(0, 1, At, B1); PG8_BAR;
            PG8_LDA(At, 1, 1); PG8_STAGE_A(PG8_SA(1, 0), a3, voffA);
            PG8_BAR; PG8_WAIT_L(0); PG8_MMA(1, 0, At, B0); PG8_BAR; PG8_SCHED;
            PG8_STAGE(PG8_SB(1, 1), b3 + hstep, voffB);
            PG8_WAIT_V(6); PG8_BAR; PG8_MMA(1, 1, At, B1); PG8_BAR;
            }
        }
        if constexpr (ALIGN_EPI) { if (wr == 0) PG8_BAR; }
        if constexpr (!Epi::AFTER_DRAIN) { E(acc, cur, wr, wc, fr, fq); S.done(cur); }
        if (!has_next) break;
#pragma unroll
        for (int a = 0; a < 2; ++a)
#pragma unroll
            for (int b = 0; b < 2; ++b)
#pragma unroll
                for (int m = 0; m < 4; ++m)
#pragma unroll
                    for (int n = 0; n < 2; ++n) acc[a][b][m][n] = (f32x4){0.f, 0.f, 0.f, 0.f};
        cur = nxt; cA = nA; cB = nB; ++ui;
        if constexpr (ALIGN_EPI) { if (wr == 1) PG8_BAR; }
    }
    PG8_WAIT_V(0);
    if constexpr (!ALIGN_EPI) { if (wr == 0) PG8_BAR; }
    PG8_BAR;
    if constexpr (Epi::AFTER_DRAIN) { E.fused(acc, cur, wr, wc, fr, fq, lds, wid, lane); S.done(cur); }
#undef PG8_SA
#undef PG8_SB
#undef PG8_STAGE
#undef PG8_STAGE_A
#undef PG8_STAGE_X
#undef PG8_LDA
#undef PG8_LDB
#undef PG8_MMA
#undef PG8_WAIT_V
#undef PG8_WAIT_L
#undef PG8_BAR
#undef PG8_SCHED
}
}

#ifndef SCALE_MIX
#define SCALE_MIX 1.0f
#endif
#ifndef SCALE_FFN
#define SCALE_FFN 1.0f
#endif
namespace mk {
#ifdef ZERO_SSD
constexpr float ZS = 0.f;
#elif defined(SC_SSD)
constexpr float ZS = SC_SSD;
#else
constexpr float ZS = 1.f;
#endif
#ifdef ZERO_FOX
constexpr float ZF = 0.f;
#elif defined(SC_FOX)
constexpr float ZF = SC_FOX;
#else
constexpr float ZF = 1.f;
#endif
#ifdef ZERO_SC
constexpr float ZC = 0.f;
#elif defined(SC_SC)
constexpr float ZC = SC_SC;
#else
constexpr float ZC = 1.f;
#endif
using pg8::bf16_t; using pg8::bf16x8; using pg8::f32x4; using pg8::u32x4;
typedef unsigned u32x2 __attribute__((ext_vector_type(2)));
constexpr int DM = 1024, BATCH = 4, SEQ = 4096, MROWS = BATCH * SEQ, DFF = 2816, NFF = 2 * DFF, NPROJ = 3072, NMOD = 9216;
constexpr int NT = 512, NW = 8;
constexpr float ALPHA = 1.4142135623730951f, LN_EPS = 1e-5f, RMS_EPS = 1e-5f, LOG2E = 1.4426950408889634f;
constexpr int PC_Z = 0, PC_XBC = 512, PC_Q = 1536, PC_K = 1792, PC_V = 2048, PC_SB = 2304, PC_SC = 2560, PC_SX = 2816;
constexpr size_t MiB = 1u << 20;
constexpr size_t WS_MOD = 0, WS_WMISC = 1 * MiB, WS_DTF = 2 * MiB, WS_CDEC = 3 * MiB, WS_BAR = 3 * MiB + 512 * 1024, WS_W = 4 * MiB;
constexpr size_t W_L = 41 * MiB;
constexpr size_t WO_1IN = 0, WO_1OUT = 11 * MiB, WO_MI = 11 * MiB + 5632 * 1024, WO_MO = WO_MI + 6 * MiB, WO_2IN = WO_MO + 2 * MiB, WO_2OUT = WO_2IN + 11 * MiB;
static_assert(WO_2OUT + 5632 * 1024 == W_L, "weight map");
constexpr size_t WS_HB = WS_W + 2 * W_L;
constexpr size_t WS_BIG = WS_HB + 32 * MiB;
constexpr size_t WS_YCAT = WS_BIG + 96 * MiB;
constexpr size_t WS_ST = WS_YCAT + 32 * MiB;
constexpr size_t WS_VT = WS_ST + 32 * MiB;
constexpr size_t WS_END = WS_VT + 8 * MiB;
constexpr int LDS_BYTES = 147456;

struct Args { const float* in[22]; float* out; unsigned char* ws; };
typedef const __attribute__((address_space(4))) Args* CArgsP;
__device__ __forceinline__ CArgsP get_args() { CArgsP p = (CArgsP)__builtin_amdgcn_kernarg_segment_ptr(); asm volatile("" : "+s"(p)); return p; }

typedef float f32x2_t __attribute__((ext_vector_type(2))); typedef __bf16 bf16x2_t __attribute__((ext_vector_type(2)));
__device__ __forceinline__ float bf_lo(unsigned w) { return __uint_as_float(w << 16); }
__device__ __forceinline__ float bf_hi(unsigned w) { return __uint_as_float(w & 0xffff0000u); }
__device__ __forceinline__ float bf2f(bf16_t v) { return __uint_as_float((unsigned)v << 16); }
#ifdef DEGRADE_BF16
__device__ __forceinline__ unsigned pk2(float lo, float hi) { return DEGRADE_OP(pg8::cvt_pk_bf16(lo, hi)); }
#elif defined(MANUAL_RNE)
__device__ __forceinline__ unsigned f2bf_rne_(float f) { unsigned u = __builtin_bit_cast(unsigned, f); return (u + 0x7fffu + ((u >> 16) & 1u)) >> 16; }
__device__ __forceinline__ unsigned pk2(float lo, float hi) { return f2bf_rne_(lo) | (f2bf_rne_(hi) << 16); }
#else
__device__ __forceinline__ unsigned pk2(float lo, float hi) { return pg8::cvt_pk_bf16(lo, hi); }
#endif
#ifdef DEGRADE_W
__device__ __forceinline__ unsigned pk2w(float lo, float hi) { return pg8::cvt_pk_bf16(lo, hi) & 0xFFFEFFFEu; }
#else
__device__ __forceinline__ unsigned pk2w(float lo, float hi) { return pg8::cvt_pk_bf16(lo, hi); }
#endif
__device__ __forceinline__ bf16_t f2bf(float f) { return (bf16_t)(pk2(f, 0.f) & 0xffffu); }
#ifndef DEG_SITES
#define DEG_SITES 0
#endif
template <int S> __device__ __forceinline__ unsigned pk2t(float lo, float hi) { unsigned r; if constexpr (S >= 2) { f32x2_t v_ = {lo, hi}; r = __builtin_bit_cast(unsigned, __builtin_convertvector(v_, bf16x2_t)); } else r = pg8::cvt_pk_bf16(lo, hi); if ((DEG_SITES >> S) & 1) r &= 0xFFFEFFFEu; return r; }
template <int S> __device__ __forceinline__ bf16_t f2bft(float f) { return (bf16_t)(pk2t<S>(f, 0.f) & 0xffffu); }
__device__ __forceinline__ float siluf(float v) { return v * __builtin_amdgcn_rcpf(1.f + __builtin_amdgcn_exp2f(-v * LOG2E)); }
__device__ __forceinline__ float wave_sum(float v) {
#pragma unroll
    for (int o = 1; o < 64; o <<= 1) v += __shfl_xor(v, o);
    return v;
}
__device__ __forceinline__ float wave_incl_scan(float v, int lane) {
#pragma unroll
    for (int o = 1; o < 64; o <<= 1) { const float t = __shfl_up(v, o); if (lane >= o) v += t; }
    return v;
}
__device__ __forceinline__ void unpack8(const u32x4 r, float (&f)[8]) {
    f[0] = bf_lo(r.x); f[1] = bf_hi(r.x); f[2] = bf_lo(r.y); f[3] = bf_hi(r.y); f[4] = bf_lo(r.z); f[5] = bf_hi(r.z); f[6] = bf_lo(r.w); f[7] = bf_hi(r.w);
}
template <class T> __device__ __forceinline__ T ldx(const T* p) {
    if constexpr (sizeof(T) == 16) { const unsigned long long* q = (const unsigned long long*)p; struct { unsigned long long a, b; } r;
        r.a = __hip_atomic_load(q, __ATOMIC_RELAXED, __HIP_MEMORY_SCOPE_AGENT); r.b = __hip_atomic_load(q + 1, __ATOMIC_RELAXED, __HIP_MEMORY_SCOPE_AGENT); return __builtin_bit_cast(T, r); }
    else if constexpr (sizeof(T) == 4) { const unsigned v = __hip_atomic_load((const unsigned*)p, __ATOMIC_RELAXED, __HIP_MEMORY_SCOPE_AGENT); return __builtin_bit_cast(T, v); }
    else { static_assert(sizeof(T) == 2, "ldx"); const unsigned short v = __hip_atomic_load((const unsigned short*)p, __ATOMIC_RELAXED, __HIP_MEMORY_SCOPE_AGENT); return __builtin_bit_cast(T, v); }
}
template <class T> __device__ __forceinline__ T ldxb(const void* ubase, unsigned off) {
    static_assert(sizeof(T) == 16, "ldxb");
    __amdgpu_buffer_rsrc_t r = __builtin_amdgcn_make_buffer_rsrc(const_cast<void*>(ubase), 0, 0x7fffffff, 0x00020000);
    return __builtin_bit_cast(T, __builtin_amdgcn_raw_buffer_load_b128(r, off, 0, 16));
}
#define LDS_WAIT() asm volatile("s_waitcnt lgkmcnt(0)" ::: "memory")

__device__ __forceinline__ int srcmap(int mode, int r0) {
    if (mode == 1) { const int pn = r0 >> 8, j = r0 & 255; return j < 128 ? pn * 128 + j : DFF + pn * 128 + (j - 128); }
    if (mode == 2) { return r0 < 1536 ? r0 : (r0 < 2304 ? r0 + 8 : r0 + 12); }
    return r0;
}
__device__ __forceinline__ void p0_item(const float* __restrict__ W, int K, int Nsrc, int Ndst, bf16_t* __restrict__ WT, int mode, float* scr, int item, int lane) {
    const int nblk = Ndst / 32, kb = item / nblk, nb = item % nblk, k0 = 64 * kb, r0 = 32 * nb, s0 = srcmap(mode, r0);
#pragma unroll
    for (int i = 0; i < 8; ++i) { const int kk = 8 * i + (lane >> 3), c4 = 4 * (lane & 7); const f32x4 v = *(const f32x4*)(W + (size_t)(k0 + kk) * Nsrc + s0 + c4);
        scr[kk * 33 + c4] = v.x; scr[kk * 33 + c4 + 1] = v.y; scr[kk * 33 + c4 + 2] = v.z; scr[kk * 33 + c4 + 3] = v.w; }
    LDS_WAIT();
    const int c = lane & 7;
#pragma unroll
    for (int j = 0; j < 4; ++j) { const int n = (lane >> 3) + 8 * j; const float* s = scr + (8 * c) * 33 + n;
        u32x4 o; o.x = pk2w(s[0 * 33], s[1 * 33]); o.y = pk2w(s[2 * 33], s[3 * 33]); o.z = pk2w(s[4 * 33], s[5 * 33]); o.w = pk2w(s[6 * 33], s[7 * 33]);
        *(u32x4*)(WT + (size_t)(r0 + n) * K + k0 + 8 * c) = o; }
    LDS_WAIT();
}
__device__ __forceinline__ void phase_p0(CArgsP a, unsigned char* lds, int tid, int wave, int lane) {
    float* mod = (float*)(a->ws + WS_MOD);
    float* sc = (float*)(lds + 69632);
    float* red = (float*)(lds + 69632 + 16384);
    for (int i = tid; i < 4096; i += NT) { const float v = a->in[1][i]; sc[i] = v / (1.f + expf(-v)); }
    __syncthreads();
    for (int it = blockIdx.x; it < 288; it += gridDim.x) {
        const int l = it / 144, cgp = it % 144, col = cgp * 64 + lane, k0 = wave * 128;
        const float* Wp = a->in[4] + (size_t)l * DM * NMOD + (size_t)k0 * NMOD + col;
        float a0 = 0.f, a1 = 0.f, a2 = 0.f, a3 = 0.f;
#pragma unroll 16
        for (int k = 0; k < 128; ++k) { const float w = Wp[(size_t)k * NMOD];
            a0 += sc[k0 + k] * w; a1 += sc[1024 + k0 + k] * w; a2 += sc[2048 + k0 + k] * w; a3 += sc[3072 + k0 + k] * w; }
        red[(wave * 4 + 0) * 64 + lane] = a0; red[(wave * 4 + 1) * 64 + lane] = a1; red[(wave * 4 + 2) * 64 + lane] = a2; red[(wave * 4 + 3) * 64 + lane] = a3;
        __syncthreads();
        if (tid < 256) { const int b = tid >> 6, ln = tid & 63; float s = 0.f;
#pragma unroll
            for (int w = 0; w < 8; ++w) s += red[(w * 4 + b) * 64 + ln];
            mod[(size_t)(l * 4 + b) * NMOD + cgp * 64 + ln] = s + a->in[5][l * NMOD + cgp * 64 + ln]; }
        __syncthreads();
    }
    { float* wm = (float*)(a->ws + WS_WMISC);
      for (int i = blockIdx.x * NT + tid; i < 2 * 12 * 1024; i += gridDim.x * NT) { const int l = i / 12288, r = i % 12288, j = r / 1024, k = r % 1024;
          const int colj = j < 8 ? 1536 + j : 2312 + (j - 8); wm[i] = a->in[8][(size_t)l * DM * 3084 + (size_t)k * 3084 + colj]; } }
    float* scr = (float*)(lds + wave * 8448);
    const int gw = blockIdx.x * NW + wave, NGW = gridDim.x * NW;
    constexpr int I_IN = 16 * (NFF / 32), I_OUT = (DFF / 64) * 32, I_MI = 16 * (NPROJ / 32), I_MO = 16 * 32, I_L = 2 * I_IN + 2 * I_OUT + I_MI + I_MO;
    for (int it = gw; it < 2 * I_L; it += NGW) {
        const int l = it / I_L; int r = it % I_L; unsigned char* wl = a->ws + WS_W + l * W_L;
        if (r < I_IN) { p0_item(a->in[6] + (size_t)l * DM * NFF, DM, NFF, NFF, (bf16_t*)(wl + WO_1IN), 1, scr, r, lane); continue; } r -= I_IN;
        if (r < I_IN) { p0_item(a->in[18] + (size_t)l * DM * NFF, DM, NFF, NFF, (bf16_t*)(wl + WO_2IN), 1, scr, r, lane); continue; } r -= I_IN;
        if (r < I_OUT) { p0_item(a->in[7] + (size_t)l * DFF * DM, DFF, DM, DM, (bf16_t*)(wl + WO_1OUT), 0, scr, r, lane); continue; } r -= I_OUT;
        if (r < I_OUT) { p0_item(a->in[19] + (size_t)l * DFF * DM, DFF, DM, DM, (bf16_t*)(wl + WO_2OUT), 0, scr, r, lane); continue; } r -= I_OUT;
        if (r < I_MI) { p0_item(a->in[8] + (size_t)l * DM * 3084, DM, 3084, NPROJ, (bf16_t*)(wl + WO_MI), 2, scr, r, lane); continue; } r -= I_MI;
        p0_item(a->in[9] + (size_t)l * DM * DM, DM, DM, DM, (bf16_t*)(wl + WO_MO), 0, scr, r, lane);
    }
}

template <bool MISC>
__device__ __forceinline__ void phase_ln(const float* src, float* X, bf16_t* Hb, const float* gamma, const float* beta, const float* modl, int sub, bool write_h,
                                         const float* wm, float* DTF, unsigned char* lds, int tid, int wave, int lane) {
    float* wml = (float*)lds;
    if (MISC) { for (int i = tid; i < 12288; i += NT) wml[i] = wm[i]; __syncthreads(); }
    const int gw = blockIdx.x * NW + wave, NGW = gridDim.x * NW;
    f32x4 g4[4], b4[4];
#pragma unroll
    for (int j = 0; j < 4; ++j) { g4[j] = *(const f32x4*)(gamma + 4 * lane + 256 * j); b4[j] = *(const f32x4*)(beta + 4 * lane + 256 * j); }
    for (int blk = gw; blk < MROWS / 8; blk += NGW) {
        const int m0 = blk * 8, b = m0 / SEQ;
        const float* shp = modl + (size_t)b * NMOD + (sub * 3 + 0) * DM; const float* scp = modl + (size_t)b * NMOD + (sub * 3 + 1) * DM;
        f32x4 sh4[4], sc4[4];
#pragma unroll
        for (int j = 0; j < 4; ++j) { if (write_h) { sh4[j] = *(const f32x4*)(shp + 4 * lane + 256 * j); sc4[j] = *(const f32x4*)(scp + 4 * lane + 256 * j) + 1.0f; } else { sh4[j] = (f32x4){0.f, 0.f, 0.f, 0.f}; sc4[j] = sh4[j]; } }
#pragma unroll 2
        for (int i = 0; i < 8; ++i) {
            const size_t m = (size_t)(m0 + i);
            f32x4 v[4]; float s = 0.f;
#pragma unroll
            for (int j = 0; j < 4; ++j) { v[j] = ldxb<f32x4>(src, (unsigned)((m * DM + 4 * lane + 256 * j) * 4)); s += (v[j].x + v[j].y) + (v[j].z + v[j].w); }
            const float mean = wave_sum(s) * (1.f / DM); float s2 = 0.f;
#pragma unroll
            for (int j = 0; j < 4; ++j) { v[j] = v[j] - mean; s2 += (v[j].x * v[j].x + v[j].y * v[j].y) + (v[j].z * v[j].z + v[j].w * v[j].w); }
            const float rstd = 1.f / sqrtf(wave_sum(s2) * (1.f / DM) + LN_EPS);
#pragma unroll
            for (int j = 0; j < 4; ++j) { v[j] = v[j] * rstd * g4[j] + b4[j]; *(f32x4*)(X + m * DM + 4 * lane + 256 * j) = v[j]; }
            if (write_h) {
#pragma unroll
                for (int j = 0; j < 4; ++j) { v[j] = v[j] * sc4[j] + sh4[j]; u32x2 w; w.x = pk2t<0>(v[j].x, v[j].y); w.y = pk2t<0>(v[j].z, v[j].w); *(u32x2*)(Hb + m * DM + 4 * lane + 256 * j) = w; }
                if (MISC) {
                    float keep = 0.f;
#pragma unroll
                    for (int jj = 0; jj < 12; ++jj) { float d = 0.f;
#pragma unroll
                        for (int j = 0; j < 4; ++j) { const f32x4 w4 = *(const f32x4*)(wml + jj * 1024 + 4 * lane + 256 * j); d += (v[j].x * w4.x + v[j].y * w4.y) + (v[j].z * w4.z + v[j].w * w4.w); }
                        d = wave_sum(d); if (lane == jj) keep = d; }
                    if (lane < 12) DTF[m * 12 + lane] = keep;
                }
            }
        }
    }
}

struct EpiMulti {
    static constexpr bool PERM = true, AFTER_DRAIN = false;
    int code;
    __device__ __forceinline__ void operator()(const f32x4 (&acc)[2][2][4][2], const pg8::Unit& u, int wr, int wc, int fr, int fq) const {
        CArgsP a = get_args(); int cd = code; asm volatile("" : "+s"(cd)); const int s = cd & 255, l = cd >> 8;
        unsigned char* ws = a->ws;
        if (s == 0 || s == 9) {
            bf16_t* O = (bf16_t*)(ws + WS_BIG);
            const int row0 = u.pm * 256 + wr * 64 + fr, col0 = u.pn * 128 + wc * 32 + 8 * fq;
#pragma unroll
            for (int ai = 0; ai < 2; ++ai)
#pragma unroll
                for (int m = 0; m < 4; ++m) {
                    const f32x4 g0 = acc[ai][0][m][0], g1 = acc[ai][0][m][1], u0 = acc[ai][1][m][0], u1 = acc[ai][1][m][1];
                    u32x4 w;
                    w.x = pk2t<1>(siluf(g0[0]) * u0[0], siluf(g0[1]) * u0[1]); w.y = pk2t<1>(siluf(g0[2]) * u0[2], siluf(g0[3]) * u0[3]);
                    w.z = pk2t<1>(siluf(g1[0]) * u1[0], siluf(g1[1]) * u1[1]); w.w = pk2t<1>(siluf(g1[2]) * u1[2], siluf(g1[3]) * u1[3]);
                    *(u32x4*)(O + (size_t)(row0 + ai * 128 + m * 16) * DFF + col0) = w;
                }
        } else if (s == 3) {
            bf16_t* O = (bf16_t*)(ws + WS_BIG);
            const int row0 = u.pm * 256 + wr * 64 + fr, col0 = u.pn * 256 + wc * 32 + 8 * fq;
#pragma unroll
            for (int ai = 0; ai < 2; ++ai)
#pragma unroll
                for (int m = 0; m < 4; ++m)
#pragma unroll
                    for (int bj = 0; bj < 2; ++bj) { const f32x4 v0 = acc[ai][bj][m][0], v1 = acc[ai][bj][m][1];
                        u32x4 w; w.x = pk2t<1>(v0[0], v0[1]); w.y = pk2t<1>(v0[2], v0[3]); w.z = pk2t<1>(v1[0], v1[1]); w.w = pk2t<1>(v1[2], v1[3]);
                        *(u32x4*)(O + (size_t)(row0 + ai * 128 + m * 16) * NPROJ + col0 + bj * 128) = w; }
        } else {
            const int sub = s == 1 ? 0 : (s == 7 ? 1 : 2);
#ifdef ZERO_FFN
            const float coef = s == 7 ? 1.0f : 0.0f;
#elif defined(ZERO_MIX)
            const float coef = s == 7 ? 0.0f : 0.5f;
#else
            const float coef = s == 7 ? 1.0f * SCALE_MIX : 0.5f * SCALE_FFN;
#endif
            float* X = a->out; const float* gate = (const float*)(ws + WS_MOD) + (size_t)l * 4 * NMOD + (sub * 3 + 2) * DM;
            const int b = u.pm >> 4, col0 = u.pn * 256 + wc * 32 + 8 * fq;
#pragma unroll
            for (int bj = 0; bj < 2; ++bj)
#pragma unroll
                for (int n = 0; n < 2; ++n) {
                    const int c = col0 + bj * 128 + n * 4;
                    const f32x4 gv = *(const f32x4*)(gate + (size_t)b * NMOD + c) * coef;
#pragma unroll
                    for (int ai = 0; ai < 2; ++ai)
#pragma unroll
                        for (int m = 0; m < 4; ++m) { float* p = X + (size_t)(u.pm * 256 + ai * 128 + wr * 64 + m * 16 + fr) * DM + c;
                            const f32x4 xv = ldxb<f32x4>(X, (unsigned)((size_t)(p - X) * 4));
#ifdef SKIP_T
                            const int rr_ = (u.pm * 256 + ai * 128 + wr * 64 + m * 16 + fr) & 4095; const float km_ = (s == 7 && rr_ >= SKIP_T0 && rr_ < SKIP_T) ? 0.f : 1.f;
                            *(f32x4*)p = xv * ALPHA + gv * acc[ai][bj][m][n] * km_; }
#else
                            *(f32x4*)p = xv * ALPHA + gv * acc[ai][bj][m][n]; }
#endif
                }
        }
    }
};

__device__ __forceinline__ void ssd_dt_acs(const float* DTF, const float* dt_bias, const float* a_log, int R0, int g, int wave, int lane, float* sDt, float* sAcs) {
    if (wave < 4) { const int h = g * 4 + wave; const float x = ldx(DTF + (size_t)(R0 + lane) * 12 + h) + dt_bias[h];
        const float dt = x > 20.f ? x : log1pf(expf(x)); const float av = -expf(a_log[h]) * dt; const float cs = wave_incl_scan(av, lane);
        sDt[wave * 64 + lane] = dt; sAcs[wave * 64 + lane] = cs; }
}
__device__ __forceinline__ void conv8(const bf16_t* PROJ, int b, int t, int cc, const float* cw, const float* cb, float (&o)[8]) {
    { const f32x4 b0 = *(const f32x4*)(cb + cc), b1 = *(const f32x4*)(cb + cc + 4); o[0] = b0.x; o[1] = b0.y; o[2] = b0.z; o[3] = b0.w; o[4] = b1.x; o[5] = b1.y; o[6] = b1.z; o[7] = b1.w; }
#pragma unroll
    for (int k = 0; k < 4; ++k) { const int tt = t - 3 + k;
        if (tt >= 0) { const u32x4 raw = ldxb<u32x4>(PROJ, (unsigned)(((size_t)(b * SEQ + tt) * NPROJ + PC_XBC + cc) * 2)); float x[8]; unpack8(raw, x);
            const f32x4 w0 = *(const f32x4*)(cw + k * 1024 + cc), w1 = *(const f32x4*)(cw + k * 1024 + cc + 4);
            o[0] += w0.x * x[0]; o[1] += w0.y * x[1]; o[2] += w0.z * x[2]; o[3] += w0.w * x[3]; o[4] += w1.x * x[4]; o[5] += w1.y * x[5]; o[6] += w1.z * x[6]; o[7] += w1.w * x[7]; } }
#pragma unroll
    for (int j = 0; j < 8; ++j) o[j] = siluf(o[j]);
}

template <int NR>
__device__ __forceinline__ void conv_rows(const bf16_t* PROJ, int b, int t, int cc, const float* cw, const float* cb, float (&o)[NR][8]) {
    float w[4][8], x[NR + 3][8];
#pragma unroll
    for (int k = 0; k < 4; ++k) { const f32x4 w0 = *(const f32x4*)(cw + k * 1024 + cc), w1 = *(const f32x4*)(cw + k * 1024 + cc + 4);
        w[k][0] = w0.x; w[k][1] = w0.y; w[k][2] = w0.z; w[k][3] = w0.w; w[k][4] = w1.x; w[k][5] = w1.y; w[k][6] = w1.z; w[k][7] = w1.w; }
    const f32x4 b0 = *(const f32x4*)(cb + cc), b1 = *(const f32x4*)(cb + cc + 4);
    const float bs[8] = {b0.x, b0.y, b0.z, b0.w, b1.x, b1.y, b1.z, b1.w};
#pragma unroll
    for (int i = 0; i < NR + 3; ++i) { const int tt = t - 3 + i;
        if (tt >= 0) unpack8(ldxb<u32x4>(PROJ, (unsigned)(((size_t)(b * SEQ + tt) * NPROJ + PC_XBC + cc) * 2)), x[i]);
        else {
#pragma unroll
            for (int j = 0; j < 8; ++j) x[i][j] = 0.f; } }
#pragma unroll
    for (int r = 0; r < NR; ++r)
#pragma unroll
        for (int j = 0; j < 8; ++j) o[r][j] = siluf(bs[j] + w[0][j] * x[r][j] + w[1][j] * x[r + 1][j] + w[2][j] * x[r + 2][j] + w[3][j] * x[r + 3][j]);
}

__device__ __forceinline__ void phase_ma(CArgsP a, int l, unsigned char* lds, int tid, int wave, int lane) {
    const bf16_t* PROJ = (const bf16_t*)(a->ws + WS_BIG); bf16_t* YCAT = (bf16_t*)(a->ws + WS_YCAT); bf16_t* ST = (bf16_t*)(a->ws + WS_ST);
    const float* DTF = (const float*)(a->ws + WS_DTF); float* CDEC = (float*)(a->ws + WS_CDEC);
    const float* cw = a->in[10] + (size_t)l * 4 * 1024; const float* cb = a->in[11] + l * 1024; const float* dtb = a->in[12] + l * 8; const float* alog = a->in[13] + l * 8;
    const int fr = lane & 15, fq = lane >> 4;
    bf16_t* sBT = (bf16_t*)lds;
    bf16_t* sXT = (bf16_t*)(lds + 18432);
    float* sDt = (float*)(lds + 18432 + 36864);
    float* sAcs = sDt + 256;
    for (int it = blockIdx.x; it < 512; it += gridDim.x) {
        const int b = it >> 7, c = (it >> 1) & 63, g = it & 1, t0 = c * 64, R0 = b * SEQ + t0;
        ssd_dt_acs(DTF, dtb, alog, R0, g, wave, lane, sDt, sAcs);
        __syncthreads();
        if (wave < 4 && lane == 63) CDEC[(b * 64 + c) * 8 + g * 4 + wave] = expf(sAcs[wave * 64 + 63]);
        {
          { const int n = (tid & 15) * 8, l0 = (tid >> 4) * 2; float v[2][8]; conv_rows<2>(PROJ, b, t0 + l0, 512 + g * 128 + n, cw, cb, v);
#pragma unroll
            for (int r = 0; r < 2; ++r)
#pragma unroll
                for (int j = 0; j < 8; ++j) sBT[(n + j) * 72 + l0 + r] = f2bft<2>(v[r][j]); }
          { const int ch = (tid & 31) * 8, l0 = (tid >> 5) * 4, e = ch >> 6; float v[4][8]; conv_rows<4>(PROJ, b, t0 + l0, g * 256 + ch, cw, cb, v);
#pragma unroll
            for (int r = 0; r < 4; ++r) { const float wgt = sDt[e * 64 + l0 + r] * expf(sAcs[e * 64 + 63] - sAcs[e * 64 + l0 + r]);
#pragma unroll
                for (int j = 0; j < 8; ++j) sXT[(ch + j) * 72 + l0 + r] = f2bft<2>(v[r][j] * wgt); } } }
        __syncthreads();
        { const int e = wave >> 1, nh = wave & 1;
          f32x4 acc[4][4];
#pragma unroll
          for (int i = 0; i < 4; ++i)
#pragma unroll
              for (int j = 0; j < 4; ++j) acc[i][j] = (f32x4){0.f, 0.f, 0.f, 0.f};
#pragma unroll
          for (int kk = 0; kk < 2; ++kk) {
              bf16x8 af[4], bfr[4];
#pragma unroll
              for (int i = 0; i < 4; ++i) af[i] = *(const bf16x8*)(sBT + (nh * 64 + 16 * i + fr) * 72 + 32 * kk + 8 * fq);
#pragma unroll
              for (int j = 0; j < 4; ++j) bfr[j] = *(const bf16x8*)(sXT + (e * 64 + 16 * j + fr) * 72 + 32 * kk + 8 * fq);
#pragma unroll
              for (int i = 0; i < 4; ++i)
#pragma unroll
                  for (int j = 0; j < 4; ++j) acc[i][j] = __builtin_amdgcn_mfma_f32_16x16x32_bf16(af[i], bfr[j], acc[i][j], 0, 0, 0);
          }
          bf16_t* sp = ST + (size_t)((b * 64 + c) * 8 + g * 4 + e) * 8192;
#pragma unroll
          for (int i = 0; i < 4; ++i)
#pragma unroll
              for (int j = 0; j < 4; ++j) { u32x2 w; w.x = pk2t<2>(acc[i][j][0], acc[i][j][1]); w.y = pk2t<2>(acc[i][j][2], acc[i][j][3]);
                  *(u32x2*)(sp + (16 * j + fr) * 128 + nh * 64 + 16 * i + 4 * fq) = w; }
        }
        __syncthreads();
    }
    { const float* sw = a->in[17] + (size_t)l * 3 * 256;
      for (int op = blockIdx.x * NT + tid; op < MROWS * 32; op += gridDim.x * NT) {
          const int m = op >> 5, ch = (op & 31) * 8, t = m & (SEQ - 1);
          float acc[8];
#pragma unroll
          for (int j = 0; j < 8; ++j) acc[j] = 0.f;
#pragma unroll
          for (int k = 0; k < 3; ++k) { const int tt = t - 2 + k;
              if (tt >= 0) { const unsigned ro = (unsigned)((size_t)(m - 2 + k) * NPROJ * 2); float cg[8], xi[8]; unpack8(ldxb<u32x4>(PROJ, ro + (PC_SC + ch) * 2), cg); unpack8(ldxb<u32x4>(PROJ, ro + (PC_SX + ch) * 2), xi);
                  const f32x4 w0 = *(const f32x4*)(sw + k * 256 + ch), w1 = *(const f32x4*)(sw + k * 256 + ch + 4);
                  acc[0] += w0.x * (cg[0] * xi[0]); acc[1] += w0.y * (cg[1] * xi[1]); acc[2] += w0.z * (cg[2] * xi[2]); acc[3] += w0.w * (cg[3] * xi[3]);
                  acc[4] += w1.x * (cg[4] * xi[4]); acc[5] += w1.y * (cg[5] * xi[5]); acc[6] += w1.z * (cg[6] * xi[6]); acc[7] += w1.w * (cg[7] * xi[7]); } }
          float bg[8]; unpack8(ldxb<u32x4>(PROJ, (unsigned)(((size_t)m * NPROJ + PC_SB + ch) * 2)), bg);
#pragma unroll
          for (int j = 0; j < 8; ++j) bg[j] *= ZC;
          u32x4 w; w.x = pk2t<6>(bg[0] * acc[0], bg[1] * acc[1]); w.y = pk2t<6>(bg[2] * acc[2], bg[3] * acc[3]); w.z = pk2t<6>(bg[4] * acc[4], bg[5] * acc[5]); w.w = pk2t<6>(bg[6] * acc[6], bg[7] * acc[7]);
          *(u32x4*)(YCAT + (size_t)m * DM + 768 + ch) = w;
      } }
    { bf16_t* VT = (bf16_t*)(a->ws + WS_VT); bf16_t* sT = (bf16_t*)lds;
      __syncthreads();
      for (int it = blockIdx.x; it < 1024; it += gridDim.x) {
          const int bh = it >> 6, kt = it & 63, b = bh >> 2, h = bh & 3, key = tid >> 3, dch = tid & 7;
          const u32x4 vreg = ldxb<u32x4>(PROJ, (unsigned)(((size_t)(b * SEQ + kt * 64 + key) * NPROJ + PC_V + h * 64 + dch * 8) * 2));
          bf16_t* vd = sT + (dch * 8) * 72 + key;
          vd[0 * 72] = (bf16_t)(vreg.x & 0xffffu); vd[1 * 72] = (bf16_t)(vreg.x >> 16); vd[2 * 72] = (bf16_t)(vreg.y & 0xffffu); vd[3 * 72] = (bf16_t)(vreg.y >> 16);
          vd[4 * 72] = (bf16_t)(vreg.z & 0xffffu); vd[5 * 72] = (bf16_t)(vreg.z >> 16); vd[6 * 72] = (bf16_t)(vreg.w & 0xffffu); vd[7 * 72] = (bf16_t)(vreg.w >> 16);
          __syncthreads();
          const u32x4 o = *(const u32x4*)(sT + key * 72 + dch * 8);
          *(u32x4*)(VT + ((size_t)bh * 64 + key) * SEQ + kt * 64 + dch * 8) = o;
          __syncthreads();
      } }
}

__device__ __forceinline__ void attn_tile(const bf16_t* sKb, const bf16_t* sVb, const float* cf2, int kt, int qw0, int qrow, int fr, int fq, float cfq,
                                          const bf16x8 qf0, const bf16x8 qf1, float& mrun, float& lrun, f32x4 (&o)[4]) {
    constexpr float C2 = 0.125f * LOG2E;
                const int k0 = kt * 64;
                if (k0 <= qw0 + 15) {
                    f32x4 sc[4];
#pragma unroll
                    for (int j = 0; j < 4; ++j) { const bf16x8 a0 = *(const bf16x8*)(sKb + (16 * j + fr) * 72 + fq * 8), a1 = *(const bf16x8*)(sKb + (16 * j + fr) * 72 + 32 + fq * 8);
                        sc[j] = __builtin_amdgcn_mfma_f32_16x16x32_bf16(a0, qf0, (f32x4){0.f, 0.f, 0.f, 0.f}, 0, 0, 0);
                        sc[j] = __builtin_amdgcn_mfma_f32_16x16x32_bf16(a1, qf1, sc[j], 0, 0, 0); }
#pragma unroll
                    for (int j = 0; j < 4; ++j) { const f32x4 ck = *(const f32x4*)(cf2 + k0 + 16 * j + 4 * fq);
#pragma unroll
                        for (int r = 0; r < 4; ++r) sc[j][r] = sc[j][r] * C2 + (cfq - ck[r]); }
                    if (k0 + 63 > qw0) {
#pragma unroll
                        for (int j = 0; j < 4; ++j)
#pragma unroll
                            for (int r = 0; r < 4; ++r) if (k0 + 16 * j + 4 * fq + r > qrow) sc[j][r] = -INFINITY;
                    }
                    float mx = fmaxf(fmaxf(sc[0][0], sc[0][1]), fmaxf(sc[0][2], sc[0][3]));
#pragma unroll
                    for (int j = 1; j < 4; ++j) mx = fmaxf(mx, fmaxf(fmaxf(sc[j][0], sc[j][1]), fmaxf(sc[j][2], sc[j][3])));
                    mx = fmaxf(mx, __shfl_xor(mx, 16)); mx = fmaxf(mx, __shfl_xor(mx, 32));
                    const float mnew = fmaxf(mrun, mx), alpha = __builtin_amdgcn_exp2f(mrun - mnew);
                    float ls = 0.f;
#pragma unroll
                    for (int j = 0; j < 4; ++j)
#pragma unroll
                        for (int r = 0; r < 4; ++r) { sc[j][r] = __builtin_amdgcn_exp2f(sc[j][r] - mnew); ls += sc[j][r]; }
                    lrun = lrun * alpha + ls; mrun = mnew;
#pragma unroll
                    for (int j = 0; j < 4; ++j) o[j] = o[j] * alpha;
#pragma unroll
                    for (int ks = 0; ks < 2; ++ks) {
                        u32x4 pw; pw.x = pk2t<4>(sc[2 * ks][0], sc[2 * ks][1]); pw.y = pk2t<4>(sc[2 * ks][2], sc[2 * ks][3]); pw.z = pk2t<4>(sc[2 * ks + 1][0], sc[2 * ks + 1][1]); pw.w = pk2t<4>(sc[2 * ks + 1][2], sc[2 * ks + 1][3]);
                        const bf16x8 pb = __builtin_bit_cast(bf16x8, pw);
#pragma unroll
                        for (int dj = 0; dj < 4; ++dj) { const bf16_t* vp = sVb + (16 * dj + fr) * 72 + 32 * ks + 4 * fq;
                            const u32x2 lo = *(const u32x2*)vp, hi = *(const u32x2*)(vp + 16); u32x4 vw; vw.x = lo.x; vw.y = lo.y; vw.z = hi.x; vw.w = hi.y;
                            o[dj] = __builtin_amdgcn_mfma_f32_16x16x32_bf16(__builtin_bit_cast(bf16x8, vw), pb, o[dj], 0, 0, 0); }
                    }
                }
}
__device__ __forceinline__ void phase_mb(CArgsP a, int l, unsigned char* lds, int tid, int wave, int lane, bool do_scan) {
    const bf16_t* PROJ = (const bf16_t*)(a->ws + WS_BIG); bf16_t* YCAT = (bf16_t*)(a->ws + WS_YCAT);
    const float* DTF = (const float*)(a->ws + WS_DTF); const float* CDEC = (const float*)(a->ws + WS_CDEC);
    if (do_scan) { unsigned* ST = (unsigned*)(a->ws + WS_ST);
      for (int gid = blockIdx.x * NT + tid; gid < 32 * 4096; gid += gridDim.x * NT) {
          const int bh = gid >> 12, rem = gid & 4095, b = bh >> 3, h = bh & 7;
          float r0 = 0.f, r1 = 0.f;
          for (int c0 = 0; c0 < 64; c0 += 8) {
              unsigned w[8]; float d[8];
#pragma unroll
              for (int i = 0; i < 8; ++i) { w[i] = ldx(ST + (size_t)((b * 64 + c0 + i) * 8 + h) * 4096 + rem); d[i] = ldx(CDEC + (b * 64 + c0 + i) * 8 + h); }
#pragma unroll
              for (int i = 0; i < 8; ++i) { ST[(size_t)((b * 64 + c0 + i) * 8 + h) * 4096 + rem] = pk2t<3>(r0, r1); r0 = r0 * d[i] + bf_lo(w[i]); r1 = r1 * d[i] + bf_hi(w[i]); }
          }
      } }
#ifdef NAIVE_ATTN
    { const float* fbias_ = a->in[16] + l * 4;
      for (int row = blockIdx.x * NT + tid; row < 16 * SEQ; row += gridDim.x * NT) {
          const int bh = row >> 12, q = row & 4095, b = bh >> 2, h = bh & 3; const float fb = fbias_[h];
          float qv[64], o[64];
#pragma unroll
          for (int d = 0; d < 64; ++d) { qv[d] = bf2f(ldx(PROJ + (size_t)(b * SEQ + q) * NPROJ + PC_Q + h * 64 + d)); o[d] = 0.f; }
          float m = -INFINITY, lsum = 0.f, bias = 0.f;
          for (int k = q; k >= 0; --k) {
              const bf16_t* kp = PROJ + (size_t)(b * SEQ + k) * NPROJ + PC_K + h * 64;
              float s = 0.f;
#pragma unroll
              for (int d8 = 0; d8 < 8; ++d8) { float kv[8]; unpack8(ldx((const u32x4*)(kp + d8 * 8)), kv);
#pragma unroll
                  for (int j = 0; j < 8; ++j) s += qv[d8 * 8 + j] * kv[j]; }
              s = s * 0.125f + bias;
              const float mn = fmaxf(m, s), al = expf(m - mn), p = expf(s - mn);
              lsum = lsum * al + p; m = mn;
#pragma unroll
              for (int d8 = 0; d8 < 8; ++d8) { float vv[8]; unpack8(ldx((const u32x4*)(kp + (PC_V - PC_K) + d8 * 8)), vv);
#pragma unroll
                  for (int j = 0; j < 8; ++j) o[d8 * 8 + j] = o[d8 * 8 + j] * al + p * vv[j]; }
              const float x = ldx(DTF + (size_t)(b * SEQ + k) * 12 + 8 + h) + fb; bias += fminf(x, 0.f) - log1pf(expf(-fabsf(x)));
          }
          const float inv = 1.f / lsum;
#pragma unroll
          for (int d = 0; d < 64; ++d) YCAT[(size_t)(b * SEQ + q) * DM + 512 + h * 64 + d] = f2bft<4>(o[d] * inv);
      } }
#endif
    const int fr = lane & 15, fq = lane >> 4;
    float* cf2 = (float*)lds;
    bf16_t* sK = (bf16_t*)(lds + 16384);
    bf16_t* sV = (bf16_t*)(lds + 16384 + 18432);
    float* wtot = (float*)(lds + 16384 + 36864);
    const float* fbias = a->in[16] + l * 4;
    constexpr float C2 = 0.125f * LOG2E;
#ifdef NAIVE_ATTN
    for (int v = 256; v < 256; v += gridDim.x) {
#else
    for (int v = blockIdx.x; v < 256; v += gridDim.x) {
#endif
        const int bh = v >> 4, s = v & 15, b = bh >> 2, h = bh & 3;
        __syncthreads();
        { float vals[8]; float run = 0.f; const float fb = fbias[h];
#pragma unroll
          for (int i = 0; i < 8; ++i) { const float x = ldx(DTF + (size_t)(b * SEQ + tid * 8 + i) * 12 + 8 + h) + fb; const float ls = fminf(x, 0.f) - log1pf(expf(-fabsf(x))); run += ls * LOG2E; vals[i] = run; }
          const float inc = wave_incl_scan(run, lane); if (lane == 63) wtot[wave] = inc;
          __syncthreads();
          float off = inc - run; for (int w = 0; w < wave; ++w) off += wtot[w];
#pragma unroll
          for (int i = 0; i < 8; ++i) cf2[tid * 8 + i] = vals[i] + off;
          __syncthreads(); }
        for (int uu = 0; uu < 2; ++uu) {
            const int qb = uu ? 31 - s : s, q0 = qb * 128, nt = 2 * (qb + 1);
            const int qw0 = q0 + wave * 16, qrow = qw0 + fr;
            const bf16_t* qp = PROJ + (size_t)(b * SEQ + qrow) * NPROJ + PC_Q + h * 64 + fq * 8;
            const bf16x8 qf0 = ldxb<bf16x8>(PROJ, (unsigned)((size_t)(qp - PROJ) * 2)), qf1 = ldxb<bf16x8>(PROJ, (unsigned)((size_t)(qp - PROJ) * 2 + 64));
            const float cfq = cf2[qrow];
            float mrun = -INFINITY, lrun = 0.f; f32x4 o[4];
#pragma unroll
            for (int j = 0; j < 4; ++j) o[j] = (f32x4){0.f, 0.f, 0.f, 0.f};
            const int key = tid >> 3, dch = tid & 7;
            const bf16_t* VT = (const bf16_t*)(a->ws + WS_VT);
            const unsigned kpo = (unsigned)(((size_t)(b * SEQ + key) * NPROJ + PC_K + h * 64 + dch * 8) * 2);
            const unsigned vpo = (unsigned)((((size_t)bh * 64 + key) * SEQ + dch * 8) * 2);
            u32x4 kA = ldxb<u32x4>(PROJ, kpo), vA = ldxb<u32x4>(VT, vpo);
            u32x4 kB = ldxb<u32x4>(PROJ, kpo + 64u * NPROJ * 2u), vB = ldxb<u32x4>(VT, vpo + 128u);
#define ATT_STEP(KT, KR, VR, BUFI) do { const int kt = (KT); bf16_t* sKb = sK + (BUFI) * 4608; bf16_t* sVb = sV + (BUFI) * 4608; \
                *(u32x4*)(sKb + key * 72 + dch * 8) = KR; *(u32x4*)(sVb + key * 72 + dch * 8) = VR; \
                __syncthreads(); \
                if (kt + 2 < nt) { KR = ldxb<u32x4>(PROJ, kpo + (unsigned)(kt + 2) * 64u * NPROJ * 2u); VR = ldxb<u32x4>(VT, vpo + (unsigned)(kt + 2) * 128u); } \
                ATT_COMPUTE } while (0)
#define ATT_COMPUTE attn_tile(sKb, sVb, cf2, kt, qw0, qrow, fr, fq, cfq, qf0, qf1, mrun, lrun, o);
            for (int kt2 = 0; kt2 < nt; kt2 += 2) { ATT_STEP(kt2, kA, vA, 0); ATT_STEP(kt2 + 1, kB, vB, 1); }
#undef ATT_STEP
#undef ATT_COMPUTE
            float lt = lrun; lt += __shfl_xor(lt, 16); lt += __shfl_xor(lt, 32);
            const float inv = ZF / lt;
            bf16_t* op = YCAT + (size_t)(b * SEQ + qrow) * DM + 512 + h * 64 + 4 * fq;
#pragma unroll
            for (int dj = 0; dj < 4; ++dj) { u32x2 w; w.x = pk2t<4>(o[dj][0] * inv, o[dj][1] * inv); w.y = pk2t<4>(o[dj][2] * inv, o[dj][3] * inv); *(u32x2*)(op + 16 * dj) = w; }
            __syncthreads();
        }
    }
}

__device__ __forceinline__ void phase_mc(CArgsP a, int l, unsigned char* lds, int tid, int wave, int lane) {
    const bf16_t* PROJ = (const bf16_t*)(a->ws + WS_BIG); bf16_t* YCAT = (bf16_t*)(a->ws + WS_YCAT); const bf16_t* ST = (const bf16_t*)(a->ws + WS_ST);
    const float* DTF = (const float*)(a->ws + WS_DTF);
    const float* cw = a->in[10] + (size_t)l * 4 * 1024; const float* cb = a->in[11] + l * 1024; const float* dtb = a->in[12] + l * 8; const float* alog = a->in[13] + l * 8;
    const float* dsk = a->in[14] + l * 8; const float* ng = a->in[15] + l * 512;
    const int fr = lane & 15, fq = lane >> 4;
    bf16_t* sC = (bf16_t*)lds;
    bf16_t* sB = (bf16_t*)(lds + 17408);
    bf16_t* sXT = (bf16_t*)(lds + 34816);
    float* sCB = (float*)(lds + 71680);
    float* sDt = (float*)(lds + 89088);
    float* sAcs = sDt + 256;
    float* sRms = sAcs + 256;
    bf16_t* sZT = (bf16_t*)(lds + 92160);
    bf16_t* sOut = (bf16_t*)lds;
    for (int it = blockIdx.x; it < 512; it += gridDim.x) {
        const int b = it >> 7, c = (it >> 1) & 63, g = it & 1, t0 = c * 64, R0 = b * SEQ + t0;
        ssd_dt_acs(DTF, dtb, alog, R0, g, wave, lane, sDt, sAcs);
        {
#pragma unroll
          for (int isC = 0; isC < 2; ++isC) { const int n = (tid & 15) * 8, l0 = (tid >> 4) * 2; float v[2][8]; conv_rows<2>(PROJ, b, t0 + l0, (isC ? 768 : 512) + g * 128 + n, cw, cb, v);
#pragma unroll
              for (int r = 0; r < 2; ++r) { u32x4 w; w.x = pk2t<5>(v[r][0], v[r][1]); w.y = pk2t<5>(v[r][2], v[r][3]); w.z = pk2t<5>(v[r][4], v[r][5]); w.w = pk2t<5>(v[r][6], v[r][7]);
                  *(u32x4*)((isC ? sC : sB) + (l0 + r) * 136 + n) = w; } }
          { const int ch = (tid & 31) * 8, l0 = (tid >> 5) * 4; float v[4][8]; conv_rows<4>(PROJ, b, t0 + l0, g * 256 + ch, cw, cb, v);
#pragma unroll
            for (int r = 0; r < 4; ++r) {
#pragma unroll
                for (int j = 0; j < 8; ++j) sXT[(ch + j) * 72 + l0 + r] = f2bft<5>(v[r][j]);
                const u32x4 zr = ldxb<u32x4>(PROJ, (unsigned)(((size_t)(R0 + l0 + r) * NPROJ + PC_Z + g * 256 + ch) * 2));
                bf16_t* zd = sZT + ch * 72 + l0 + r;
                zd[0 * 72] = (bf16_t)(zr.x & 0xffffu); zd[1 * 72] = (bf16_t)(zr.x >> 16); zd[2 * 72] = (bf16_t)(zr.y & 0xffffu); zd[3 * 72] = (bf16_t)(zr.y >> 16);
                zd[4 * 72] = (bf16_t)(zr.z & 0xffffu); zd[5 * 72] = (bf16_t)(zr.z >> 16); zd[6 * 72] = (bf16_t)(zr.w & 0xffffu); zd[7 * 72] = (bf16_t)(zr.w >> 16); } } }
        __syncthreads();
        { const int li = wave >> 1;
#pragma unroll
          for (int q = 0; q < 2; ++q) { const int sj = 2 * (wave & 1) + q; f32x4 acc = (f32x4){0.f, 0.f, 0.f, 0.f};
#pragma unroll
              for (int kk = 0; kk < 4; ++kk) { const bf16x8 af = *(const bf16x8*)(sC + (16 * li + fr) * 136 + 32 * kk + 8 * fq), bfr = *(const bf16x8*)(sB + (16 * sj + fr) * 136 + 32 * kk + 8 * fq);
                  acc = __builtin_amdgcn_mfma_f32_16x16x32_bf16(af, bfr, acc, 0, 0, 0); }
#pragma unroll
              for (int r = 0; r < 4; ++r) sCB[(16 * li + 4 * fq + r) * 68 + 16 * sj + fr] = acc[r]; } }
        __syncthreads();
        { const int e = wave >> 1, lh = wave & 1, h = g * 4 + e;
          f32x4 yd[2][4], yo[2][4];
#pragma unroll
          for (int mi = 0; mi < 2; ++mi)
#pragma unroll
              for (int pj = 0; pj < 4; ++pj) { yd[mi][pj] = (f32x4){0.f, 0.f, 0.f, 0.f}; yo[mi][pj] = yd[mi][pj]; }
#ifdef NOSKIP
          for (int kk = 0; kk < 2; ++kk) {
#else
          for (int kk = 0; kk <= lh; ++kk) {
#endif
              bf16x8 bx[4];
#pragma unroll
              for (int pj = 0; pj < 4; ++pj) bx[pj] = *(const bf16x8*)(sXT + (e * 64 + 16 * pj + fr) * 72 + 32 * kk + 8 * fq);
#pragma unroll
              for (int mi = 0; mi < 2; ++mi) { const int lrow = 32 * lh + 16 * mi + fr, s0 = 32 * kk + 8 * fq; const float al = sAcs[e * 64 + lrow];
                  const f32x4 c0 = *(const f32x4*)(sCB + lrow * 68 + s0), c1 = *(const f32x4*)(sCB + lrow * 68 + s0 + 4);
                  const f32x4 as0 = *(const f32x4*)(sAcs + e * 64 + s0), as1 = *(const f32x4*)(sAcs + e * 64 + s0 + 4), d0 = *(const f32x4*)(sDt + e * 64 + s0), d1 = *(const f32x4*)(sDt + e * 64 + s0 + 4);
                  float gv[8];
#pragma unroll
                  for (int j = 0; j < 4; ++j) { gv[j] = (s0 + j <= lrow) ? c0[j] * d0[j] * __expf(al - as0[j]) : 0.f; gv[4 + j] = (s0 + 4 + j <= lrow) ? c1[j] * d1[j] * __expf(al - as1[j]) : 0.f; }
                  u32x4 gw; gw.x = pk2t<5>(gv[0], gv[1]); gw.y = pk2t<5>(gv[2], gv[3]); gw.z = pk2t<5>(gv[4], gv[5]); gw.w = pk2t<5>(gv[6], gv[7]);
                  const bf16x8 ga = __builtin_bit_cast(bf16x8, gw);
#pragma unroll
                  for (int pj = 0; pj < 4; ++pj) yd[mi][pj] = __builtin_amdgcn_mfma_f32_16x16x32_bf16(ga, bx[pj], yd[mi][pj], 0, 0, 0); }
          }
          const bf16_t* sp = ST + (size_t)((b * 64 + c) * 8 + h) * 8192;
#pragma unroll
          for (int kk = 0; kk < 4; ++kk) {
              bf16x8 bs[4], ca[2];
#pragma unroll
              for (int pj = 0; pj < 4; ++pj) bs[pj] = ldxb<bf16x8>(ST, (unsigned)(((size_t)(sp - ST) + (16 * pj + fr) * 128 + 32 * kk + 8 * fq) * 2));
#pragma unroll
              for (int mi = 0; mi < 2; ++mi) ca[mi] = *(const bf16x8*)(sC + (32 * lh + 16 * mi + fr) * 136 + 32 * kk + 8 * fq);
#pragma unroll
              for (int mi = 0; mi < 2; ++mi)
#pragma unroll
                  for (int pj = 0; pj < 4; ++pj) yo[mi][pj] = __builtin_amdgcn_mfma_f32_16x16x32_bf16(ca[mi], bs[pj], yo[mi][pj], 0, 0, 0);
          }
          const float dh = dsk[h];
          float ss[2][4];
#pragma unroll
          for (int mi = 0; mi < 2; ++mi) { const int lb = 32 * lh + 16 * mi + 4 * fq; const f32x4 ea = *(const f32x4*)(sAcs + e * 64 + lb);
#pragma unroll
              for (int r = 0; r < 4; ++r) ss[mi][r] = 0.f;
#pragma unroll
              for (int pj = 0; pj < 4; ++pj) { const int p = 16 * pj + fr; const u32x2 xw = *(const u32x2*)(sXT + (e * 64 + p) * 72 + lb);
                  const float xs[4] = {bf_lo(xw.x), bf_hi(xw.x), bf_lo(xw.y), bf_hi(xw.y)};
                  const u32x2 zw = *(const u32x2*)(sZT + (e * 64 + p) * 72 + lb); const float zs[4] = {bf_lo(zw.x), bf_hi(zw.x), bf_lo(zw.y), bf_hi(zw.y)};
#pragma unroll
                  for (int r = 0; r < 4; ++r) { const float z = zs[r];
                      float y = yd[mi][pj][r] + __expf(ea[r]) * yo[mi][pj][r] + dh * xs[r]; y *= siluf(z); yd[mi][pj][r] = y; ss[mi][r] += y * y; } } }
#pragma unroll
          for (int mi = 0; mi < 2; ++mi)
#pragma unroll
              for (int r = 0; r < 4; ++r) { float s = ss[mi][r]; s += __shfl_xor(s, 1); s += __shfl_xor(s, 2); s += __shfl_xor(s, 4); s += __shfl_xor(s, 8);
                  if (fr == 0) sRms[(32 * lh + 16 * mi + 4 * fq + r) * 4 + e] = s; }
          __syncthreads();
#pragma unroll
          for (int mi = 0; mi < 2; ++mi) { const int lb = 32 * lh + 16 * mi + 4 * fq;
#pragma unroll
              for (int r = 0; r < 4; ++r) { const f32x4 q4 = *(const f32x4*)(sRms + (lb + r) * 4); const float rstd = 1.f / sqrtf(((q4.x + q4.y) + (q4.z + q4.w)) * (1.f / 256.f) + RMS_EPS);
#pragma unroll
                  for (int pj = 0; pj < 4; ++pj) { const int chl = e * 64 + 16 * pj + fr; sOut[(lb + r) * 264 + chl] = f2bft<5>(ZS * yd[mi][pj][r] * rstd * ng[g * 256 + chl]); } } }
        }
        __syncthreads();
        for (int o = tid; o < 2048; o += NT) { const int ll = o >> 5, c8 = (o & 31) * 8; *(u32x4*)(YCAT + (size_t)(R0 + ll) * DM + g * 256 + c8) = *(const u32x4*)(sOut + ll * 264 + c8); }
        __syncthreads();
    }
}
}


#define LAS __attribute__((address_space(3)))
#ifndef XB_ACQ_SCOPE
#define XB_ACQ_SCOPE ""
#endif
#define XB_TMO      128
#define XB_XCNT(j)  (256  + 64 * (j))
#define XB_XSUB(j)  (1280 + 64 * (j))
#define XB_XGEN(j)  (2304 + 64 * (j))
#define XB_TOP      3328
#define XB_TOPGEN   3392
#define XCD_BAR_WORDS 3456
#define XB_SPIN_CAP (1u << 18)

__device__ __forceinline__ unsigned xb_ld(unsigned* p)              { return __hip_atomic_load(p, __ATOMIC_RELAXED, __HIP_MEMORY_SCOPE_AGENT); }
__device__ __forceinline__ unsigned xb_add(unsigned* p, unsigned v) { return __hip_atomic_fetch_add(p, v, __ATOMIC_RELAXED, __HIP_MEMORY_SCOPE_AGENT); }
__device__ __forceinline__ unsigned xb_xcc_id() { return (unsigned)__builtin_amdgcn_s_getreg((3 << 11) | 20) & 0xFu; }
#define XB_SPIN(cond, bar) do { unsigned _sp = 0; while (cond) { __builtin_amdgcn_s_sleep(1); \
    if ((++_sp & 255u) == 0u) { if (xb_ld(&(bar)[XB_TMO])) break; if (_sp > XB_SPIN_CAP) { atomicAdd(&(bar)[XB_TMO], 1u); break; } } } } while (0)

struct XcdBarrier {
    unsigned* bar; unsigned x;
    volatile LAS unsigned* st;
};

__device__ __forceinline__ XcdBarrier xcd_barrier_post(unsigned* bar, volatile LAS unsigned* st) {
    XcdBarrier b; b.bar = bar; b.x = xb_xcc_id(); b.st = st;
    if (threadIdx.x == 0) (void)xb_add(&bar[XB_XCNT(b.x)], 1u);
    return b;
}
__device__ __forceinline__ void xcd_barrier_complete(unsigned* bar, unsigned x, unsigned& nloc, unsigned& nx) {
    const unsigned G = gridDim.x * gridDim.y * gridDim.z;
    unsigned sum, cnt, mine, sp = 0u;
    for (;;) {
        sum = 0u; cnt = 0u; mine = 0u;
#pragma unroll
        for (unsigned j = 0; j < 16; ++j) { const unsigned c = xb_ld(&bar[XB_XCNT(j)]); sum += c; cnt += (c > 0u) ? 1u : 0u; mine = (j == x) ? c : mine; }
        if (sum == G) break;
        __builtin_amdgcn_s_sleep(1);
        if ((++sp & 255u) == 0u) { if (xb_ld(&bar[XB_TMO])) break; if (sp > XB_SPIN_CAP) { atomicAdd(&bar[XB_TMO], 1u); break; } }
    }
    nloc = mine > 0u ? mine : 1u; nx = cnt > 0u ? cnt : 1u;
}

__device__ __forceinline__ void xcd_barrier(const XcdBarrier& b) {
    asm volatile("s_waitcnt vmcnt(0)" ::: "memory");
    __syncthreads();
    if (threadIdx.x == 0) {
        unsigned* bar = b.bar;
        __builtin_amdgcn_s_waitcnt(0);
        unsigned nloc = b.st[0], nx = b.st[1];
        if (nloc == 0u) { xcd_barrier_complete(bar, b.x, nloc, nx); b.st[0] = nloc; b.st[1] = nx; }
        const unsigned old = xb_add(&bar[XB_XSUB(b.x)], 1u);
        const unsigned gen = old / nloc;
        if (old + 1u == (gen + 1u) * nloc) {
            __builtin_amdgcn_fence(__ATOMIC_RELEASE, "agent");
            asm volatile("s_waitcnt vmcnt(0)" ::: "memory");
            const unsigned og = xb_add(&bar[XB_TOP], 1u);
            const unsigned tg = og / nx;
            if (og + 1u == (tg + 1u) * nx) xb_add(&bar[XB_TOPGEN], 1u);
            else XB_SPIN(xb_ld(&bar[XB_TOPGEN]) == tg, bar);
            __builtin_amdgcn_fence(__ATOMIC_ACQUIRE, "");
            asm volatile("s_waitcnt vmcnt(0)" ::: "memory");
            xb_add(&bar[XB_XGEN(b.x)], 1u);
            asm volatile("s_waitcnt vmcnt(0)" ::: "memory");
        } else {
            XB_SPIN(xb_ld(&bar[XB_XGEN(b.x)]) == gen, bar);
            __builtin_amdgcn_fence(__ATOMIC_ACQUIRE, "agent");
            asm volatile("s_waitcnt vmcnt(0)" ::: "memory");
        }
    }
    __syncthreads();
}


#ifndef MK_STOP_AFTER
#define MK_STOP_AFTER 1000
#endif
__global__ void __launch_bounds__(512, 2) mega_fwd(mk::Args a_unused) {
    using namespace mk;
    extern __shared__ __attribute__((aligned(16))) unsigned char lds[];
    cg::grid_group grid = cg::this_grid();
    volatile LAS unsigned* bst = (volatile LAS unsigned*)((LAS unsigned char*)lds + 131072 + 256);
#ifdef LDS_POISON
    for (int i = threadIdx.x; i < mk::LDS_BYTES / 4; i += 512) ((volatile unsigned*)lds)[i] = 0xFFFFFFFFu;
    __syncthreads();
#endif
    if (threadIdx.x < 8) bst[threadIdx.x] = 0u;
    __syncthreads();
    { CArgsP a0 = get_args(); (void)xcd_barrier_post((unsigned*)(a0->ws + WS_BAR), bst); }
    grid.sync();
#define GSYNC() do { CArgsP a_ = get_args(); XcdBarrier b_; b_.bar = (unsigned*)(a_->ws + WS_BAR); b_.x = xb_xcc_id(); b_.st = bst; xcd_barrier(b_); } while (0)
#pragma unroll 1
    for (int ph_ = 0; ph_ < (MK_STOP_AFTER < 25 ? MK_STOP_AFTER + 1 : 26); ++ph_) {
        int ph = ph_; asm volatile("" : "+s"(ph));
#ifdef TIME_CAT
        unsigned long long tc0_ = __builtin_amdgcn_s_memrealtime();
#endif
        int tid = threadIdx.x; asm volatile("" : "+v"(tid)); const int lane = tid & 63, wave = __builtin_amdgcn_readfirstlane(tid >> 6);
        CArgsP a = get_args();
        unsigned char* ws = a->ws;
        const int p = ph - 2, l = p < 0 ? 0 : p / 12, s = p < 0 ? -1 : p % 12;
        if (s == 0 || s == 1 || s == 3 || s == 7 || s == 9 || s == 10) {
#ifndef NO_G
            unsigned char* wl = ws + WS_W + (size_t)l * W_L;
            const size_t aoff = (s == 0 || s == 3 || s == 9) ? WS_HB : (s == 7 ? WS_YCAT : WS_BIG);
            const size_t boff = s == 0 ? WO_1IN : s == 1 ? WO_1OUT : s == 3 ? WO_MI : s == 7 ? WO_MO : s == 9 ? WO_2IN : WO_2OUT;
            const int N = (s == 0 || s == 9) ? NFF : (s == 3 ? NPROJ : DM), K = (s == 1 || s == 10) ? DFF : DM;
            pg8::Gemm g_{(const bf16_t*)(ws + aoff), (const bf16_t*)(wl + boff), MROWS, N, K}; pg8::StaticOrder S_; S_.init(MROWS, N, (int)gridDim.x, (int)blockIdx.x);
            EpiMulti E{s | (l << 8)};
            pg8::gemm_phase<EpiMulti, pg8::StaticOrder, true, true>((PG8_LAS unsigned char*)lds, g_, S_, E);
#ifdef DUP_G0
            if (s == 0 || s == 9) { __syncthreads(); pg8::gemm_phase<EpiMulti, pg8::StaticOrder, true, true>((PG8_LAS unsigned char*)lds, g_, S_, E); }
#endif
#endif
        } else if (ph == 0) {
#ifndef NO_P0
            phase_p0(a, lds, tid, wave, lane);
#ifdef DUP_P0
            __syncthreads(); phase_p0(a, lds, tid, wave, lane);
#endif
#endif
        } else if (ph == 1 || s == 8 || s == 11) {
            const float* modl = (const float*)(ws + WS_MOD) + (size_t)l * 4 * NMOD;
            const int li = s == 8 ? 1 : 2, sub = s == 8 ? 2 : 0; const bool wh = !(s == 11 && l == 1);
            const float* src = ph == 1 ? a->in[0] : (const float*)a->out;
            const float* gm = ph == 1 ? a->in[2] : a->in[20] + (l * 3 + li) * DM; const float* bt = ph == 1 ? a->in[3] : a->in[21] + (l * 3 + li) * DM;
            const float* md = (s == 11 && l == 0) ? modl + 4 * NMOD : modl;
            phase_ln<false>(src, a->out, (bf16_t*)(ws + WS_HB), gm, bt, md, sub, wh, nullptr, nullptr, lds, tid, wave, lane);
#ifdef DUP_LN1
            if (ph == 1) { phase_ln<false>(src, a->out, (bf16_t*)(ws + WS_HB), gm, bt, md, sub, wh, nullptr, nullptr, lds, tid, wave, lane); phase_ln<false>(src, a->out, (bf16_t*)(ws + WS_HB), gm, bt, md, sub, wh, nullptr, nullptr, lds, tid, wave, lane); phase_ln<false>(src, a->out, (bf16_t*)(ws + WS_HB), gm, bt, md, sub, wh, nullptr, nullptr, lds, tid, wave, lane); }
#endif
        } else if (s == 2) {
            const float* modl = (const float*)(ws + WS_MOD) + (size_t)l * 4 * NMOD;
            phase_ln<true>(a->out, a->out, (bf16_t*)(ws + WS_HB), a->in[20] + l * 3 * DM, a->in[21] + l * 3 * DM, modl, 1, true, (const float*)(ws + WS_WMISC) + l * 12288, (float*)(ws + WS_DTF), lds, tid, wave, lane);
        } else if (s == 4) {
            phase_ma(a, l, lds, tid, wave, lane);
#if defined(DUP_MIX) && (DUP_MIX & 1)
            __syncthreads(); phase_ma(a, l, lds, tid, wave, lane);
#endif
        } else if (s == 5) {
            phase_mb(a, l, lds, tid, wave, lane, true);
#if defined(DUP_MIX) && (DUP_MIX & 2)
            __syncthreads(); phase_mb(a, l, lds, tid, wave, lane, false);
#endif
        } else {
            phase_mc(a, l, lds, tid, wave, lane);
#if defined(DUP_MIX) && (DUP_MIX & 4)
            __syncthreads(); phase_mc(a, l, lds, tid, wave, lane);
#endif
        }
        if (ph_ < 25) GSYNC();
#ifdef DUP_BAR
        if (ph_ < 25) { GSYNC(); GSYNC(); }
#endif
#ifdef TIME_CAT
        { const int p2_ = ph_ - 2, s2_ = p2_ < 0 ? -1 : p2_ % 12;
          const int cat_ = (s2_ == 0 || s2_ == 1 || s2_ == 3 || s2_ == 7 || s2_ == 9 || s2_ == 10) ? 1 : (ph_ == 0 ? 6 : ((ph_ == 1 || s2_ == 2 || s2_ == 8 || s2_ == 11) ? 2 : (s2_ == 4 ? 3 : (s2_ == 5 ? 4 : 5))));
          if (cat_ == TIME_CAT && threadIdx.x == 0) { volatile LAS unsigned* tacc = bst + 4; tacc[0] = tacc[0] + (unsigned)(__builtin_amdgcn_s_memrealtime() - tc0_); } }
#endif
    }
#ifdef TIME_CAT
    if (blockIdx.x == 0 && threadIdx.x == 0) { CArgsP a9 = get_args(); a9->out[0] = (float)bst[4] * 0.01f; }
#endif
}

extern "C" void kernel_launch(void* const* d_in, const int* in_sizes, int n_in, void* d_out, int out_size, void* d_ws, size_t ws_size, hipStream_t stream) {
    static int grid = 0;
    if (grid == 0) {
        if (n_in != 22 || out_size != mk::MROWS * mk::DM || ws_size < mk::WS_END) { fprintf(stderr, "kernel_launch: unexpected problem (n_in %d out %d ws %zu)\n", n_in, out_size, ws_size); grid = -1; return; }
        int dev = 0, cus = 0, per_cu = 0;
        (void)hipGetDevice(&dev); (void)hipDeviceGetAttribute(&cus, hipDeviceAttributeMultiprocessorCount, dev);
        (void)hipFuncSetAttribute((const void*)mega_fwd, hipFuncAttributeMaxDynamicSharedMemorySize, mk::LDS_BYTES);
        (void)hipOccupancyMaxActiveBlocksPerMultiprocessor(&per_cu, (const void*)mega_fwd, 512, mk::LDS_BYTES);
        (void)hipGetLastError();
        if (per_cu < 1) { fprintf(stderr, "kernel_launch: occupancy query says %d\n", per_cu); grid = -1; return; }
        grid = cus;
    }
    if (grid < 0) return;
#ifdef NAN_POISON
    (void)hipMemsetAsync(d_ws, 0xFF, mk::WS_END, stream); (void)hipMemsetAsync(d_out, 0xFF, (size_t)out_size * 4, stream);
#endif
    if (hipMemsetAsync((char*)d_ws + mk::WS_BAR, 0, 16384, stream) != hipSuccess) { fprintf(stderr, "kernel_launch: memset failed\n"); return; }
    mk::Args a{};
    for (int i = 0; i < 22; ++i) a.in[i] = (const float*)d_in[i];
    a.out = (float*)d_out; a.ws = (unsigned char*)d_ws;
    void* args[] = {&a};
    hipError_t e = hipLaunchCooperativeKernel((const void*)mega_fwd, dim3(grid), dim3(512), args, mk::LDS_BYTES, stream);
    if (e != hipSuccess) fprintf(stderr, "cooperative launch failed: %s (grid %d)\n", hipGetErrorString(e), grid);
}
```

```cpp
#include <hip/hip_runtime.h>
#include <hip/hip_cooperative_groups.h>
#include <cstdio>
#include <cstdint>
namespace cg = cooperative_groups;
#ifndef PG8_A_AUX
#define PG8_A_AUX 16
#endif
namespace pg8 {
#define PG8_LAS __attribute__((address_space(3)))
typedef unsigned short bf16_t;
typedef short bf16x8 __attribute__((ext_vector_type(8)));
typedef float f32x4 __attribute__((ext_vector_type(4)));
typedef unsigned u32x4 __attribute__((ext_vector_type(4)));
constexpr int BM = 256, BK = 64, HALF = 128, HTB = HALF * BK * 2  , STAGE_BYTES = 8 * HTB, NXCD = 8, WGM = 8;

__host__ __device__ __forceinline__ int lds_byte(int r, int c) { const int st = (r >> 4) * 2 + (c >> 5), rr = r & 15, cc = c & 31, ob = rr * 64 + cc * 2; return st * 1024 + (ob ^ (((ob >> 9) & 1) << 5)); }
__host__ __device__ __forceinline__ void stage_rc(int b, int& R, int& C) { const int st = b / 1024, sb = b % 1024, swz = sb ^ (((sb >> 9) & 1) << 5); R = (st >> 1) * 16 + swz / 64; C = (st & 1) * 32 + (swz % 64) / 2; }
__host__ __device__ __forceinline__ int perm32(int rho) { const int n = rho >> 4, i = rho & 15; return 8 * (i >> 2) + 4 * n + (i & 3); }

struct Unit { int pm, pn; };
struct Gemm { const bf16_t* A; const bf16_t* Bt; int M, N, K; };

struct StaticOrder {
    int nM, nN, nwg, G, c;
    __host__ __device__ void init(int M, int N, int G_, int c_) { nM = M / BM; nN = N / BM; nwg = nM * nN; G = G_; c = c_; }
    __host__ __device__ bool next(int i, Unit& u) const {
        const long L = (long)i * G + c; if (L >= nwg) return false;
        int wgid = (int)L; { const int q = nwg / NXCD, r = nwg % NXCD, xcd = wgid % NXCD, off = wgid / NXCD; wgid = (xcd < r ? xcd * (q + 1) : r * (q + 1) + (xcd - r) * q) + off; }
        const int nig = WGM * nN, gid = wgid / nig, fm = gid * WGM, gsz = (nM - fm) < WGM ? (nM - fm) : WGM;
        u.pm = fm + ((wgid % nig) % gsz); u.pn = (wgid % nig) / gsz; return true;
    }
    __device__ __forceinline__ void a_ready(const Unit&) const {}
    __device__ __forceinline__ void done(const Unit&) const {}
};

__device__ __forceinline__ unsigned cvt_pk_bf16(float lo, float hi) { unsigned r; asm volatile("v_cvt_pk_bf16_f32 %0, %1, %2" : "=v"(r) : "v"(lo), "v"(hi)); return r; }
typedef float f32x2 __attribute__((ext_vector_type(2)));
__device__ __forceinline__ f32x2 gelu_pk(f32x2 v) {
    const f32x2 av = __builtin_elementwise_abs(v), d = av * 0.2316418882f + 1.0f;
    f32x2 t; t.x = __builtin_amdgcn_rcpf(d.x); t.y = __builtin_amdgcn_rcpf(d.y);
    f32x2 q = t * 0.5307027145f + (-0.7265760135f); q = q * t + 0.7107068705f; q = q * t + (-0.142248368f); q = q * t + 0.127414796f; q = q * t;
    const f32x2 s = (v * v) * (-0.72134752044f);
    f32x2 e; e.x = __builtin_amdgcn_exp2f(s.x); e.y = __builtin_amdgcn_exp2f(s.y);
    const f32x2 m = v * (q * e), r = v - m;
    f32x2 o; o.x = v.x < 0.f ? m.x : r.x; o.y = v.y < 0.f ? m.y : r.y; return o;
}

template <int ACT  > struct EpiBf16 {
    static constexpr bool PERM = true, AFTER_DRAIN = false; static_assert(ACT == 0 || ACT == 1, "EpiBf16: ACT is 0 (none) or 1 (gelu_pk)");
    bf16_t* O; int ldc; const float* bias; int split_cols; size_t split_stride; float scale0;
    __device__ __forceinline__ void operator()(const f32x4 (&acc)[2][2][4][2], const Unit& u, int wr, int wc, int fr, int fq) const {
        const int row0 = u.pm * BM + wr * 64 + fr; int colt = u.pn * BM; bf16_t* base = O;
        float sc = 1.f; if (split_cols) { const int t = colt / split_cols; base += (size_t)t * split_stride; colt -= t * split_cols; if (t == 0) sc = scale0; }
        const int col0 = colt + wc * 32 + 8 * fq, bcol0 = u.pn * BM + wc * 32 + 8 * fq;
        f32x4 bv[2][2];
#pragma unroll
        for (int bj = 0; bj < 2; ++bj)
#pragma unroll
            for (int n = 0; n < 2; ++n) bv[bj][n] = bias ? *(const f32x4*)(bias + bcol0 + bj * HALF + 4 * n) : (f32x4){0.f, 0.f, 0.f, 0.f};
#pragma unroll
        for (int ai = 0; ai < 2; ++ai)
#pragma unroll
            for (int m = 0; m < 4; ++m) { bf16_t* rowp = base + (size_t)(row0 + ai * HALF + m * 16) * ldc + col0;
#pragma unroll
                for (int bj = 0; bj < 2; ++bj) { f32x4 v0 = acc[ai][bj][m][0] + bv[bj][0], v1 = acc[ai][bj][m][1] + bv[bj][1];
                    if (ACT == 1) { f32x2 a = gelu_pk((f32x2){v0[0], v0[1]}), b = gelu_pk((f32x2){v0[2], v0[3]}), c = gelu_pk((f32x2){v1[0], v1[1]}), d = gelu_pk((f32x2){v1[2], v1[3]});
                        v0 = (f32x4){a.x, a.y, b.x, b.y}; v1 = (f32x4){c.x, c.y, d.x, d.y}; }
                    v0 = v0 * sc; v1 = v1 * sc; u32x4 w; w.x = cvt_pk_bf16(v0[0], v0[1]); w.y = cvt_pk_bf16(v0[2], v0[3]); w.z = cvt_pk_bf16(v1[0], v1[1]); w.w = cvt_pk_bf16(v1[2], v1[3]);
                    *(u32x4*)(rowp + bj * HALF) = w; } }
    }
};

struct PanelStats {
    unsigned* xbuf;
    unsigned* cnt;
    unsigned* tmo;
    int ntn; float eps;
    unsigned code;
    __device__ __forceinline__ bool run(const f32x4 (&v)[2][2][4][2], const Unit& u, int wr, int wc, int fr, int fq, PG8_LAS unsigned char* lds, int wid, int lane) const {
        typedef float f32x2v __attribute__((ext_vector_type(2)));
        PG8_LAS f32x2v* P = (PG8_LAS f32x2v*)lds;
        PG8_LAS f32x2v* S = (PG8_LAS f32x2v*)(lds + 8192);
        PG8_LAS unsigned* flag = (PG8_LAS unsigned*)(lds + 8192 + 2048);
#pragma unroll
        for (int ai = 0; ai < 2; ++ai)
#pragma unroll
            for (int m = 0; m < 4; ++m) {
                float s = 0.f;
#pragma unroll
                for (int bj = 0; bj < 2; ++bj)
#pragma unroll
                    for (int n = 0; n < 2; ++n) { const f32x4 x = v[ai][bj][m][n]; s += (x[0] + x[1]) + (x[2] + x[3]); }
                s += __shfl_xor(s, 16); s += __shfl_xor(s, 32);
                const float mw = s * (1.0f / 64.0f); float q = 0.f;
#pragma unroll
                for (int bj = 0; bj < 2; ++bj)
#pragma unroll
                    for (int n = 0; n < 2; ++n) { const f32x4 d = v[ai][bj][m][n] - mw; q += (d[0] * d[0] + d[1] * d[1]) + (d[2] * d[2] + d[3] * d[3]); }
                q += __shfl_xor(q, 16); q += __shfl_xor(q, 32);
                if (fq == 0) P[(ai * HALF + wr * 64 + m * 16 + fr) * 4 + wc] = (f32x2v){mw, q};
            }
        asm volatile("s_waitcnt lgkmcnt(0)" ::: "memory"); __builtin_amdgcn_s_barrier(); asm volatile("" ::: "memory");
#if defined(BROKEN_EXCHANGE_NO_WAIT)
#warning BROKEN CONTROL BUILD: the row-statistics exchange does not wait; results are wrong by design
        if (blockIdx.x >= 64) { const long long t0_ = clock64(); while (clock64() - t0_ < 60000) __builtin_amdgcn_s_sleep(8); }
#endif
        const int row = wid * 32 + (lane & 31);
        if (lane < 32) {
            const f32x2v a = P[row * 4 + 0], b = P[row * 4 + 1], c = P[row * 4 + 2], d = P[row * 4 + 3];
            const float mt = (a.x + b.x + c.x + d.x) * 0.25f;
            const float da = a.x - mt, db = b.x - mt, dc = c.x - mt, dd = d.x - mt;
            const float m2 = (a.y + b.y) + (c.y + d.y) + 64.0f * ((da * da + db * db) + (dc * dc + dd * dd));
            unsigned long long* slot = (unsigned long long*)xbuf + ((size_t)(u.pm * BM + row) * 4 + u.pn);
            __hip_atomic_store(slot, ((unsigned long long)__float_as_uint(m2) << 32) | __float_as_uint(mt), __ATOMIC_RELAXED, __HIP_MEMORY_SCOPE_AGENT);
        }
        asm volatile("s_waitcnt vmcnt(0)" ::: "memory");
        if (lane == 0) __hip_atomic_fetch_add(cnt + 64 * u.pm, 1u, __ATOMIC_RELAXED, __HIP_MEMORY_SCOPE_AGENT);
        if (wid == 0) {
            bool dead = false; const unsigned long long t0 = __builtin_amdgcn_s_memrealtime(); const unsigned want = 8u * (unsigned)ntn;
            for (;;) {
#if defined(BROKEN_EXCHANGE_NO_WAIT)
                break;
#endif
                if ((unsigned)__builtin_amdgcn_readfirstlane(__hip_atomic_load(cnt + 64 * u.pm, __ATOMIC_RELAXED, __HIP_MEMORY_SCOPE_AGENT)) >= want) break;
                if (__builtin_amdgcn_s_memrealtime() - t0 > 2000000ull) {
                    if (lane == 0) { unsigned expect = 0u; __hip_atomic_compare_exchange_strong(tmo + 1, &expect, code | (unsigned)(u.pm & 0xff), __ATOMIC_RELAXED, __ATOMIC_RELAXED, __HIP_MEMORY_SCOPE_AGENT);
                                     __hip_atomic_store(tmo, 1u, __ATOMIC_RELAXED, __HIP_MEMORY_SCOPE_AGENT); }
                    dead = true; break; }
                __builtin_amdgcn_s_sleep(2);
            }
            __builtin_amdgcn_fence(__ATOMIC_ACQUIRE, "agent");
            if (lane == 0) flag[0] = dead ? 1u : 0u;
        }
        asm volatile("s_waitcnt vmcnt(0) lgkmcnt(0)" ::: "memory"); __builtin_amdgcn_s_barrier(); asm volatile("" ::: "memory");
        const bool bad = flag[0] != 0u;
        if (lane < 32) {
            const unsigned long long* slot = (const unsigned long long*)xbuf + (size_t)(u.pm * BM + row) * 4; float mt[4], m2[4]; float ms = 0.f;
#pragma unroll
            for (int t = 0; t < 4; ++t) { if (t < ntn) { const unsigned long long w = __hip_atomic_load(slot + t, __ATOMIC_RELAXED, __HIP_MEMORY_SCOPE_AGENT); mt[t] = __uint_as_float((unsigned)w); m2[t] = __uint_as_float((unsigned)(w >> 32)); } else { mt[t] = 0.f; m2[t] = 0.f; } ms += mt[t]; }
            const float mean = ms / (float)ntn; float q = 0.f;
#pragma unroll
            for (int t = 0; t < 4; ++t) if (t < ntn) { const float dm = mt[t] - mean; q += m2[t] + 256.0f * dm * dm; }
            S[row] = (f32x2v){mean, 1.0f / sqrtf(q / (256.0f * (float)ntn) + eps)};
        }
        asm volatile("s_waitcnt lgkmcnt(0)" ::: "memory"); __builtin_amdgcn_s_barrier(); asm volatile("" ::: "memory");
        return bad;
    }
};
struct EpiLnRes {
    static constexpr bool PERM = false, AFTER_DRAIN = true;
    const float* base; float* out; int ldc; const float* bias; PanelStats st; unsigned poison;
    __device__ __forceinline__ void fused(f32x4 (&acc)[2][2][4][2], const Unit& u, int wr, int wc, int fr, int fq, PG8_LAS unsigned char* lds, int wid, int lane) const {
        typedef float f32x2v __attribute__((ext_vector_type(2)));
        const PG8_LAS f32x2v* S = (const PG8_LAS f32x2v*)(lds + 8192);
        const int col0 = u.pn * BM + wc * 32 + 4 * fq;
#pragma unroll
        for (int bj = 0; bj < 2; ++bj)
#pragma unroll
            for (int n = 0; n < 2; ++n) { const f32x4 bv = bias ? *(const f32x4*)(bias + col0 + bj * HALF + n * 16) : (f32x4){0.f, 0.f, 0.f, 0.f};
#pragma unroll
                for (int ai = 0; ai < 2; ++ai)
#pragma unroll
                    for (int m = 0; m < 4; ++m) acc[ai][bj][m][n] += bv; }
        f32x4 pre[4][2][2];
#pragma unroll
        for (int m = 0; m < 4; ++m) { const size_t off = (size_t)(u.pm * BM + wr * 64 + m * 16 + fr) * ldc + col0;
#pragma unroll
            for (int bj = 0; bj < 2; ++bj)
#pragma unroll
                for (int n = 0; n < 2; ++n) pre[m][bj][n] = *(const f32x4*)(base + off + bj * HALF + n * 16); }
        const bool bad = st.run(acc, u, wr, wc, fr, fq, lds, wid, lane) || poison != 0u;
        const float qnan = __builtin_nanf("");
#pragma unroll
        for (int ai = 0; ai < 2; ++ai)
#pragma unroll
            for (int m = 0; m < 4; ++m) { const int r = ai * HALF + wr * 64 + m * 16 + fr; const f32x2v sr = S[r]; const size_t off = (size_t)(u.pm * BM + r) * ldc + col0;
#pragma unroll
                for (int bj = 0; bj < 2; ++bj)
#pragma unroll
                    for (int n = 0; n < 2; ++n) { const f32x4 bs = ai == 0 ? pre[m][bj][n] : *(const f32x4*)(base + off + bj * HALF + n * 16); f32x4 o = bs + (acc[ai][bj][m][n] - sr.x) * sr.y;
                        if (bad) o = (f32x4){qnan, qnan, qnan, qnan}; *(f32x4*)(out + off + bj * HALF + n * 16) = o; }
                if (m & 1) asm volatile("" ::: "memory"); }
    }
};
struct EpiLnResLn {
    static constexpr bool PERM = false, AFTER_DRAIN = true;
    const float* base; float* out; bf16_t* xn; int ldc; const float* bias; PanelStats st1, st2; unsigned poison;
    __device__ __forceinline__ void fused(f32x4 (&acc)[2][2][4][2], const Unit& u, int wr, int wc, int fr, int fq, PG8_LAS unsigned char* lds, int wid, int lane) const {
        typedef float f32x2v __attribute__((ext_vector_type(2))); typedef unsigned u32x2v __attribute__((ext_vector_type(2)));
        const PG8_LAS f32x2v* S = (const PG8_LAS f32x2v*)(lds + 8192);
        const int col0 = u.pn * BM + wc * 32 + 4 * fq;
#pragma unroll
        for (int bj = 0; bj < 2; ++bj)
#pragma unroll
            for (int n = 0; n < 2; ++n) { const f32x4 bv = bias ? *(const f32x4*)(bias + col0 + bj * HALF + n * 16) : (f32x4){0.f, 0.f, 0.f, 0.f};
#pragma unroll
                for (int ai = 0; ai < 2; ++ai)
#pragma unroll
                    for (int m = 0; m < 4; ++m) acc[ai][bj][m][n] += bv; }
        bool bad = st1.run(acc, u, wr, wc, fr, fq, lds, wid, lane) || poison != 0u;
        const float qnan = __builtin_nanf("");
#pragma unroll
        for (int ai = 0; ai < 2; ++ai)
#pragma unroll
            for (int m = 0; m < 4; ++m) { const int r = ai * HALF + wr * 64 + m * 16 + fr; const f32x2v sr = S[r]; const size_t off = (size_t)(u.pm * BM + r) * ldc + col0;
#pragma unroll
                for (int bj = 0; bj < 2; ++bj)
#pragma unroll
                    for (int n = 0; n < 2; ++n) { const f32x4 bs = *(const f32x4*)(base + off + bj * HALF + n * 16); acc[ai][bj][m][n] = bs + (acc[ai][bj][m][n] - sr.x) * sr.y; }
                asm volatile("" : "+v"(acc[ai][0][m][0]), "+v"(acc[ai][0][m][1]), "+v"(acc[ai][1][m][0]), "+v"(acc[ai][1][m][1]));
                if (m & 1) asm volatile("" ::: "memory"); }
        const bool bad1 = bad;
        bad = st2.run(acc, u, wr, wc, fr, fq, lds, wid, lane) || bad;
#pragma unroll
        for (int ai = 0; ai < 2; ++ai)
#pragma unroll
            for (int m = 0; m < 4; ++m) { const int r = ai * HALF + wr * 64 + m * 16 + fr; const f32x2v sr = S[r]; const size_t off = (size_t)(u.pm * BM + r) * ldc + col0;
#pragma unroll
                for (int bj = 0; bj < 2; ++bj)
#pragma unroll
                    for (int n = 0; n < 2; ++n) { const f32x4 x1 = acc[ai][bj][m][n]; *(f32x4*)(out + off + bj * HALF + n * 16) = bad1 ? (f32x4){qnan, qnan, qnan, qnan} : x1;
                        const f32x4 o = (x1 - sr.x) * sr.y; u32x2v w; w.x = cvt_pk_bf16(o[0], o[1]); w.y = cvt_pk_bf16(o[2], o[3]);
                        if (bad) { w.x = 0x7fc07fc0u; w.y = 0x7fc07fc0u; } *(u32x2v*)(xn + off + bj * HALF + n * 16) = w; }
                asm volatile("" ::: "memory"); }
    }
};

template <class Epi, class Sched, bool ALIGN_EPI = false, bool SP2 = false>
__device__ __forceinline__ void gemm_phase(PG8_LAS unsigned char* lds, const Gemm g, const Sched& S, const Epi& E) {
    int tid_ = threadIdx.x; asm volatile("" : "+v"(tid_)); const int tid = tid_, wid = __builtin_amdgcn_readfirstlane(tid >> 6), lane = tid & 63, wr = wid >> 2, wc = wid & 3, fr = lane & 15, fq = lane >> 4;
    const int K = g.K, nt = K / BK;
    unsigned voffA[2], voffB[2];
#pragma unroll
    for (int i = 0; i < 2; ++i) { int R, C; stage_rc(tid * 16 + i * 8192, R, C); const int Rb = Epi::PERM ? ((R & ~31) + perm32(R & 31)) : R;
        voffA[i] = (unsigned)(R * K + C) * 2u; voffB[i] = (unsigned)(Rb * K + C) * 2u; }
    const size_t kstep = (size_t)(BK * 2);
    const size_t hstep = (size_t)HALF * K * 2;
    const size_t tstep = 2 * hstep;
    const unsigned ldsw = (unsigned)wid * 1024u;
    const int aoff = lds_byte(wr * 64 + fr, fq * 8), boff = lds_byte(wc * 32 + fr, fq * 8);
#define PG8_SA(b, h) (((b) * 2 + (h)) * HTB)
#define PG8_SB(b, h) ((4 + (b) * 2 + (h)) * HTB)
#define PG8_STAGE_X(bufoff, gbase, voff, aux) do { _Pragma("unroll") for (int _i = 0; _i < 2; ++_i) \
        __builtin_amdgcn_global_load_lds((const unsigned*)((const char*)(gbase) + (voff)[_i]), (PG8_LAS unsigned*)(lds + (bufoff) + ldsw + _i * 8192), 16, 0, aux); } while (0)
#define PG8_STAGE(bufoff, gbase, voff) PG8_STAGE_X(bufoff, gbase, voff, 0)
#define PG8_STAGE_A(bufoff, gbase, voff) PG8_STAGE_X(bufoff, gbase, voff, PG8_A_AUX)
#define PG8_LDA(dst, b, h) do { _Pragma("unroll") for (int m = 0; m < 4; ++m) _Pragma("unroll") for (int k = 0; k < 2; ++k) dst[m][k] = *(const PG8_LAS bf16x8*)(lds + PG8_SA(b, h) + aoff + m * 2048 + k * 1024); } while (0)
#define PG8_LDB(dst, b, h) do { _Pragma("unroll") for (int n = 0; n < 2; ++n) _Pragma("unroll") for (int k = 0; k < 2; ++k) dst[n][k] = *(const PG8_LAS bf16x8*)(lds + PG8_SB(b, h) + boff + n * 2048 + k * 1024); } while (0)
#define PG8_MMA(ai, bj, At, Bt) do { __builtin_amdgcn_s_setprio(1); _Pragma("unroll") for (int m = 0; m < 4; ++m) _Pragma("unroll") for (int n = 0; n < 2; ++n) _Pragma("unroll") for (int k = 0; k < 2; ++k) \
        acc[ai][bj][m][n] = __builtin_amdgcn_mfma_f32_16x16x32_bf16(Bt[n][k], At[m][k], acc[ai][bj][m][n], 0, 0, 0); __builtin_amdgcn_s_setprio(0); } while (0)
#define PG8_WAIT_V(n) asm volatile("s_waitcnt vmcnt(" #n ")" ::: "memory")
#define PG8_WAIT_L(n) asm volatile("s_waitcnt lgkmcnt(" #n ")" ::: "memory")
#define PG8_BAR __builtin_amdgcn_s_barrier()
#define PG8_SCHED __builtin_amdgcn_sched_barrier(0)
    Unit cur, nxt; int ui = 0;
    if (!S.next(0, cur)) return;
    f32x4 acc[2][2][4][2];
#pragma unroll
    for (int a = 0; a < 2; ++a)
#pragma unroll
        for (int b = 0; b < 2; ++b)
#pragma unroll
            for (int m = 0; m < 4; ++m)
#pragma unroll
                for (int n = 0; n < 2; ++n) acc[a][b][m][n] = (f32x4){0.f, 0.f, 0.f, 0.f};
    bf16x8 At[4][2], B0[2][2], B1[2][2];
    const char* cA = (const char*)g.A + (size_t)cur.pm * tstep; const char* cB = (const char*)g.Bt + (size_t)cur.pn * tstep;
    S.a_ready(cur);
    if constexpr (SP2) {
        PG8_STAGE(PG8_SB(0, 0), cB, voffB); PG8_STAGE(PG8_SB(0, 1), cB + hstep, voffB); PG8_STAGE_A(PG8_SA(0, 0), cA, voffA); PG8_STAGE_A(PG8_SA(0, 1), cA + hstep, voffA);
        if (wr == 1) PG8_BAR;
        PG8_WAIT_V(2); PG8_BAR;
        PG8_STAGE(PG8_SB(1, 0), cB + kstep, voffB); PG8_STAGE_A(PG8_SA(1, 0), cA + kstep, voffA); PG8_STAGE(PG8_SB(1, 1), cB + hstep + kstep, voffB);
        PG8_WAIT_V(6); PG8_BAR;
    } else {
        PG8_STAGE(PG8_SB(0, 0), cB, voffB); PG8_STAGE_A(PG8_SA(0, 0), cA, voffA); PG8_STAGE(PG8_SB(0, 1), cB + hstep, voffB); PG8_STAGE_A(PG8_SA(0, 1), cA + hstep, voffA);
        if (wr == 1) PG8_BAR;
        PG8_WAIT_V(4); PG8_BAR;
        PG8_STAGE(PG8_SB(1, 0), cB + kstep, voffB); PG8_STAGE_A(PG8_SA(1, 0), cA + kstep, voffA); PG8_STAGE(PG8_SB(1, 1), cB + hstep + kstep, voffB);
        PG8_WAIT_V(6); PG8_BAR;
    }
    for (;;) {
        const bool has_next = S.next(ui + 1, nxt);
        const char* nA = has_next ? (const char*)g.A + (size_t)nxt.pm * tstep : cA; const char* nB = has_next ? (const char*)g.Bt + (size_t)nxt.pn * tstep : cB;
        for (int t = 0; t < nt; t += 2) {
            const bool last = (t == nt - 2);
            const char* a1 = cA + (size_t)(t + 1) * kstep;
            const char* a2 = last ? nA : cA + (size_t)(t + 2) * kstep; const char* b2 = last ? nB : cB + (size_t)(t + 2) * kstep;
            const char* a3 = a2 + kstep; const char* b3 = b2 + kstep;
            if (last && has_next) S.a_ready(nxt);
            if constexpr (SP2) {
            PG8_LDB(B0, 0, 0); PG8_LDB(B1, 0, 1); PG8_SCHED; PG8_LDA(At, 0, 0); PG8_STAGE_A(PG8_SA(1, 1), a1 + hstep, voffA);
            PG8_WAIT_V(8); PG8_WAIT_L(0); PG8_BAR; PG8_MMA(0, 0, At, B0); PG8_MMA(0, 1, At, B1); PG8_BAR; PG8_SCHED;
            PG8_LDA(At, 0, 1); PG8_STAGE(PG8_SB(0, 0), b2, voffB); PG8_STAGE(PG8_SB(0, 1), b2 + hstep, voffB); PG8_STAGE_A(PG8_SA(0, 0), a2, voffA);
            PG8_WAIT_V(8); PG8_WAIT_L(0); PG8_BAR; PG8_MMA(1, 0, At, B0); PG8_MMA(1, 1, At, B1); PG8_BAR; PG8_SCHED;
            PG8_LDB(B0, 1, 0); PG8_LDB(B1, 1, 1); PG8_SCHED; PG8_LDA(At, 1, 0); PG8_STAGE_A(PG8_SA(0, 1), a2 + hstep, voffA);
            PG8_WAIT_V(8); PG8_WAIT_L(0); PG8_BAR; PG8_MMA(0, 0, At, B0); PG8_MMA(0, 1, At, B1); PG8_BAR; PG8_SCHED;
            PG8_LDA(At, 1, 1); PG8_STAGE(PG8_SB(1, 0), b3, voffB); PG8_STAGE(PG8_SB(1, 1), b3 + hstep, voffB); PG8_STAGE_A(PG8_SA(1, 0), a3, voffA);
            PG8_WAIT_V(8); PG8_WAIT_L(0); PG8_BAR; PG8_MMA(1, 0, At, B0); PG8_MMA(1, 1, At, B1); PG8_BAR; PG8_SCHED;
            } else {
            PG8_LDB(B0, 0, 0); PG8_SCHED; PG8_LDA(At, 0, 0); PG8_STAGE_A(PG8_SA(1, 1), a1 + hstep, voffA);
            PG8_WAIT_L(8); PG8_BAR; PG8_WAIT_L(0); PG8_MMA(0, 0, At, B0); PG8_BAR; PG8_SCHED;
            PG8_LDB(B1, 0, 1); PG8_STAGE(PG8_SB(0, 0), b2, voffB);
            PG8_BAR; PG8_WAIT_L(0); PG8_MMA(0, 1, At, B1); PG8_BAR;
            PG8_LDA(At, 0, 1); PG8_STAGE_A(PG8_SA(0, 0), a2, voffA);
            PG8_BAR; PG8_WAIT_L(0); PG8_MMA(1, 0, At, B0); PG8_BAR; PG8_SCHED;
            PG8_STAGE(PG8_SB(0, 1), b2 + hstep, voffB);
            PG8_WAIT_V(6); PG8_BAR; PG8_MMA(1, 1, At, B1); PG8_BAR;
            PG8_LDB(B0, 1, 0); PG8_SCHED; PG8_LDA(At, 1, 0); PG8_STAGE_A(PG8_SA(0, 1), a2 + hstep, voffA);
            PG8_WAIT_L(8); PG8_BAR; PG8_WAIT_L(0); PG8_MMA(0, 0, At, B0); PG8_BAR; PG8_SCHED;
            PG8_LDB(B1, 1, 1); PG8_STAGE(PG8_SB(1, 0), b3, voffB);
            PG8_BAR; PG8_WAIT_L(0); PG8_MMA(0, 1, At, B1); PG8_BAR;
            PG8_LDA(At, 1, 1); PG8_STAGE_A(PG8_SA(1, 0), a3, voffA);
            PG8_BAR; PG8_WAIT_L(0); PG8_MMA(1, 0, At, B0); PG8_BAR; PG8_SCHED;
            PG8_STAGE(PG8_SB(1, 1), b3 + hstep, voffB);
            PG8_WAIT_V(6); PG8_BAR; PG8_MMA(1, 1, At, B1); PG8_BAR;
            }
        }
        if constexpr (ALIGN_EPI) { if (wr == 0) PG8_BAR; }
        if constexpr (!Epi::AFTER_DRAIN) { E(acc, cur, wr, wc, fr, fq); S.done(cur); }
        if (!has_next) break;
#pragma unroll
        for (int a = 0; a < 2; ++a)
#pragma unroll
            for (int b = 0; b < 2; ++b)
#pragma unroll
                for (int m = 0; m < 4; ++m)
#pragma unroll
                    for (int n = 0; n < 2; ++n) acc[a][b][m][n] = (f32x4){0.f, 0.f, 0.f, 0.f};
        cur = nxt; cA = nA; cB = nB; ++ui;
        if constexpr (ALIGN_EPI) { if (wr == 1) PG8_BAR; }
    }
    PG8_WAIT_V(0);
    if constexpr (!ALIGN_EPI) { if (wr == 0) PG8_BAR; }
    PG8_BAR;
    if constexpr (Epi::AFTER_DRAIN) { E.fused(acc, cur, wr, wc, fr, fq, lds, wid, lane); S.done(cur); }
#undef PG8_SA
#undef PG8_SB
#undef PG8_STAGE
#undef PG8_STAGE_A
#undef PG8_STAGE_X
#undef PG8_LDA
#undef PG8_LDB
#undef PG8_MMA
#undef PG8_WAIT_V
#undef PG8_WAIT_L
#undef PG8_BAR
#undef PG8_SCHED
}
}

#ifndef SCALE_MIX
#define SCALE_MIX 1.0f
#endif
#ifndef SCALE_FFN
#define SCALE_FFN 1.0f
#endif
namespace mk {
#ifdef ZERO_SSD
constexpr float ZS = 0.f;
#elif defined(SC_SSD)
constexpr float ZS = SC_SSD;
#else
constexpr float ZS = 1.f;
#endif
#ifdef ZERO_FOX
constexpr float ZF = 0.f;
#elif defined(SC_FOX)
constexpr float ZF = SC_FOX;
#else
constexpr float ZF = 1.f;
#endif
#ifdef ZERO_SC
constexpr float ZC = 0.f;
#elif defined(SC_SC)
constexpr float ZC = SC_SC;
#else
constexpr float ZC = 1.f;
#endif
using pg8::bf16_t; using pg8::bf16x8; using pg8::f32x4; using pg8::u32x4;
typedef unsigned u32x2 __attribute__((ext_vector_type(2)));
constexpr int DM = 1024, BATCH = 4, SEQ = 4096, MROWS = BATCH * SEQ, DFF = 2816, NFF = 2 * DFF, NPROJ = 3072, NMOD = 9216;
constexpr int NT = 512, NW = 8;
constexpr float ALPHA = 1.4142135623730951f, LN_EPS = 1e-5f, RMS_EPS = 1e-5f, LOG2E = 1.4426950408889634f;
constexpr int PC_Z = 0, PC_XBC = 512, PC_Q = 1536, PC_K = 1792, PC_V = 2048, PC_SB = 2304, PC_SC = 2560, PC_SX = 2816;
constexpr size_t MiB = 1u << 20;
constexpr size_t WS_MOD = 0, WS_WMISC = 1 * MiB, WS_DTF = 2 * MiB, WS_CDEC = 3 * MiB, WS_BAR = 3 * MiB + 512 * 1024, WS_W = 4 * MiB;
constexpr size_t W_L = 41 * MiB;
constexpr size_t WO_1IN = 0, WO_1OUT = 11 * MiB, WO_MI = 11 * MiB + 5632 * 1024, WO_MO = WO_MI + 6 * MiB, WO_2IN = WO_MO + 2 * MiB, WO_2OUT = WO_2IN + 11 * MiB;
static_assert(WO_2OUT + 5632 * 1024 == W_L, "weight map");
constexpr size_t WS_HB = WS_W + 2 * W_L;
constexpr size_t WS_BIG = WS_HB + 32 * MiB;
constexpr size_t WS_YCAT = WS_BIG + 96 * MiB;
constexpr size_t WS_ST = WS_YCAT + 32 * MiB;
constexpr size_t WS_VT = WS_ST + 32 * MiB;
constexpr size_t WS_END = WS_VT + 8 * MiB;
constexpr int LDS_BYTES = 147456;

struct Args { const float* in[22]; float* out; unsigned char* ws; };
typedef const __attribute__((address_space(4))) Args* CArgsP;
__device__ __forceinline__ CArgsP get_args() { CArgsP p = (CArgsP)__builtin_amdgcn_kernarg_segment_ptr(); asm volatile("" : "+s"(p)); return p; }

typedef float f32x2_t __attribute__((ext_vector_type(2))); typedef __bf16 bf16x2_t __attribute__((ext_vector_type(2)));
__device__ __forceinline__ float bf_lo(unsigned w) { return __uint_as_float(w << 16); }
__device__ __forceinline__ float bf_hi(unsigned w) { return __uint_as_float(w & 0xffff0000u); }
__device__ __forceinline__ float bf2f(bf16_t v) { return __uint_as_float((unsigned)v << 16); }
#ifdef DEGRADE_BF16
__device__ __forceinline__ unsigned pk2(float lo, float hi) { return DEGRADE_OP(pg8::cvt_pk_bf16(lo, hi)); }
#elif defined(MANUAL_RNE)
__device__ __forceinline__ unsigned f2bf_rne_(float f) { unsigned u = __builtin_bit_cast(unsigned, f); return (u + 0x7fffu + ((u >> 16) & 1u)) >> 16; }
__device__ __forceinline__ unsigned pk2(float lo, float hi) { return f2bf_rne_(lo) | (f2bf_rne_(hi) << 16); }
#else
__device__ __forceinline__ unsigned pk2(float lo, float hi) { return pg8::cvt_pk_bf16(lo, hi); }
#endif
#ifdef DEGRADE_W
__device__ __forceinline__ unsigned pk2w(float lo, float hi) { return pg8::cvt_pk_bf16(lo, hi) & 0xFFFEFFFEu; }
#else
__device__ __forceinline__ unsigned pk2w(float lo, float hi) { return pg8::cvt_pk_bf16(lo, hi); }
#endif
__device__ __forceinline__ bf16_t f2bf(float f) { return (bf16_t)(pk2(f, 0.f) & 0xffffu); }
#ifndef DEG_SITES
#define DEG_SITES 0
#endif
template <int S> __device__ __forceinline__ unsigned pk2t(float lo, float hi) { unsigned r; if constexpr (S >= 2) { f32x2_t v_ = {lo, hi}; r = __builtin_bit_cast(unsigned, __builtin_convertvector(v_, bf16x2_t)); } else r = pg8::cvt_pk_bf16(lo, hi); if ((DEG_SITES >> S) & 1) r &= 0xFFFEFFFEu; return r; }
template <int S> __device__ __forceinline__ bf16_t f2bft(float f) { return (bf16_t)(pk2t<S>(f, 0.f) & 0xffffu); }
__device__ __forceinline__ float siluf(float v) { return v * __builtin_amdgcn_rcpf(1.f + __builtin_amdgcn_exp2f(-v * LOG2E)); }
__device__ __forceinline__ float wave_sum(float v) {
#pragma unroll
    for (int o = 1; o < 64; o <<= 1) v += __shfl_xor(v, o);
    return v;
}
__device__ __forceinline__ float wave_incl_scan(float v, int lane) {
#pragma unroll
    for (int o = 1; o < 64; o <<= 1) { const float t = __shfl_up(v, o); if (lane >= o) v += t; }
    return v;
}
__device__ __forceinline__ void unpack8(const u32x4 r, float (&f)[8]) {
    f[0] = bf_lo(r.x); f[1] = bf_hi(r.x); f[2] = bf_lo(r.y); f[3] = bf_hi(r.y); f[4] = bf_lo(r.z); f[5] = bf_hi(r.z); f[6] = bf_lo(r.w); f[7] = bf_hi(r.w);
}
template <class T> __device__ __forceinline__ T ldx(const T* p) {
    if constexpr (sizeof(T) == 16) { const unsigned long long* q = (const unsigned long long*)p; struct { unsigned long long a, b; } r;
        r.a = __hip_atomic_load(q, __ATOMIC_RELAXED, __HIP_MEMORY_SCOPE_AGENT); r.b = __hip_atomic_load(q + 1, __ATOMIC_RELAXED, __HIP_MEMORY_SCOPE_AGENT); return __builtin_bit_cast(T, r); }
    else if constexpr (sizeof(T) == 4) { const unsigned v = __hip_atomic_load((const unsigned*)p, __ATOMIC_RELAXED, __HIP_MEMORY_SCOPE_AGENT); return __builtin_bit_cast(T, v); }
    else { static_assert(sizeof(T) == 2, "ldx"); const unsigned short v = __hip_atomic_load((const unsigned short*)p, __ATOMIC_RELAXED, __HIP_MEMORY_SCOPE_AGENT); return __builtin_bit_cast(T, v); }
}
template <class T> __device__ __forceinline__ T ldxb(const void* ubase, unsigned off) {
    static_assert(sizeof(T) == 16, "ldxb");
    __amdgpu_buffer_rsrc_t r = __builtin_amdgcn_make_buffer_rsrc(const_cast<void*>(ubase), 0, 0x7fffffff, 0x00020000);
    return __builtin_bit_cast(T, __builtin_amdgcn_raw_buffer_load_b128(r, off, 0, 16));
}
#define LDS_WAIT() asm volatile("s_waitcnt lgkmcnt(0)" ::: "memory")

__device__ __forceinline__ int srcmap(int mode, int r0) {
    if (mode == 1) { const int pn = r0 >> 8, j = r0 & 255; return j < 128 ? pn * 128 + j : DFF + pn * 128 + (j - 128); }
    if (mode == 2) { return r0 < 1536 ? r0 : (r0 < 2304 ? r0 + 8 : r0 + 12); }
    return r0;
}
__device__ __forceinline__ void p0_item(const float* __restrict__ W, int K, int Nsrc, int Ndst, bf16_t* __restrict__ WT, int mode, float* scr, int item, int lane) {
    const int nblk = Ndst / 64, kb = item / nblk, nb = item % nblk, k0 = 64 * kb, r0 = 64 * nb, s0 = srcmap(mode, r0);
    f32x4 v[16];
#pragma unroll
    for (int i = 0; i < 16; ++i) v[i] = *(const f32x4*)(W + (size_t)(k0 + 4 * i + (lane >> 4)) * Nsrc + s0 + 4 * (lane & 15));
#pragma unroll
    for (int i = 0; i < 16; ++i) { float* d = scr + (4 * i + (lane >> 4)) * 65 + 4 * (lane & 15); d[0] = v[i].x; d[1] = v[i].y; d[2] = v[i].z; d[3] = v[i].w; }
    LDS_WAIT();
    const int c = lane & 7;
#pragma unroll
    for (int j = 0; j < 8; ++j) { const int n = (lane >> 3) + 8 * j; const float* s = scr + (8 * c) * 65 + n;
        u32x4 o; o.x = pk2w(s[0 * 65], s[1 * 65]); o.y = pk2w(s[2 * 65], s[3 * 65]); o.z = pk2w(s[4 * 65], s[5 * 65]); o.w = pk2w(s[6 * 65], s[7 * 65]);
        *(u32x4*)(WT + (size_t)(r0 + n) * K + k0 + 8 * c) = o; }
    LDS_WAIT();
}
__device__ __forceinline__ void phase_p0(CArgsP a, unsigned char* lds, int tid, int wave, int lane, int parts = 3) {
    float* mod = (float*)(a->ws + WS_MOD);
    float* sc = (float*)(lds + 69632);
    float* red = (float*)(lds + 69632 + 16384);
    for (int i = tid; i < 4096; i += NT) { const float v = a->in[1][i]; sc[i] = v / (1.f + expf(-v)); }
    __syncthreads();
    for (int v = blockIdx.x; v < ((parts & 1) ? 256 : 0); v += gridDim.x) {
        const int l = v >> 7, col0 = (v & 127) * 72, kk = lane / 18, c4 = lane - kk * 18, k0 = wave * 128;
        const float* Wp = a->in[4] + (size_t)l * DM * NMOD + col0 + 4 * c4;
        f32x4 acc[4];
#pragma unroll
        for (int bb = 0; bb < 4; ++bb) acc[bb] = (f32x4){0.f, 0.f, 0.f, 0.f};
        if (lane < 54) {
#pragma unroll 8
            for (int i = 0; i < 43; ++i) { const int k = k0 + 3 * i + kk;
                if (3 * i + kk < 128) { const f32x4 w = *(const f32x4*)(Wp + (size_t)k * NMOD);
#pragma unroll
                    for (int bb = 0; bb < 4; ++bb) acc[bb] += w * sc[bb * 1024 + k]; } }
#pragma unroll
            for (int bb = 0; bb < 4; ++bb) *(f32x4*)(red + ((wave * 3 + kk) * 4 + bb) * 72 + 4 * c4) = acc[bb];
        }
        __syncthreads();
        if (tid < 288) { const int bb = tid / 72, cc = tid - bb * 72; float s = 0.f;
#pragma unroll
            for (int p = 0; p < 24; ++p) s += red[(p * 4 + bb) * 72 + cc];
            mod[(size_t)(l * 4 + bb) * NMOD + col0 + cc] = s + a->in[5][l * NMOD + col0 + cc]; }
        __syncthreads();
    }
    { float* wm = (float*)(a->ws + WS_WMISC);
      for (int i = blockIdx.x * NT + tid; i < 2 * 12 * 1024; i += gridDim.x * NT) { const int l = i / 12288, r = i % 12288, j = r / 1024, k = r % 1024;
          const int colj = j < 8 ? 1536 + j : 2312 + (j - 8); wm[i] = a->in[8][(size_t)l * DM * 3084 + (size_t)k * 3084 + colj]; } }
    float* scr = (float*)(lds + wave * 16640);
    const int gw = blockIdx.x * NW + wave, NGW = gridDim.x * NW;
    constexpr int I_IN = 16 * (NFF / 64), I_OUT = (DFF / 64) * 16, I_MI = 16 * (NPROJ / 64), I_MO = 16 * 16, I_L = 2 * I_IN + 2 * I_OUT + I_MI + I_MO;
    for (int it = gw; it < ((parts & 2) ? 2 * I_L : 0); it += NGW) {
        const int l = it / I_L; int r = it % I_L; unsigned char* wl = a->ws + WS_W + l * W_L;
        if (r < I_IN) { p0_item(a->in[6] + (size_t)l * DM * NFF, DM, NFF, NFF, (bf16_t*)(wl + WO_1IN), 1, scr, r, lane); continue; } r -= I_IN;
        if (r < I_IN) { p0_item(a->in[18] + (size_t)l * DM * NFF, DM, NFF, NFF, (bf16_t*)(wl + WO_2IN), 1, scr, r, lane); continue; } r -= I_IN;
        if (r < I_OUT) { p0_item(a->in[7] + (size_t)l * DFF * DM, DFF, DM, DM, (bf16_t*)(wl + WO_1OUT), 0, scr, r, lane); continue; } r -= I_OUT;
        if (r < I_OUT) { p0_item(a->in[19] + (size_t)l * DFF * DM, DFF, DM, DM, (bf16_t*)(wl + WO_2OUT), 0, scr, r, lane); continue; } r -= I_OUT;
        if (r < I_MI) { p0_item(a->in[8] + (size_t)l * DM * 3084, DM, 3084, NPROJ, (bf16_t*)(wl + WO_MI), 2, scr, r, lane); continue; } r -= I_MI;
        p0_item(a->in[9] + (size_t)l * DM * DM, DM, DM, DM, (bf16_t*)(wl + WO_MO), 0, scr, r, lane);
    }
}

template <bool MISC>
__device__ __forceinline__ void phase_ln(const float* src, float* X, bf16_t* Hb, const float* gamma, const float* beta, const float* modl, int sub, bool write_h,
                                         const float* wm, float* DTF, unsigned char* lds, int tid, int wave, int lane) {
    float* wml = (float*)lds;
    if (MISC) { for (int i = tid; i < 12288; i += NT) wml[i] = wm[i]; __syncthreads(); }
    const int gw = blockIdx.x * NW + wave, NGW = gridDim.x * NW;
    f32x4 g4[4], b4[4];
#pragma unroll
    for (int j = 0; j < 4; ++j) { g4[j] = *(const f32x4*)(gamma + 4 * lane + 256 * j); b4[j] = *(const f32x4*)(beta + 4 * lane + 256 * j); }
    for (int blk = gw; blk < MROWS / 8; blk += NGW) {
        const int m0 = blk * 8, b = m0 / SEQ;
        const float* shp = modl + (size_t)b * NMOD + (sub * 3 + 0) * DM; const float* scp = modl + (size_t)b * NMOD + (sub * 3 + 1) * DM;
        f32x4 sh4[4], sc4[4];
#pragma unroll
        for (int j = 0; j < 4; ++j) { if (write_h) { sh4[j] = *(const f32x4*)(shp + 4 * lane + 256 * j); sc4[j] = *(const f32x4*)(scp + 4 * lane + 256 * j) + 1.0f; } else { sh4[j] = (f32x4){0.f, 0.f, 0.f, 0.f}; sc4[j] = sh4[j]; } }
#pragma unroll 2
        for (int i = 0; i < 8; ++i) {
            const size_t m = (size_t)(m0 + i);
            f32x4 v[4]; float s = 0.f;
#pragma unroll
            for (int j = 0; j < 4; ++j) { v[j] = ldxb<f32x4>(src, (unsigned)((m * DM + 4 * lane + 256 * j) * 4)); s += (v[j].x + v[j].y) + (v[j].z + v[j].w); }
            const float mean = wave_sum(s) * (1.f / DM); float s2 = 0.f;
#pragma unroll
            for (int j = 0; j < 4; ++j) { v[j] = v[j] - mean; s2 += (v[j].x * v[j].x + v[j].y * v[j].y) + (v[j].z * v[j].z + v[j].w * v[j].w); }
            const float rstd = 1.f / sqrtf(wave_sum(s2) * (1.f / DM) + LN_EPS);
#pragma unroll
            for (int j = 0; j < 4; ++j) { v[j] = v[j] * rstd * g4[j] + b4[j]; *(f32x4*)(X + m * DM + 4 * lane + 256 * j) = v[j]; }
            if (write_h) {
#pragma unroll
                for (int j = 0; j < 4; ++j) { v[j] = v[j] * sc4[j] + sh4[j]; u32x2 w; w.x = pk2t<0>(v[j].x, v[j].y); w.y = pk2t<0>(v[j].z, v[j].w); *(u32x2*)(Hb + m * DM + 4 * lane + 256 * j) = w; }
                if (MISC) {
                    float keep = 0.f;
#pragma unroll
                    for (int jj = 0; jj < 12; ++jj) { float d = 0.f;
#pragma unroll
                        for (int j = 0; j < 4; ++j) { const f32x4 w4 = *(const f32x4*)(wml + jj * 1024 + 4 * lane + 256 * j); d += (v[j].x * w4.x + v[j].y * w4.y) + (v[j].z * w4.z + v[j].w * w4.w); }
                        d = wave_sum(d); if (lane == jj) keep = d; }
                    if (lane < 12) DTF[m * 12 + lane] = keep;
                }
            }
        }
    }
}

struct EpiMulti {
    static constexpr bool PERM = true, AFTER_DRAIN = false;
    int code;
    __device__ __forceinline__ void operator()(const f32x4 (&acc)[2][2][4][2], const pg8::Unit& u, int wr, int wc, int fr, int fq) const {
        CArgsP a = get_args(); int cd = code; asm volatile("" : "+s"(cd)); const int s = cd & 255, l = cd >> 8;
        unsigned char* ws = a->ws;
        if (s == 0 || s == 9) {
            bf16_t* O = (bf16_t*)(ws + WS_BIG);
            const int row0 = u.pm * 256 + wr * 64 + fr, col0 = u.pn * 128 + wc * 32 + 8 * fq;
#pragma unroll
            for (int ai = 0; ai < 2; ++ai)
#pragma unroll
                for (int m = 0; m < 4; ++m) {
                    const f32x4 g0 = acc[ai][0][m][0], g1 = acc[ai][0][m][1], u0 = acc[ai][1][m][0], u1 = acc[ai][1][m][1];
                    u32x4 w;
                    w.x = pk2t<1>(siluf(g0[0]) * u0[0], siluf(g0[1]) * u0[1]); w.y = pk2t<1>(siluf(g0[2]) * u0[2], siluf(g0[3]) * u0[3]);
                    w.z = pk2t<1>(siluf(g1[0]) * u1[0], siluf(g1[1]) * u1[1]); w.w = pk2t<1>(siluf(g1[2]) * u1[2], siluf(g1[3]) * u1[3]);
                    *(u32x4*)(O + (size_t)(row0 + ai * 128 + m * 16) * DFF + col0) = w;
                }
        } else if (s == 3) {
            bf16_t* O = (bf16_t*)(ws + WS_BIG);
            const int row0 = u.pm * 256 + wr * 64 + fr, col0 = u.pn * 256 + wc * 32 + 8 * fq;
#pragma unroll
            for (int ai = 0; ai < 2; ++ai)
#pragma unroll
                for (int m = 0; m < 4; ++m)
#pragma unroll
                    for (int bj = 0; bj < 2; ++bj) { const f32x4 v0 = acc[ai][bj][m][0], v1 = acc[ai][bj][m][1];
                        u32x4 w; w.x = pk2t<1>(v0[0], v0[1]); w.y = pk2t<1>(v0[2], v0[3]); w.z = pk2t<1>(v1[0], v1[1]); w.w = pk2t<1>(v1[2], v1[3]);
                        *(u32x4*)(O + (size_t)(row0 + ai * 128 + m * 16) * NPROJ + col0 + bj * 128) = w; }
        } else {
            const int sub = s == 1 ? 0 : (s == 7 ? 1 : 2);
#ifdef ZERO_FFN
            const float coef = s == 7 ? 1.0f : 0.0f;
#elif defined(ZERO_MIX)
            const float coef = s == 7 ? 0.0f : 0.5f;
#else
            const float coef = s == 7 ? 1.0f * SCALE_MIX : 0.5f * SCALE_FFN;
#endif
            float* X = a->out; const float* gate = (const float*)(ws + WS_MOD) + (size_t)l * 4 * NMOD + (sub * 3 + 2) * DM;
            const int b = u.pm >> 4, col0 = u.pn * 256 + wc * 32 + 8 * fq;
#pragma unroll
            for (int bj = 0; bj < 2; ++bj)
#pragma unroll
                for (int n = 0; n < 2; ++n) {
                    const int c = col0 + bj * 128 + n * 4;
                    const f32x4 gv = *(const f32x4*)(gate + (size_t)b * NMOD + c) * coef;
#pragma unroll
                    for (int ai = 0; ai < 2; ++ai)
#pragma unroll
                        for (int m = 0; m < 4; ++m) { float* p = X + (size_t)(u.pm * 256 + ai * 128 + wr * 64 + m * 16 + fr) * DM + c;
                            const f32x4 xv = ldxb<f32x4>(X, (unsigned)((size_t)(p - X) * 4));
#ifdef SKIP_T
                            const int rr_ = (u.pm * 256 + ai * 128 + wr * 64 + m * 16 + fr) & 4095; const float km_ = (s == 7 && rr_ >= SKIP_T0 && rr_ < SKIP_T) ? 0.f : 1.f;
                            *(f32x4*)p = xv * ALPHA + gv * acc[ai][bj][m][n] * km_; }
#else
                            *(f32x4*)p = xv * ALPHA + gv * acc[ai][bj][m][n]; }
#endif
                }
        }
    }
};

__device__ __forceinline__ void ssd_dt_acs(const float* DTF, const float* dt_bias, const float* a_log, int R0, int g, int wave, int lane, float* sDt, float* sAcs) {
    if (wave < 4) { const int h = g * 4 + wave; const float x = ldx(DTF + (size_t)(R0 + lane) * 12 + h) + dt_bias[h];
        const float dt = x > 20.f ? x : log1pf(expf(x)); const float av = -expf(a_log[h]) * dt; const float cs = wave_incl_scan(av, lane);
        sDt[wave * 64 + lane] = dt; sAcs[wave * 64 + lane] = cs; }
}
__device__ __forceinline__ void conv8(const bf16_t* PROJ, int b, int t, int cc, const float* cw, const float* cb, float (&o)[8]) {
    { const f32x4 b0 = *(const f32x4*)(cb + cc), b1 = *(const f32x4*)(cb + cc + 4); o[0] = b0.x; o[1] = b0.y; o[2] = b0.z; o[3] = b0.w; o[4] = b1.x; o[5] = b1.y; o[6] = b1.z; o[7] = b1.w; }
#pragma unroll
    for (int k = 0; k < 4; ++k) { const int tt = t - 3 + k;
        if (tt >= 0) { const u32x4 raw = ldxb<u32x4>(PROJ, (unsigned)(((size_t)(b * SEQ + tt) * NPROJ + PC_XBC + cc) * 2)); float x[8]; unpack8(raw, x);
            const f32x4 w0 = *(const f32x4*)(cw + k * 1024 + cc), w1 = *(const f32x4*)(cw + k * 1024 + cc + 4);
            o[0] += w0.x * x[0]; o[1] += w0.y * x[1]; o[2] += w0.z * x[2]; o[3] += w0.w * x[3]; o[4] += w1.x * x[4]; o[5] += w1.y * x[5]; o[6] += w1.z * x[6]; o[7] += w1.w * x[7]; } }
#pragma unroll
    for (int j = 0; j < 8; ++j) o[j] = siluf(o[j]);
}

template <int NR>
__device__ __forceinline__ void conv_rows(const bf16_t* PROJ, int b, int t, int cc, const float* cw, const float* cb, float (&o)[NR][8]) {
    float w[4][8], x[NR + 3][8];
#pragma unroll
    for (int k = 0; k < 4; ++k) { const f32x4 w0 = *(const f32x4*)(cw + k * 1024 + cc), w1 = *(const f32x4*)(cw + k * 1024 + cc + 4);
        w[k][0] = w0.x; w[k][1] = w0.y; w[k][2] = w0.z; w[k][3] = w0.w; w[k][4] = w1.x; w[k][5] = w1.y; w[k][6] = w1.z; w[k][7] = w1.w; }
    const f32x4 b0 = *(const f32x4*)(cb + cc), b1 = *(const f32x4*)(cb + cc + 4);
    const float bs[8] = {b0.x, b0.y, b0.z, b0.w, b1.x, b1.y, b1.z, b1.w};
#pragma unroll
    for (int i = 0; i < NR + 3; ++i) { const int tt = t - 3 + i;
        if (tt >= 0) unpack8(ldxb<u32x4>(PROJ, (unsigned)(((size_t)(b * SEQ + tt) * NPROJ + PC_XBC + cc) * 2)), x[i]);
        else {
#pragma unroll
            for (int j = 0; j < 8; ++j) x[i][j] = 0.f; } }
#pragma unroll
    for (int r = 0; r < NR; ++r)
#pragma unroll
        for (int j = 0; j < 8; ++j) o[r][j] = siluf(bs[j] + w[0][j] * x[r][j] + w[1][j] * x[r + 1][j] + w[2][j] * x[r + 2][j] + w[3][j] * x[r + 3][j]);
}

__device__ __forceinline__ void phase_ma(CArgsP a, int l, unsigned char* lds, int tid, int wave, int lane) {
    const bf16_t* PROJ = (const bf16_t*)(a->ws + WS_BIG); bf16_t* YCAT = (bf16_t*)(a->ws + WS_YCAT); bf16_t* ST = (bf16_t*)(a->ws + WS_ST);
    const float* DTF = (const float*)(a->ws + WS_DTF); float* CDEC = (float*)(a->ws + WS_CDEC);
    const float* cw = a->in[10] + (size_t)l * 4 * 1024; const float* cb = a->in[11] + l * 1024; const float* dtb = a->in[12] + l * 8; const float* alog = a->in[13] + l * 8;
    const int fr = lane & 15, fq = lane >> 4;
    bf16_t* sBT = (bf16_t*)lds;
    bf16_t* sXT = (bf16_t*)(lds + 18432);
    float* sDt = (float*)(lds + 18432 + 36864);
    float* sAcs = sDt + 256;
    for (int it = blockIdx.x; it < 512; it += gridDim.x) {
        const int b = it >> 7, c = (it >> 1) & 63, g = it & 1, t0 = c * 64, R0 = b * SEQ + t0;
        ssd_dt_acs(DTF, dtb, alog, R0, g, wave, lane, sDt, sAcs);
        __syncthreads();
        if (wave < 4 && lane == 63) CDEC[(b * 64 + c) * 8 + g * 4 + wave] = expf(sAcs[wave * 64 + 63]);
        {
          { const int n = (tid & 15) * 8, l0 = (tid >> 4) * 2; float v[2][8]; conv_rows<2>(PROJ, b, t0 + l0, 512 + g * 128 + n, cw, cb, v);
#pragma unroll
            for (int r = 0; r < 2; ++r)
#pragma unroll
                for (int j = 0; j < 8; ++j) sBT[(n + j) * 72 + l0 + r] = f2bft<2>(v[r][j]); }
          { const int ch = (tid & 31) * 8, l0 = (tid >> 5) * 4, e = ch >> 6; float v[4][8]; conv_rows<4>(PROJ, b, t0 + l0, g * 256 + ch, cw, cb, v);
#pragma unroll
            for (int r = 0; r < 4; ++r) { const float wgt = sDt[e * 64 + l0 + r] * expf(sAcs[e * 64 + 63] - sAcs[e * 64 + l0 + r]);
#pragma unroll
                for (int j = 0; j < 8; ++j) sXT[(ch + j) * 72 + l0 + r] = f2bft<2>(v[r][j] * wgt); } } }
        __syncthreads();
        { const int e = wave >> 1, nh = wave & 1;
          f32x4 acc[4][4];
#pragma unroll
          for (int i = 0; i < 4; ++i)
#pragma unroll
              for (int j = 0; j < 4; ++j) acc[i][j] = (f32x4){0.f, 0.f, 0.f, 0.f};
#pragma unroll
          for (int kk = 0; kk < 2; ++kk) {
              bf16x8 af[4], bfr[4];
#pragma unroll
              for (int i = 0; i < 4; ++i) af[i] = *(const bf16x8*)(sBT + (nh * 64 + 16 * i + fr) * 72 + 32 * kk + 8 * fq);
#pragma unroll
              for (int j = 0; j < 4; ++j) bfr[j] = *(const bf16x8*)(sXT + (e * 64 + 16 * j + fr) * 72 + 32 * kk + 8 * fq);
#pragma unroll
              for (int i = 0; i < 4; ++i)
#pragma unroll
                  for (int j = 0; j < 4; ++j) acc[i][j] = __builtin_amdgcn_mfma_f32_16x16x32_bf16(af[i], bfr[j], acc[i][j], 0, 0, 0);
          }
          bf16_t* sp = ST + (size_t)((b * 64 + c) * 8 + g * 4 + e) * 8192;
#pragma unroll
          for (int i = 0; i < 4; ++i)
#pragma unroll
              for (int j = 0; j < 4; ++j) { u32x2 w; w.x = pk2t<2>(acc[i][j][0], acc[i][j][1]); w.y = pk2t<2>(acc[i][j][2], acc[i][j][3]);
                  *(u32x2*)(sp + (16 * j + fr) * 128 + nh * 64 + 16 * i + 4 * fq) = w; }
        }
        __syncthreads();
    }
    { const float* sw = a->in[17] + (size_t)l * 3 * 256;
      for (int op = blockIdx.x * NT + tid; op < MROWS * 32; op += gridDim.x * NT) {
          const int m = op >> 5, ch = (op & 31) * 8, t = m & (SEQ - 1);
          float acc[8];
#pragma unroll
          for (int j = 0; j < 8; ++j) acc[j] = 0.f;
#pragma unroll
          for (int k = 0; k < 3; ++k) { const int tt = t - 2 + k;
              if (tt >= 0) { const unsigned ro = (unsigned)((size_t)(m - 2 + k) * NPROJ * 2); float cg[8], xi[8]; unpack8(ldxb<u32x4>(PROJ, ro + (PC_SC + ch) * 2), cg); unpack8(ldxb<u32x4>(PROJ, ro + (PC_SX + ch) * 2), xi);
                  const f32x4 w0 = *(const f32x4*)(sw + k * 256 + ch), w1 = *(const f32x4*)(sw + k * 256 + ch + 4);
                  acc[0] += w0.x * (cg[0] * xi[0]); acc[1] += w0.y * (cg[1] * xi[1]); acc[2] += w0.z * (cg[2] * xi[2]); acc[3] += w0.w * (cg[3] * xi[3]);
                  acc[4] += w1.x * (cg[4] * xi[4]); acc[5] += w1.y * (cg[5] * xi[5]); acc[6] += w1.z * (cg[6] * xi[6]); acc[7] += w1.w * (cg[7] * xi[7]); } }
          float bg[8]; unpack8(ldxb<u32x4>(PROJ, (unsigned)(((size_t)m * NPROJ + PC_SB + ch) * 2)), bg);
#pragma unroll
          for (int j = 0; j < 8; ++j) bg[j] *= ZC;
          u32x4 w; w.x = pk2t<6>(bg[0] * acc[0], bg[1] * acc[1]); w.y = pk2t<6>(bg[2] * acc[2], bg[3] * acc[3]); w.z = pk2t<6>(bg[4] * acc[4], bg[5] * acc[5]); w.w = pk2t<6>(bg[6] * acc[6], bg[7] * acc[7]);
          *(u32x4*)(YCAT + (size_t)m * DM + 768 + ch) = w;
      } }
    { bf16_t* VT = (bf16_t*)(a->ws + WS_VT); bf16_t* sT = (bf16_t*)lds;
      __syncthreads();
      for (int it = blockIdx.x; it < 1024; it += gridDim.x) {
          const int bh = it >> 6, kt = it & 63, b = bh >> 2, h = bh & 3, key = tid >> 3, dch = tid & 7;
          const u32x4 vreg = ldxb<u32x4>(PROJ, (unsigned)(((size_t)(b * SEQ + kt * 64 + key) * NPROJ + PC_V + h * 64 + dch * 8) * 2));
          bf16_t* vd = sT + (dch * 8) * 72 + key;
          vd[0 * 72] = (bf16_t)(vreg.x & 0xffffu); vd[1 * 72] = (bf16_t)(vreg.x >> 16); vd[2 * 72] = (bf16_t)(vreg.y & 0xffffu); vd[3 * 72] = (bf16_t)(vreg.y >> 16);
          vd[4 * 72] = (bf16_t)(vreg.z & 0xffffu); vd[5 * 72] = (bf16_t)(vreg.z >> 16); vd[6 * 72] = (bf16_t)(vreg.w & 0xffffu); vd[7 * 72] = (bf16_t)(vreg.w >> 16);
          __syncthreads();
          const u32x4 o = *(const u32x4*)(sT + key * 72 + dch * 8);
          *(u32x4*)(VT + ((size_t)bh * 64 + key) * SEQ + kt * 64 + dch * 8) = o;
          __syncthreads();
      } }
}

__device__ __forceinline__ void attn_tile(const bf16_t* sKb, const bf16_t* sVb, const float* cf2, int kt, int qw0, int qrow, int fr, int fq, float cfq,
                                          const bf16x8 qf0, const bf16x8 qf1, float& mrun, float& lrun, f32x4 (&o)[4]) {
    constexpr float C2 = 0.125f * LOG2E;
                const int k0 = kt * 64;
                if (k0 <= qw0 + 15) {
                    f32x4 sc[4];
#pragma unroll
                    for (int j = 0; j < 4; ++j) { const bf16x8 a0 = *(const bf16x8*)(sKb + (16 * j + fr) * 72 + fq * 8), a1 = *(const bf16x8*)(sKb + (16 * j + fr) * 72 + 32 + fq * 8);
                        sc[j] = __builtin_amdgcn_mfma_f32_16x16x32_bf16(a0, qf0, (f32x4){0.f, 0.f, 0.f, 0.f}, 0, 0, 0);
                        sc[j] = __builtin_amdgcn_mfma_f32_16x16x32_bf16(a1, qf1, sc[j], 0, 0, 0); }
#pragma unroll
                    for (int j = 0; j < 4; ++j) { const f32x4 ck = *(const f32x4*)(cf2 + k0 + 16 * j + 4 * fq);
#pragma unroll
                        for (int r = 0; r < 4; ++r) sc[j][r] = sc[j][r] * C2 + (cfq - ck[r]); }
                    if (k0 + 63 > qw0) {
#pragma unroll
                        for (int j = 0; j < 4; ++j)
#pragma unroll
                            for (int r = 0; r < 4; ++r) if (k0 + 16 * j + 4 * fq + r > qrow) sc[j][r] = -INFINITY;
                    }
                    float mx = fmaxf(fmaxf(sc[0][0], sc[0][1]), fmaxf(sc[0][2], sc[0][3]));
#pragma unroll
                    for (int j = 1; j < 4; ++j) mx = fmaxf(mx, fmaxf(fmaxf(sc[j][0], sc[j][1]), fmaxf(sc[j][2], sc[j][3])));
                    mx = fmaxf(mx, __shfl_xor(mx, 16)); mx = fmaxf(mx, __shfl_xor(mx, 32));
                    const float mnew = fmaxf(mrun, mx), alpha = __builtin_amdgcn_exp2f(mrun - mnew);
                    float ls = 0.f;
#pragma unroll
                    for (int j = 0; j < 4; ++j)
#pragma unroll
                        for (int r = 0; r < 4; ++r) { sc[j][r] = __builtin_amdgcn_exp2f(sc[j][r] - mnew); ls += sc[j][r]; }
                    lrun = lrun * alpha + ls; mrun = mnew;
#pragma unroll
                    for (int j = 0; j < 4; ++j) o[j] = o[j] * alpha;
#pragma unroll
                    for (int ks = 0; ks < 2; ++ks) {
                        u32x4 pw; pw.x = pk2t<4>(sc[2 * ks][0], sc[2 * ks][1]); pw.y = pk2t<4>(sc[2 * ks][2], sc[2 * ks][3]); pw.z = pk2t<4>(sc[2 * ks + 1][0], sc[2 * ks + 1][1]); pw.w = pk2t<4>(sc[2 * ks + 1][2], sc[2 * ks + 1][3]);
                        const bf16x8 pb = __builtin_bit_cast(bf16x8, pw);
#pragma unroll
                        for (int dj = 0; dj < 4; ++dj) { const bf16_t* vp = sVb + (16 * dj + fr) * 72 + 32 * ks + 4 * fq;
                            const u32x2 lo = *(const u32x2*)vp, hi = *(const u32x2*)(vp + 16); u32x4 vw; vw.x = lo.x; vw.y = lo.y; vw.z = hi.x; vw.w = hi.y;
                            o[dj] = __builtin_amdgcn_mfma_f32_16x16x32_bf16(__builtin_bit_cast(bf16x8, vw), pb, o[dj], 0, 0, 0); }
                    }
                }
}
__device__ __forceinline__ void phase_mb(CArgsP a, int l, unsigned char* lds, int tid, int wave, int lane, bool do_scan) {
    const bf16_t* PROJ = (const bf16_t*)(a->ws + WS_BIG); bf16_t* YCAT = (bf16_t*)(a->ws + WS_YCAT);
    const float* DTF = (const float*)(a->ws + WS_DTF); const float* CDEC = (const float*)(a->ws + WS_CDEC);
    if (do_scan) { unsigned* ST = (unsigned*)(a->ws + WS_ST);
      for (int gid = blockIdx.x * NT + tid; gid < 32 * 4096; gid += gridDim.x * NT) {
          const int bh = gid >> 12, rem = gid & 4095, b = bh >> 3, h = bh & 7;
          float r0 = 0.f, r1 = 0.f;
          for (int c0 = 0; c0 < 64; c0 += 8) {
              unsigned w[8]; float d[8];
#pragma unroll
              for (int i = 0; i < 8; ++i) { w[i] = ldx(ST + (size_t)((b * 64 + c0 + i) * 8 + h) * 4096 + rem); d[i] = ldx(CDEC + (b * 64 + c0 + i) * 8 + h); }
#pragma unroll
              for (int i = 0; i < 8; ++i) { ST[(size_t)((b * 64 + c0 + i) * 8 + h) * 4096 + rem] = pk2t<3>(r0, r1); r0 = r0 * d[i] + bf_lo(w[i]); r1 = r1 * d[i] + bf_hi(w[i]); }
          }
      } }
#ifdef NAIVE_ATTN
    { const float* fbias_ = a->in[16] + l * 4;
      for (int row = blockIdx.x * NT + tid; row < 16 * SEQ; row += gridDim.x * NT) {
          const int bh = row >> 12, q = row & 4095, b = bh >> 2, h = bh & 3; const float fb = fbias_[h];
          float qv[64], o[64];
#pragma unroll
          for (int d = 0; d < 64; ++d) { qv[d] = bf2f(ldx(PROJ + (size_t)(b * SEQ + q) * NPROJ + PC_Q + h * 64 + d)); o[d] = 0.f; }
          float m = -INFINITY, lsum = 0.f, bias = 0.f;
          for (int k = q; k >= 0; --k) {
              const bf16_t* kp = PROJ + (size_t)(b * SEQ + k) * NPROJ + PC_K + h * 64;
              float s = 0.f;
#pragma unroll
              for (int d8 = 0; d8 < 8; ++d8) { float kv[8]; unpack8(ldx((const u32x4*)(kp + d8 * 8)), kv);
#pragma unroll
                  for (int j = 0; j < 8; ++j) s += qv[d8 * 8 + j] * kv[j]; }
              s = s * 0.125f + bias;
              const float mn = fmaxf(m, s), al = expf(m - mn), p = expf(s - mn);
              lsum = lsum * al + p; m = mn;
#pragma unroll
              for (int d8 = 0; d8 < 8; ++d8) { float vv[8]; unpack8(ldx((const u32x4*)(kp + (PC_V - PC_K) + d8 * 8)), vv);
#pragma unroll
                  for (int j = 0; j < 8; ++j) o[d8 * 8 + j] = o[d8 * 8 + j] * al + p * vv[j]; }
              const float x = ldx(DTF + (size_t)(b * SEQ + k) * 12 + 8 + h) + fb; bias += fminf(x, 0.f) - log1pf(expf(-fabsf(x)));
          }
          const float inv = 1.f / lsum;
#pragma unroll
          for (int d = 0; d < 64; ++d) YCAT[(size_t)(b * SEQ + q) * DM + 512 + h * 64 + d] = f2bft<4>(o[d] * inv);
      } }
#endif
    const int fr = lane & 15, fq = lane >> 4;
    float* cf2 = (float*)lds;
    bf16_t* sK = (bf16_t*)(lds + 16384);
    bf16_t* sV = (bf16_t*)(lds + 16384 + 18432);
    float* wtot = (float*)(lds + 16384 + 36864);
    const float* fbias = a->in[16] + l * 4;
    constexpr float C2 = 0.125f * LOG2E;
#ifdef NAIVE_ATTN
    for (int v = 256; v < 256; v += gridDim.x) {
#else
    for (int v = blockIdx.x; v < 256; v += gridDim.x) {
#endif
        const int bh = v >> 4, s = v & 15, b = bh >> 2, h = bh & 3;
        __syncthreads();
        { float vals[8]; float run = 0.f; const float fb = fbias[h];
#pragma unroll
          for (int i = 0; i < 8; ++i) { const float x = ldx(DTF + (size_t)(b * SEQ + tid * 8 + i) * 12 + 8 + h) + fb; const float ls = fminf(x, 0.f) - log1pf(expf(-fabsf(x))); run += ls * LOG2E; vals[i] = run; }
          const float inc = wave_incl_scan(run, lane); if (lane == 63) wtot[wave] = inc;
          __syncthreads();
          float off = inc - run; for (int w = 0; w < wave; ++w) off += wtot[w];
#pragma unroll
          for (int i = 0; i < 8; ++i) cf2[tid * 8 + i] = vals[i] + off;
          __syncthreads(); }
        for (int uu = 0; uu < 2; ++uu) {
            const int qb = uu ? 31 - s : s, q0 = qb * 128, nt = 2 * (qb + 1);
            const int qw0 = q0 + wave * 16, qrow = qw0 + fr;
            const bf16_t* qp = PROJ + (size_t)(b * SEQ + qrow) * NPROJ + PC_Q + h * 64 + fq * 8;
            const bf16x8 qf0 = ldxb<bf16x8>(PROJ, (unsigned)((size_t)(qp - PROJ) * 2)), qf1 = ldxb<bf16x8>(PROJ, (unsigned)((size_t)(qp - PROJ) * 2 + 64));
            const float cfq = cf2[qrow];
            float mrun = -INFINITY, lrun = 0.f; f32x4 o[4];
#pragma unroll
            for (int j = 0; j < 4; ++j) o[j] = (f32x4){0.f, 0.f, 0.f, 0.f};
            const int key = tid >> 3, dch = tid & 7;
            const bf16_t* VT = (const bf16_t*)(a->ws + WS_VT);
            const unsigned kpo = (unsigned)(((size_t)(b * SEQ + key) * NPROJ + PC_K + h * 64 + dch * 8) * 2);
            const unsigned vpo = (unsigned)((((size_t)bh * 64 + key) * SEQ + dch * 8) * 2);
            u32x4 kA = ldxb<u32x4>(PROJ, kpo), vA = ldxb<u32x4>(VT, vpo);
            u32x4 kB = ldxb<u32x4>(PROJ, kpo + 64u * NPROJ * 2u), vB = ldxb<u32x4>(VT, vpo + 128u);
#define ATT_STEP(KT, KR, VR, BUFI) do { const int kt = (KT); bf16_t* sKb = sK + (BUFI) * 4608; bf16_t* sVb = sV + (BUFI) * 4608; \
                *(u32x4*)(sKb + key * 72 + dch * 8) = KR; *(u32x4*)(sVb + key * 72 + dch * 8) = VR; \
                __syncthreads(); \
                if (kt + 2 < nt) { KR = ldxb<u32x4>(PROJ, kpo + (unsigned)(kt + 2) * 64u * NPROJ * 2u); VR = ldxb<u32x4>(VT, vpo + (unsigned)(kt + 2) * 128u); } \
                ATT_COMPUTE } while (0)
#define ATT_COMPUTE attn_tile(sKb, sVb, cf2, kt, qw0, qrow, fr, fq, cfq, qf0, qf1, mrun, lrun, o);
            for (int kt2 = 0; kt2 < nt; kt2 += 2) { ATT_STEP(kt2, kA, vA, 0); ATT_STEP(kt2 + 1, kB, vB, 1); }
#undef ATT_STEP
#undef ATT_COMPUTE
            float lt = lrun; lt += __shfl_xor(lt, 16); lt += __shfl_xor(lt, 32);
            const float inv = ZF / lt;
            bf16_t* op = YCAT + (size_t)(b * SEQ + qrow) * DM + 512 + h * 64 + 4 * fq;
#pragma unroll
            for (int dj = 0; dj < 4; ++dj) { u32x2 w; w.x = pk2t<4>(o[dj][0] * inv, o[dj][1] * inv); w.y = pk2t<4>(o[dj][2] * inv, o[dj][3] * inv); *(u32x2*)(op + 16 * dj) = w; }
            __syncthreads();
        }
    }
}

__device__ __forceinline__ void phase_mc(CArgsP a, int l, unsigned char* lds, int tid, int wave, int lane) {
    const bf16_t* PROJ = (const bf16_t*)(a->ws + WS_BIG); bf16_t* YCAT = (bf16_t*)(a->ws + WS_YCAT); const bf16_t* ST = (const bf16_t*)(a->ws + WS_ST);
    const float* DTF = (const float*)(a->ws + WS_DTF);
    const float* cw = a->in[10] + (size_t)l * 4 * 1024; const float* cb = a->in[11] + l * 1024; const float* dtb = a->in[12] + l * 8; const float* alog = a->in[13] + l * 8;
    const float* dsk = a->in[14] + l * 8; const float* ng = a->in[15] + l * 512;
    const int fr = lane & 15, fq = lane >> 4;
    bf16_t* sC = (bf16_t*)lds;
    bf16_t* sB = (bf16_t*)(lds + 17408);
    bf16_t* sXT = (bf16_t*)(lds + 34816);
    float* sCB = (float*)(lds + 71680);
    float* sDt = (float*)(lds + 89088);
    float* sAcs = sDt + 256;
    float* sRms = sAcs + 256;
    bf16_t* sZT = (bf16_t*)(lds + 92160);
    bf16_t* sOut = (bf16_t*)lds;
    for (int it = blockIdx.x; it < 512; it += gridDim.x) {
        const int b = it >> 7, c = (it >> 1) & 63, g = it & 1, t0 = c * 64, R0 = b * SEQ + t0;
        ssd_dt_acs(DTF, dtb, alog, R0, g, wave, lane, sDt, sAcs);
        {
#pragma unroll
          for (int isC = 0; isC < 2; ++isC) { const int n = (tid & 15) * 8, l0 = (tid >> 4) * 2; float v[2][8]; conv_rows<2>(PROJ, b, t0 + l0, (isC ? 768 : 512) + g * 128 + n, cw, cb, v);
#pragma unroll
              for (int r = 0; r < 2; ++r) { u32x4 w; w.x = pk2t<5>(v[r][0], v[r][1]); w.y = pk2t<5>(v[r][2], v[r][3]); w.z = pk2t<5>(v[r][4], v[r][5]); w.w = pk2t<5>(v[r][6], v[r][7]);
                  *(u32x4*)((isC ? sC : sB) + (l0 + r) * 136 + n) = w; } }
          { const int ch = (tid & 31) * 8, l0 = (tid >> 5) * 4; float v[4][8]; conv_rows<4>(PROJ, b, t0 + l0, g * 256 + ch, cw, cb, v);
#pragma unroll
            for (int r = 0; r < 4; ++r) {
#pragma unroll
                for (int j = 0; j < 8; ++j) sXT[(ch + j) * 72 + l0 + r] = f2bft<5>(v[r][j]);
                const u32x4 zr = ldxb<u32x4>(PROJ, (unsigned)(((size_t)(R0 + l0 + r) * NPROJ + PC_Z + g * 256 + ch) * 2));
                bf16_t* zd = sZT + ch * 72 + l0 + r;
                zd[0 * 72] = (bf16_t)(zr.x & 0xffffu); zd[1 * 72] = (bf16_t)(zr.x >> 16); zd[2 * 72] = (bf16_t)(zr.y & 0xffffu); zd[3 * 72] = (bf16_t)(zr.y >> 16);
                zd[4 * 72] = (bf16_t)(zr.z & 0xffffu); zd[5 * 72] = (bf16_t)(zr.z >> 16); zd[6 * 72] = (bf16_t)(zr.w & 0xffffu); zd[7 * 72] = (bf16_t)(zr.w >> 16); } } }
        __syncthreads();
        { const int li = wave >> 1;
#pragma unroll
          for (int q = 0; q < 2; ++q) { const int sj = 2 * (wave & 1) + q; f32x4 acc = (f32x4){0.f, 0.f, 0.f, 0.f};
#pragma unroll
              for (int kk = 0; kk < 4; ++kk) { const bf16x8 af = *(const bf16x8*)(sC + (16 * li + fr) * 136 + 32 * kk + 8 * fq), bfr = *(const bf16x8*)(sB + (16 * sj + fr) * 136 + 32 * kk + 8 * fq);
                  acc = __builtin_amdgcn_mfma_f32_16x16x32_bf16(af, bfr, acc, 0, 0, 0); }
#pragma unroll
              for (int r = 0; r < 4; ++r) sCB[(16 * li + 4 * fq + r) * 68 + 16 * sj + fr] = acc[r]; } }
        __syncthreads();
        { const int e = wave >> 1, lh = wave & 1, h = g * 4 + e;
          f32x4 yd[2][4], yo[2][4];
#pragma unroll
          for (int mi = 0; mi < 2; ++mi)
#pragma unroll
              for (int pj = 0; pj < 4; ++pj) { yd[mi][pj] = (f32x4){0.f, 0.f, 0.f, 0.f}; yo[mi][pj] = yd[mi][pj]; }
#ifdef NOSKIP
          for (int kk = 0; kk < 2; ++kk) {
#else
          for (int kk = 0; kk <= lh; ++kk) {
#endif
              bf16x8 bx[4];
#pragma unroll
              for (int pj = 0; pj < 4; ++pj) bx[pj] = *(const bf16x8*)(sXT + (e * 64 + 16 * pj + fr) * 72 + 32 * kk + 8 * fq);
#pragma unroll
              for (int mi = 0; mi < 2; ++mi) { const int lrow = 32 * lh + 16 * mi + fr, s0 = 32 * kk + 8 * fq; const float al = sAcs[e * 64 + lrow];
                  const f32x4 c0 = *(const f32x4*)(sCB + lrow * 68 + s0), c1 = *(const f32x4*)(sCB + lrow * 68 + s0 + 4);
                  const f32x4 as0 = *(const f32x4*)(sAcs + e * 64 + s0), as1 = *(const f32x4*)(sAcs + e * 64 + s0 + 4), d0 = *(const f32x4*)(sDt + e * 64 + s0), d1 = *(const f32x4*)(sDt + e * 64 + s0 + 4);
                  float gv[8];
#pragma unroll
                  for (int j = 0; j < 4; ++j) { gv[j] = (s0 + j <= lrow) ? c0[j] * d0[j] * __expf(al - as0[j]) : 0.f; gv[4 + j] = (s0 + 4 + j <= lrow) ? c1[j] * d1[j] * __expf(al - as1[j]) : 0.f; }
                  u32x4 gw; gw.x = pk2t<5>(gv[0], gv[1]); gw.y = pk2t<5>(gv[2], gv[3]); gw.z = pk2t<5>(gv[4], gv[5]); gw.w = pk2t<5>(gv[6], gv[7]);
                  const bf16x8 ga = __builtin_bit_cast(bf16x8, gw);
#pragma unroll
                  for (int pj = 0; pj < 4; ++pj) yd[mi][pj] = __builtin_amdgcn_mfma_f32_16x16x32_bf16(ga, bx[pj], yd[mi][pj], 0, 0, 0); }
          }
          const bf16_t* sp = ST + (size_t)((b * 64 + c) * 8 + h) * 8192;
#pragma unroll
          for (int kk = 0; kk < 4; ++kk) {
              bf16x8 bs[4], ca[2];
#pragma unroll
              for (int pj = 0; pj < 4; ++pj) bs[pj] = ldxb<bf16x8>(ST, (unsigned)(((size_t)(sp - ST) + (16 * pj + fr) * 128 + 32 * kk + 8 * fq) * 2));
#pragma unroll
              for (int mi = 0; mi < 2; ++mi) ca[mi] = *(const bf16x8*)(sC + (32 * lh + 16 * mi + fr) * 136 + 32 * kk + 8 * fq);
#pragma unroll
              for (int mi = 0; mi < 2; ++mi)
#pragma unroll
                  for (int pj = 0; pj < 4; ++pj) yo[mi][pj] = __builtin_amdgcn_mfma_f32_16x16x32_bf16(ca[mi], bs[pj], yo[mi][pj], 0, 0, 0);
          }
          const float dh = dsk[h];
          float ss[2][4];
#pragma unroll
          for (int mi = 0; mi < 2; ++mi) { const int lb = 32 * lh + 16 * mi + 4 * fq; const f32x4 ea = *(const f32x4*)(sAcs + e * 64 + lb);
#pragma unroll
              for (int r = 0; r < 4; ++r) ss[mi][r] = 0.f;
#pragma unroll
              for (int pj = 0; pj < 4; ++pj) { const int p = 16 * pj + fr; const u32x2 xw = *(const u32x2*)(sXT + (e * 64 + p) * 72 + lb);
                  const float xs[4] = {bf_lo(xw.x), bf_hi(xw.x), bf_lo(xw.y), bf_hi(xw.y)};
                  const u32x2 zw = *(const u32x2*)(sZT + (e * 64 + p) * 72 + lb); const float zs[4] = {bf_lo(zw.x), bf_hi(zw.x), bf_lo(zw.y), bf_hi(zw.y)};
#pragma unroll
                  for (int r = 0; r < 4; ++r) { const float z = zs[r];
                      float y = yd[mi][pj][r] + __expf(ea[r]) * yo[mi][pj][r] + dh * xs[r]; y *= siluf(z); yd[mi][pj][r] = y; ss[mi][r] += y * y; } } }
#pragma unroll
          for (int mi = 0; mi < 2; ++mi)
#pragma unroll
              for (int r = 0; r < 4; ++r) { float s = ss[mi][r]; s += __shfl_xor(s, 1); s += __shfl_xor(s, 2); s += __shfl_xor(s, 4); s += __shfl_xor(s, 8);
                  if (fr == 0) sRms[(32 * lh + 16 * mi + 4 * fq + r) * 4 + e] = s; }
          __syncthreads();
#pragma unroll
          for (int mi = 0; mi < 2; ++mi) { const int lb = 32 * lh + 16 * mi + 4 * fq;
#pragma unroll
              for (int r = 0; r < 4; ++r) { const f32x4 q4 = *(const f32x4*)(sRms + (lb + r) * 4); const float rstd = 1.f / sqrtf(((q4.x + q4.y) + (q4.z + q4.w)) * (1.f / 256.f) + RMS_EPS);
#pragma unroll
                  for (int pj = 0; pj < 4; ++pj) { const int chl = e * 64 + 16 * pj + fr; sOut[(lb + r) * 264 + chl] = f2bft<5>(ZS * yd[mi][pj][r] * rstd * ng[g * 256 + chl]); } } }
        }
        __syncthreads();
        for (int o = tid; o < 2048; o += NT) { const int ll = o >> 5, c8 = (o & 31) * 8; *(u32x4*)(YCAT + (size_t)(R0 + ll) * DM + g * 256 + c8) = *(const u32x4*)(sOut + ll * 264 + c8); }
        __syncthreads();
    }
}
}


#define LAS __attribute__((address_space(3)))
#ifndef XB_ACQ_SCOPE
#define XB_ACQ_SCOPE ""
#endif
#define XB_TMO      128
#define XB_XCNT(j)  (256  + 64 * (j))
#define XB_XSUB(j)  (1280 + 64 * (j))
#define XB_XGEN(j)  (2304 + 64 * (j))
#define XB_TOP      3328
#define XB_TOPGEN   3392
#define XCD_BAR_WORDS 3456
#define XB_SPIN_CAP (1u << 18)

__device__ __forceinline__ unsigned xb_ld(unsigned* p)              { return __hip_atomic_load(p, __ATOMIC_RELAXED, __HIP_MEMORY_SCOPE_AGENT); }
__device__ __forceinline__ unsigned xb_add(unsigned* p, unsigned v) { return __hip_atomic_fetch_add(p, v, __ATOMIC_RELAXED, __HIP_MEMORY_SCOPE_AGENT); }
__device__ __forceinline__ unsigned xb_xcc_id() { return (unsigned)__builtin_amdgcn_s_getreg((3 << 11) | 20) & 0xFu; }
#define XB_SPIN(cond, bar) do { unsigned _sp = 0; while (cond) { __builtin_amdgcn_s_sleep(1); \
    if ((++_sp & 255u) == 0u) { if (xb_ld(&(bar)[XB_TMO])) break; if (_sp > XB_SPIN_CAP) { atomicAdd(&(bar)[XB_TMO], 1u); break; } } } } while (0)

struct XcdBarrier {
    unsigned* bar; unsigned x;
    volatile LAS unsigned* st;
};

__device__ __forceinline__ XcdBarrier xcd_barrier_post(unsigned* bar, volatile LAS unsigned* st) {
    XcdBarrier b; b.bar = bar; b.x = xb_xcc_id(); b.st = st;
    if (threadIdx.x == 0) (void)xb_add(&bar[XB_XCNT(b.x)], 1u);
    return b;
}
__device__ __forceinline__ void xcd_barrier_complete(unsigned* bar, unsigned x, unsigned& nloc, unsigned& nx) {
    const unsigned G = gridDim.x * gridDim.y * gridDim.z;
    unsigned sum, cnt, mine, sp = 0u;
    for (;;) {
        sum = 0u; cnt = 0u; mine = 0u;
#pragma unroll
        for (unsigned j = 0; j < 16; ++j) { const unsigned c = xb_ld(&bar[XB_XCNT(j)]); sum += c; cnt += (c > 0u) ? 1u : 0u; mine = (j == x) ? c : mine; }
        if (sum == G) break;
        __builtin_amdgcn_s_sleep(1);
        if ((++sp & 255u) == 0u) { if (xb_ld(&bar[XB_TMO])) break; if (sp > XB_SPIN_CAP) { atomicAdd(&bar[XB_TMO], 1u); break; } }
    }
    nloc = mine > 0u ? mine : 1u; nx = cnt > 0u ? cnt : 1u;
}

__device__ __forceinline__ void xcd_barrier(const XcdBarrier& b) {
    asm volatile("s_waitcnt vmcnt(0)" ::: "memory");
    __syncthreads();
    if (threadIdx.x == 0) {
        unsigned* bar = b.bar;
        __builtin_amdgcn_s_waitcnt(0);
        unsigned nloc = b.st[0], nx = b.st[1];
        if (nloc == 0u) { xcd_barrier_complete(bar, b.x, nloc, nx); b.st[0] = nloc; b.st[1] = nx; }
        const unsigned old = xb_add(&bar[XB_XSUB(b.x)], 1u);
        const unsigned gen = old / nloc;
        if (old + 1u == (gen + 1u) * nloc) {
            __builtin_amdgcn_fence(__ATOMIC_RELEASE, "agent");
            asm volatile("s_waitcnt vmcnt(0)" ::: "memory");
            const unsigned og = xb_add(&bar[XB_TOP], 1u);
            const unsigned tg = og / nx;
            if (og + 1u == (tg + 1u) * nx) xb_add(&bar[XB_TOPGEN], 1u);
            else XB_SPIN(xb_ld(&bar[XB_TOPGEN]) == tg, bar);
            __builtin_amdgcn_fence(__ATOMIC_ACQUIRE, "");
            asm volatile("s_waitcnt vmcnt(0)" ::: "memory");
            xb_add(&bar[XB_XGEN(b.x)], 1u);
            asm volatile("s_waitcnt vmcnt(0)" ::: "memory");
        } else {
            XB_SPIN(xb_ld(&bar[XB_XGEN(b.x)]) == gen, bar);
            __builtin_amdgcn_fence(__ATOMIC_ACQUIRE, "agent");
            asm volatile("s_waitcnt vmcnt(0)" ::: "memory");
        }
    }
    __syncthreads();
}


#ifndef MK_STOP_AFTER
#define MK_STOP_AFTER 1000
#endif
__global__ void __launch_bounds__(512, 2) mega_fwd(mk::Args a_unused) {
    using namespace mk;
    extern __shared__ __attribute__((aligned(16))) unsigned char lds[];
    cg::grid_group grid = cg::this_grid();
    volatile LAS unsigned* bst = (volatile LAS unsigned*)((LAS unsigned char*)lds + 147392);
#ifdef LDS_POISON
    for (int i = threadIdx.x; i < mk::LDS_BYTES / 4; i += 512) ((volatile unsigned*)lds)[i] = 0xFFFFFFFFu;
    __syncthreads();
#endif
    if (threadIdx.x < 8) bst[threadIdx.x] = 0u;
    __syncthreads();
    { CArgsP a0 = get_args(); (void)xcd_barrier_post((unsigned*)(a0->ws + WS_BAR), bst); }
    grid.sync();
#define GSYNC() do { CArgsP a_ = get_args(); XcdBarrier b_; b_.bar = (unsigned*)(a_->ws + WS_BAR); b_.x = xb_xcc_id(); b_.st = bst; xcd_barrier(b_); } while (0)
#pragma unroll 1
    for (int ph_ = 0; ph_ < (MK_STOP_AFTER < 25 ? MK_STOP_AFTER + 1 : 26); ++ph_) {
        int ph = ph_; asm volatile("" : "+s"(ph));
#ifdef TIME_CAT
        unsigned long long tc0_ = __builtin_amdgcn_s_memrealtime();
#endif
        int tid = threadIdx.x; asm volatile("" : "+v"(tid)); const int lane = tid & 63, wave = __builtin_amdgcn_readfirstlane(tid >> 6);
        CArgsP a = get_args();
        unsigned char* ws = a->ws;
        const int p = ph - 2, l = p < 0 ? 0 : p / 12, s = p < 0 ? -1 : p % 12;
        if (s == 0 || s == 1 || s == 3 || s == 7 || s == 9 || s == 10) {
#ifndef NO_G
            unsigned char* wl = ws + WS_W + (size_t)l * W_L;
            const size_t aoff = (s == 0 || s == 3 || s == 9) ? WS_HB : (s == 7 ? WS_YCAT : WS_BIG);
            const size_t boff = s == 0 ? WO_1IN : s == 1 ? WO_1OUT : s == 3 ? WO_MI : s == 7 ? WO_MO : s == 9 ? WO_2IN : WO_2OUT;
            const int N = (s == 0 || s == 9) ? NFF : (s == 3 ? NPROJ : DM), K = (s == 1 || s == 10) ? DFF : DM;
            pg8::Gemm g_{(const bf16_t*)(ws + aoff), (const bf16_t*)(wl + boff), MROWS, N, K}; pg8::StaticOrder S_; S_.init(MROWS, N, (int)gridDim.x, (int)blockIdx.x);
            EpiMulti E{s | (l << 8)};
            pg8::gemm_phase<EpiMulti, pg8::StaticOrder, true, true>((PG8_LAS unsigned char*)lds, g_, S_, E);
#ifdef DUP_G0
            if (s == 0 || s == 9) { __syncthreads(); pg8::gemm_phase<EpiMulti, pg8::StaticOrder, true, true>((PG8_LAS unsigned char*)lds, g_, S_, E); }
#endif
#endif
        } else if (ph == 0) {
#ifndef NO_P0
            phase_p0(a, lds, tid, wave, lane);
#ifdef DUP_P0
            __syncthreads(); phase_p0(a, lds, tid, wave, lane, DUP_P0);
#endif
#endif
        } else if (ph == 1 || s == 8 || s == 11) {
            const float* modl = (const float*)(ws + WS_MOD) + (size_t)l * 4 * NMOD;
            const int li = s == 8 ? 1 : 2, sub = s == 8 ? 2 : 0; const bool wh = !(s == 11 && l == 1);
            const float* src = ph == 1 ? a->in[0] : (const float*)a->out;
            const float* gm = ph == 1 ? a->in[2] : a->in[20] + (l * 3 + li) * DM; const float* bt = ph == 1 ? a->in[3] : a->in[21] + (l * 3 + li) * DM;
            const float* md = (s == 11 && l == 0) ? modl + 4 * NMOD : modl;
            phase_ln<false>(src, a->out, (bf16_t*)(ws + WS_HB), gm, bt, md, sub, wh, nullptr, nullptr, lds, tid, wave, lane);
#ifdef DUP_LN1
            if (ph == 1) { phase_ln<false>(src, a->out, (bf16_t*)(ws + WS_HB), gm, bt, md, sub, wh, nullptr, nullptr, lds, tid, wave, lane); phase_ln<false>(src, a->out, (bf16_t*)(ws + WS_HB), gm, bt, md, sub, wh, nullptr, nullptr, lds, tid, wave, lane); phase_ln<false>(src, a->out, (bf16_t*)(ws + WS_HB), gm, bt, md, sub, wh, nullptr, nullptr, lds, tid, wave, lane); }
#endif
        } else if (s == 2) {
            const float* modl = (const float*)(ws + WS_MOD) + (size_t)l * 4 * NMOD;
            phase_ln<true>(a->out, a->out, (bf16_t*)(ws + WS_HB), a->in[20] + l * 3 * DM, a->in[21] + l * 3 * DM, modl, 1, true, (const float*)(ws + WS_WMISC) + l * 12288, (float*)(ws + WS_DTF), lds, tid, wave, lane);
        } else if (s == 4) {
            phase_ma(a, l, lds, tid, wave, lane);
#if defined(DUP_MIX) && (DUP_MIX & 1)
            __syncthreads(); phase_ma(a, l, lds, tid, wave, lane);
#endif
        } else if (s == 5) {
            phase_mb(a, l, lds, tid, wave, lane, true);
#if defined(DUP_MIX) && (DUP_MIX & 2)
            __syncthreads(); phase_mb(a, l, lds, tid, wave, lane, false);
#endif
        } else {
            phase_mc(a, l, lds, tid, wave, lane);
#if defined(DUP_MIX) && (DUP_MIX & 4)
            __syncthreads(); phase_mc(a, l, lds, tid, wave, lane);
#endif
        }
        if (ph_ < 25) GSYNC();
#ifdef DUP_BAR
        if (ph_ < 25) { GSYNC(); GSYNC(); }
#endif
#ifdef TIME_CAT
        { const int p2_ = ph_ - 2, s2_ = p2_ < 0 ? -1 : p2_ % 12;
          const int cat_ = (s2_ == 0 || s2_ == 1 || s2_ == 3 || s2_ == 7 || s2_ == 9 || s2_ == 10) ? 1 : (ph_ == 0 ? 6 : ((ph_ == 1 || s2_ == 2 || s2_ == 8 || s2_ == 11) ? 2 : (s2_ == 4 ? 3 : (s2_ == 5 ? 4 : 5))));
          if (cat_ == TIME_CAT && threadIdx.x == 0) { volatile LAS unsigned* tacc = bst + 4; tacc[0] = tacc[0] + (unsigned)(__builtin_amdgcn_s_memrealtime() - tc0_); } }
#endif
    }
#ifdef TIME_CAT
    if (blockIdx.x == 0 && threadIdx.x == 0) { CArgsP a9 = get_args(); a9->out[0] = (float)bst[4] * 0.01f; }
#endif
}

extern "C" void kernel_launch(void* const* d_in, const int* in_sizes, int n_in, void* d_out, int out_size, void* d_ws, size_t ws_size, hipStream_t stream) {
    static int grid = 0;
    if (grid == 0) {
        if (n_in != 22 || out_size != mk::MROWS * mk::DM || ws_size < mk::WS_END) { fprintf(stderr, "kernel_launch: unexpected problem (n_in %d out %d ws %zu)\n", n_in, out_size, ws_size); grid = -1; return; }
        int dev = 0, cus = 0, per_cu = 0;
        (void)hipGetDevice(&dev); (void)hipDeviceGetAttribute(&cus, hipDeviceAttributeMultiprocessorCount, dev);
        (void)hipFuncSetAttribute((const void*)mega_fwd, hipFuncAttributeMaxDynamicSharedMemorySize, mk::LDS_BYTES);
        (void)hipOccupancyMaxActiveBlocksPerMultiprocessor(&per_cu, (const void*)mega_fwd, 512, mk::LDS_BYTES);
        (void)hipGetLastError();
        if (per_cu < 1) { fprintf(stderr, "kernel_launch: occupancy query says %d\n", per_cu); grid = -1; return; }
        grid = cus;
    }
    if (grid < 0) return;
#ifdef NAN_POISON
    (void)hipMemsetAsync(d_ws, 0xFF, mk::WS_END, stream); (void)hipMemsetAsync(d_out, 0xFF, (size_t)out_size * 4, stream);
#endif
    if (hipMemsetAsync((char*)d_ws + mk::WS_BAR, 0, 16384, stream) != hipSuccess) { fprintf(stderr, "kernel_launch: memset failed\n"); return; }
    mk::Args a{};
    for (int i = 0; i < 22; ++i) a.in[i] = (const float*)d_in[i];
    a.out = (float*)d_out; a.ws = (unsigned char*)d_ws;
    void* args[] = {&a};
    hipError_t e = hipLaunchCooperativeKernel((const void*)mega_fwd, dim3(grid), dim3(512), args, mk::LDS_BYTES, stream);
    if (e != hipSuccess) fprintf(stderr, "cooperative launch failed: %s (grid %d)\n", hipGetErrorString(e), grid);
}
```
